# Optimizing an MI355X kernel written in HIP

```python
import jax, jax.numpy as jnp
from jax import lax
import numpy as np

D_MODEL = 2048
BATCH = 4
SEQ = 4096
DEPTH = 1

A_HEADS = 8
A_HEAD_DIM = 128
A_WIDTH = A_HEADS * A_HEAD_DIM
Q_RANK = 512
IDX_HEADS = 16
IDX_DIM = 128
TOPK_MAX = 256
Q_BLOCK = 128
ROPE_THETA = 10000.0
G_HEADS = 8
G_KDIM = 128
G_VDIM = 128
G_WIDTH_K = G_HEADS * G_KDIM
G_WIDTH_V = G_HEADS * G_VDIM
CHUNK = 64
N_GROUPS = 4
EXP_PER_GROUP = 8
N_EXPERTS = N_GROUPS * EXP_PER_GROUP
TOPK_EXP = 2
D_EXPERT = 512
EPS = 1e-6
SEG_SIZES = (Q_RANK, A_HEAD_DIM, A_HEAD_DIM, IDX_DIM, IDX_HEADS, G_WIDTH_K, G_WIDTH_K, G_WIDTH_V, G_WIDTH_V, D_MODEL, D_MODEL)
D_IN = Q_RANK + 2 * A_HEAD_DIM + IDX_DIM + IDX_HEADS + 2 * G_WIDTH_K + 2 * G_WIDTH_V + 2 * D_MODEL

kernel_name = 'hybrid_dsa_hgrn2_hmoe'


def rmsnorm(x, g):
    x32 = x.astype(jnp.float32)
    y = x32 * lax.rsqrt(jnp.mean(x32 * x32, axis=-1, keepdims=True) + EPS)
    return (y * g.astype(jnp.float32)).astype(x.dtype)


def rope_tables(seq, dim):
    inv = 1.0 / (ROPE_THETA ** (jnp.arange(0, dim, 2, dtype=jnp.float32) / dim))
    ang = jnp.arange(seq, dtype=jnp.float32)[:, None] * inv[None, :]
    return jnp.cos(ang), jnp.sin(ang)


def apply_rope(x, cos, sin):
    x32 = x.astype(jnp.float32)
    x1, x2 = jnp.split(x32, 2, axis=-1)
    c = cos[None, :, None, :]
    s = sin[None, :, None, :]
    return jnp.concatenate([x1 * c - x2 * s, x2 * c + x1 * s], axis=-1).astype(x.dtype)


def split_cols(p):
    bounds = np.cumsum(SEG_SIZES)[:-1].tolist()
    return jnp.split(p, bounds, axis=-1)


def dsa_attention(c_q, k_att, v_att, k_idx, w_idx, g_cq, w_uq, w_qidx, cos, sin):
    b, s, _ = c_q.shape
    topk = min(TOPK_MAX, s // 4)
    nb = s // Q_BLOCK
    cqn = rmsnorm(c_q, g_cq)
    q = apply_rope((cqn @ w_uq).reshape(b, s, A_HEADS, A_HEAD_DIM), cos, sin)
    qi = apply_rope((cqn @ w_qidx).reshape(b, s, IDX_HEADS, IDX_DIM), cos, sin)
    k = apply_rope(k_att[:, :, None, :], cos, sin)[:, :, 0, :]
    ki = apply_rope(k_idx[:, :, None, :], cos, sin)[:, :, 0, :]
    wi = w_idx.astype(jnp.float32) * (IDX_HEADS ** -0.5 * IDX_DIM ** -0.5)
    key_pos = jnp.arange(s)
    scale = A_HEAD_DIM ** -0.5

    def blocks(t):
        return jnp.swapaxes(t.reshape((b, nb, Q_BLOCK) + t.shape[2:]), 0, 1)

    def one_block(args):
        qb, qib, wb, pos = args
        logits = jnp.einsum('bthd,bsd->bths', qib, ki, preferred_element_type=jnp.float32)
        score = jnp.einsum('bths,bth->bts', jax.nn.relu(logits), wb)
        causal = key_pos[None, :] <= pos[:, None]
        score = jnp.where(causal[None], score, -jnp.inf)
        _, idx = lax.top_k(score, topk)
        valid = idx <= pos[None, :, None]
        kg = jax.vmap(lambda kk, ii: kk[ii])(k, idx)
        vg = jax.vmap(lambda vv, ii: vv[ii])(v_att, idx)
        att = jnp.einsum('bthd,btkd->bthk', qb, kg, preferred_element_type=jnp.float32) * scale
        att = jnp.where(valid[:, :, None, :], att, -jnp.inf)
        p = jax.nn.softmax(att, axis=-1)
        return jnp.einsum('bthk,btkd->bthd', p.astype(vg.dtype), vg)

    pos_blocks = key_pos.reshape(nb, Q_BLOCK)
    out = lax.map(one_block, (blocks(q), blocks(qi), blocks(wi), pos_blocks))
    return jnp.swapaxes(out, 0, 1).reshape(b, s, A_WIDTH)


def hgrn2(hq, hf, hi, hg, lb, g_onorm):
    b, s, _ = hq.shape
    n = s // CHUNK
    f = lb + (1.0 - lb) * jax.nn.sigmoid(hf.astype(jnp.float32))
    log_f = jnp.log(f)
    k = 1.0 - f
    q = jax.nn.silu(hq.astype(jnp.float32))
    v = hi.astype(jnp.float32)

    def chunks(t, d):
        return t.reshape(b, n, CHUNK, G_HEADS, d).transpose(1, 0, 3, 2, 4)

    tri = jnp.tril(jnp.ones((CHUNK, CHUNK), dtype=bool))

    def step(state, inp):
        qc, kc, vc, gc = inp
        cum = jnp.cumsum(gc, axis=2)
        diff = cum[:, :, :, None, :] - cum[:, :, None, :, :]
        decay = jnp.exp(jnp.where(tri[None, None, :, :, None], diff, -jnp.inf))
        scores = jnp.einsum('bhtsd,bhsd->bhts', qc[:, :, :, None, :] * decay, kc)
        o = jnp.einsum('bhts,bhsv->bhtv', scores, vc) + jnp.einsum('bhtd,bhdv->bhtv', qc * jnp.exp(cum), state)
        last = cum[:, :, -1:, :]
        new_state = jnp.exp(last[:, :, 0, :])[..., None] * state + jnp.einsum('bhsd,bhsv->bhdv', kc * jnp.exp(last - cum), vc)
        return new_state, o

    s0 = jnp.zeros((b, G_HEADS, G_KDIM, G_VDIM), jnp.float32)
    _, o = lax.scan(step, s0, (chunks(q, G_KDIM), chunks(k, G_KDIM), chunks(v, G_VDIM), chunks(log_f, G_KDIM)))
    o = o.transpose(1, 0, 3, 2, 4).reshape(b, s, G_WIDTH_V).astype(hq.dtype)
    return rmsnorm(o, g_onorm) * jax.nn.silu(hg)


def hier_moe(h, w_grp, b_grp, w_exp, b_exp, w_gate, w_up, w_down):
    b, s, d = h.shape
    n = b * s
    t = h.reshape(n, d)
    p_grp = jax.nn.softmax((t @ w_grp).astype(jnp.float32) + b_grp.astype(jnp.float32), axis=-1)
    grp = jnp.argmax(p_grp, axis=-1)
    p_g = jnp.max(p_grp, axis=-1, keepdims=True)
    logit_e = ((t @ w_exp).astype(jnp.float32) + b_exp.astype(jnp.float32)).reshape(n, N_GROUPS, EXP_PER_GROUP)
    logit_e = logit_e[jnp.arange(n), grp]
    p_e, e_idx = lax.top_k(jax.nn.softmax(logit_e, axis=-1), TOPK_EXP)
    gate = p_g * p_e / jnp.sum(p_e, axis=-1, keepdims=True)
    eid = (grp[:, None] * EXP_PER_GROUP + e_idx).reshape(-1)
    order = jnp.argsort(eid)
    tok = order // TOPK_EXP
    xs = t[tok]
    sizes = jnp.bincount(eid, length=N_EXPERTS).astype(jnp.int32)
    a = lax.ragged_dot(xs, w_gate, sizes)
    u = lax.ragged_dot(xs, w_up, sizes)
    y = lax.ragged_dot(jax.nn.silu(a) * u, w_down, sizes)
    y = y * gate.reshape(-1)[order][:, None].astype(y.dtype)
    return jax.ops.segment_sum(y, tok, num_segments=n).reshape(b, s, d)


def setup_inputs(seed: int = 0) -> dict:
    key = jax.random.key(seed)
    ks = jax.random.split(key, 20)
    f32 = jnp.float32

    def nrm(k, shape, fan_in):
        return jax.random.normal(k, shape, f32) * (fan_in ** -0.5)

    def gain(k, shape):
        return 1.0 + 0.02 * jax.random.normal(k, shape, f32)

    return {
        'x': jax.random.normal(ks[0], (BATCH, SEQ, D_MODEL), f32),
        'g_norm1': gain(ks[1], (DEPTH, D_MODEL)),
        'w_in': nrm(ks[2], (DEPTH, D_MODEL, D_IN), D_MODEL),
        'g_cq': gain(ks[3], (DEPTH, Q_RANK)),
        'w_uq': nrm(ks[4], (DEPTH, Q_RANK, A_WIDTH), Q_RANK),
        'w_qidx': nrm(ks[5], (DEPTH, Q_RANK, IDX_HEADS * IDX_DIM), Q_RANK),
        'lb_logits': 0.5 * jax.random.normal(ks[6], (DEPTH + 1, G_WIDTH_K), f32),
        'g_hnorm': gain(ks[7], (DEPTH, G_WIDTH_V)),
        'w_pa': nrm(ks[8], (DEPTH, A_WIDTH, D_MODEL), A_WIDTH),
        'w_pb': nrm(ks[9], (DEPTH, G_WIDTH_V, D_MODEL), G_WIDTH_V),
        'w_o': nrm(ks[10], (DEPTH, D_MODEL, D_MODEL), D_MODEL),
        'g_norm2': gain(ks[11], (DEPTH, D_MODEL)),
        'w_grp': nrm(ks[12], (DEPTH, D_MODEL, N_GROUPS), D_MODEL),
        'b_grp': 0.01 * jax.random.normal(ks[13], (DEPTH, N_GROUPS), f32),
        'w_exp': nrm(ks[14], (DEPTH, D_MODEL, N_EXPERTS), D_MODEL),
        'b_exp': 0.01 * jax.random.normal(ks[15], (DEPTH, N_EXPERTS), f32),
        'w_gate': nrm(ks[16], (DEPTH, N_EXPERTS, D_MODEL, D_EXPERT), D_MODEL),
        'w_up': nrm(ks[17], (DEPTH, N_EXPERTS, D_MODEL, D_EXPERT), D_MODEL),
        'w_down': nrm(ks[18], (DEPTH, N_EXPERTS, D_EXPERT, D_MODEL), D_EXPERT),
        'g_final': gain(ks[19], (D_MODEL,)),
    }


def reference(x, g_norm1, w_in, g_cq, w_uq, w_qidx, lb_logits, g_hnorm, w_pa, w_pb, w_o, g_norm2, w_grp, b_grp, w_exp, b_exp, w_gate, w_up, w_down, g_final):
    s = x.shape[1]
    cos, sin = rope_tables(s, A_HEAD_DIM)
    lb_all = jnp.cumsum(jax.nn.softmax(lb_logits.astype(jnp.float32), axis=0), axis=0)
    for l in range(DEPTH):
        h = rmsnorm(x, g_norm1[l])
        c_q, k_att, v_att, k_idx, w_idx, hq, hf, hi, hg, ga, gb = split_cols(h @ w_in[l])
        y_att = dsa_attention(c_q, k_att, v_att, k_idx, w_idx, g_cq[l], w_uq[l], w_qidx[l], cos, sin)
        y_rec = hgrn2(hq, hf, hi, hg, lb_all[l], g_hnorm[l])
        merged = jax.nn.sigmoid(ga) * (y_att @ w_pa[l]) + jax.nn.sigmoid(gb) * (y_rec @ w_pb[l])
        x = x + merged @ w_o[l]
        x = x + hier_moe(rmsnorm(x, g_norm2[l]), w_grp[l], b_grp[l], w_exp[l], b_exp[l], w_gate[l], w_up[l], w_down[l])
    return rmsnorm(x, g_final)
```

```cpp
#include <hip/hip_runtime.h>
#include <hip/hip_cooperative_groups.h>
#include <cstdio>
#include <cstdint>
namespace cg = cooperative_groups;

#define LAS __attribute__((address_space(3)))
typedef unsigned short bf16_t;
typedef short bf16x8 __attribute__((ext_vector_type(8)));
typedef float f32x4 __attribute__((ext_vector_type(4)));
typedef float f32x2 __attribute__((ext_vector_type(2)));
typedef float f32x16 __attribute__((ext_vector_type(16)));
typedef unsigned u32x4 __attribute__((ext_vector_type(4)));
typedef unsigned u32x2 __attribute__((ext_vector_type(2)));

constexpr int NTOK = 16384, DM = 2048, SEQ = 4096, NBATCH = 4;
constexpr int DIN = 9104, NP1 = 9216;
constexpr int QR = 512;
constexpr int NEXP = 32, DEXP = 512;
constexpr int XS_ROWS = 40704;
constexpr float EPS = 1e-6f;

constexpr size_t MiB = 1u << 20;
constexpr size_t WS_R0 = 0;
constexpr size_t WS_R1 = 64 * MiB;
constexpr size_t WS_R2 = 100 * MiB;
constexpr size_t WS_R3 = 228 * MiB;
constexpr size_t WS_R4 = 292 * MiB;
constexpr size_t WS_R5 = 420 * MiB;
constexpr size_t WS_R6 = 452 * MiB;
constexpr size_t WS_R7 = 484 * MiB;
constexpr size_t WS_R8 = 516 * MiB;
constexpr size_t WS_R9 = 548 * MiB;
constexpr size_t WS_R10 = 564 * MiB;
constexpr size_t WS_R11 = 580 * MiB;
constexpr size_t WS_MISC = 599 * MiB;
constexpr size_t WS_END = 607 * MiB;

constexpr size_t WS_XB = WS_R0, WS_QI = WS_R0, WS_YATT = WS_R0, WS_YREC = WS_R0 + 32 * MiB, WS_X1B = WS_R0, WS_ACT = WS_R3;
constexpr size_t WS_WTIN = WS_R1, WS_Q = WS_R1;
constexpr size_t WS_RG = WS_R2, WS_SB = WS_R2 + 64 * MiB, WS_WDT = WS_R2;
constexpr size_t WS_LOGF = WS_R3, WS_SEL = WS_R3, WS_MERGED = WS_R3;
constexpr size_t WS_KV = WS_R4, WS_WGUT = WS_R4;
constexpr size_t WS_QT = WS_R5, WS_XS = WS_R5, WS_YS = WS_R5;
constexpr size_t WS_VH = WS_R6, WS_SG = WS_R7, WS_KT = WS_R8, WS_CQ = WS_R9;
constexpr size_t WS_KR = WS_R10, WS_KIR = WS_R10 + 4 * MiB, WS_VV = WS_R10 + 8 * MiB, WS_WI = WS_R10 + 12 * MiB, WS_COS = WS_R10 + 13 * MiB, WS_SIN = WS_R10 + 14 * MiB;
constexpr size_t WS_WTQQ = WS_R11, WS_WTPA = WS_R11 + 3 * MiB, WS_WTPB = WS_R11 + 7 * MiB, WS_WTO = WS_R11 + 11 * MiB;
constexpr size_t WS_RSTD1 = WS_MISC;
constexpr size_t WS_SSQCQ = WS_MISC + 64 * 1024;
constexpr size_t WS_SSQ2 = WS_MISC + 576 * 1024;
constexpr size_t WS_NSEL = WS_MISC + 2624 * 1024;
constexpr size_t WS_LB = WS_MISC + 2688 * 1024;
constexpr size_t WS_AVEC = WS_MISC + 2692 * 1024;
constexpr size_t WS_DECAY = WS_MISC + 3716 * 1024;
constexpr size_t WS_ROUTE_E = WS_MISC + 4740 * 1024;
constexpr size_t WS_ROUTE_G = WS_MISC + 4868 * 1024;
constexpr size_t WS_DEST = WS_MISC + 4996 * 1024;
constexpr size_t WS_RSS = WS_MISC + 5124 * 1024;
constexpr size_t WS_GS = WS_MISC + 5284 * 1024;
constexpr size_t WS_WRT = WS_MISC + 5444 * 1024;
constexpr size_t WS_CTL = WS_MISC + 5636 * 1024;
constexpr size_t WS_BAR = WS_MISC + 5640 * 1024;
static_assert(WS_BAR + 16384 <= WS_END, "ws map");

__device__ __forceinline__ float bf2f(unsigned b) { return __uint_as_float(b << 16); }
__device__ __forceinline__ unsigned f2bf(float f) { unsigned u = __float_as_uint(f); return (u + 0x7fffu + ((u >> 16) & 1u)) >> 16; }
typedef __bf16 bf16v2 __attribute__((ext_vector_type(2)));
__device__ __forceinline__ unsigned pk2(float lo, float hi) { f32x2 v = {lo, hi}; bf16v2 b = __builtin_convertvector(v, bf16v2); return __builtin_bit_cast(unsigned, b); }
__device__ __forceinline__ float shx(float v, int m, int lane) { return __int_as_float(__builtin_amdgcn_ds_bpermute((lane ^ m) << 2, __float_as_int(v))); }
__device__ __forceinline__ int shx_i(int v, int m, int lane) { return __builtin_amdgcn_ds_bpermute((lane ^ m) << 2, v); }
__device__ __forceinline__ int shl_i(int v, int src, int) { return __builtin_amdgcn_ds_bpermute(src << 2, v); }
__device__ __forceinline__ float wave_sum(float v, int lane) {
#pragma unroll
    for (int o = 1; o < 64; o <<= 1) v += shx(v, o, lane);
    return v;
}
__device__ __forceinline__ int wave_sum_i(int v, int lane) {
#pragma unroll
    for (int o = 1; o < 64; o <<= 1) v += shx_i(v, o, lane);
    return v;
}
__device__ __forceinline__ float sigmoidf_(float x) { return __builtin_amdgcn_rcpf(1.0f + __expf(-x)); }
__device__ __forceinline__ float siluf_(float x) { return x * sigmoidf_(x); }
__device__ __forceinline__ int opaque_i(int x) { asm volatile("" : "+v"(x)); return x; }
__device__ __forceinline__ int lane_id() { int x; asm volatile("v_mbcnt_lo_u32_b32 %0, -1, 0\n\tv_mbcnt_hi_u32_b32 %0, -1, %0" : "=v"(x)); return x; }
#define LDS_WAIT() asm volatile("s_waitcnt lgkmcnt(0)" ::: "memory")
#define VM_WAIT() asm volatile("s_waitcnt vmcnt(0)" ::: "memory")

namespace pg8 {
constexpr int BM = 256, BK = 64, HALF = 128, HTB = HALF * BK * 2, STAGE_BYTES = 8 * HTB, NXCD = 8, WGM = 8;
__host__ __device__ __forceinline__ int lds_byte(int r, int c) { const int st = (r >> 4) * 2 + (c >> 5), rr = r & 15, cc = c & 31, ob = rr * 64 + cc * 2; return st * 1024 + (ob ^ (((ob >> 9) & 1) << 5)); }
__host__ __device__ __forceinline__ void stage_rc(int b, int& R, int& C) { const int st = b / 1024, sb = b % 1024, swz = sb ^ (((sb >> 9) & 1) << 5); R = (st >> 1) * 16 + swz / 64; C = (st & 1) * 32 + (swz % 64) / 2; }
__host__ __device__ __forceinline__ int perm32(int rho) { const int n = rho >> 4, i = rho & 15; return 8 * (i >> 2) + 4 * n + (i & 3); }

struct Unit { const char* A; const char* B; int pm, pn, aux; };

__device__ __forceinline__ bool static_tile(long L, int nM, int nN, int& pm, int& pn) {
    const int nwg = nM * nN; if (L >= nwg) return false;
    int wgid = (int)L; { const int q = nwg / NXCD, r = nwg % NXCD, xcd = wgid % NXCD, off = wgid / NXCD; wgid = (xcd < r ? xcd * (q + 1) : r * (q + 1) + (xcd - r) * q) + off; }
    const int nig = WGM * nN, gid = wgid / nig, fm = gid * WGM, gsz = (nM - fm) < WGM ? (nM - fm) : WGM;
    pm = fm + ((wgid % nig) % gsz); pn = (wgid % nig) / gsz; return true;
}

template <class Epi, class Sched>
__device__ __forceinline__ void gemm_phase(LAS unsigned char* lds, const int K, const Sched& S, const Epi& E, const int wid) {
    const int lane = opaque_i(lane_id()), tid = wid * 64 + lane, wr = wid >> 2, wc = wid & 3, fr = lane & 15, fq = lane >> 4;
    const int nt = K / BK;
    unsigned voffA[2], voffB[2];
#pragma unroll
    for (int i = 0; i < 2; ++i) { int R, C; stage_rc(tid * 16 + i * 8192, R, C); const int Rb = (R & ~31) + perm32(R & 31);
        voffA[i] = (unsigned)(R * K + C) * 2u; voffB[i] = (unsigned)(Rb * K + C) * 2u; }
    const size_t kstep = (size_t)(BK * 2);
    const size_t hstep = (size_t)HALF * K * 2;
    const unsigned ldsw = (unsigned)wid * 1024u;
    const int aoff = lds_byte(wr * 64 + fr, fq * 8), boff = lds_byte(wc * 32 + fr, fq * 8);
#define PG8_SA(b, h) (((b) * 2 + (h)) * HTB)
#define PG8_SB(b, h) ((4 + (b) * 2 + (h)) * HTB)
#define PG8_STAGE(bufoff, gbase, voff) do { _Pragma("unroll") for (int _i = 0; _i < 2; ++_i) \
        __builtin_amdgcn_global_load_lds((const unsigned*)((const char*)(gbase) + (voff)[_i]), (LAS unsigned*)(lds + (bufoff) + ldsw + _i * 8192), 16, 0, 0); } while (0)
#define PG8_LDA(dst, b, h) do { _Pragma("unroll") for (int m = 0; m < 4; ++m) _Pragma("unroll") for (int k = 0; k < 2; ++k) dst[m][k] = *(const LAS bf16x8*)(lds + PG8_SA(b, h) + aoff + m * 2048 + k * 1024); } while (0)
#define PG8_LDB(dst, b, h) do { _Pragma("unroll") for (int n = 0; n < 2; ++n) _Pragma("unroll") for (int k = 0; k < 2; ++k) dst[n][k] = *(const LAS bf16x8*)(lds + PG8_SB(b, h) + boff + n * 2048 + k * 1024); } while (0)
#define PG8_MMA(ai, bj, At, Bt) do { __builtin_amdgcn_s_setprio(1); _Pragma("unroll") for (int m = 0; m < 4; ++m) _Pragma("unroll") for (int n = 0; n < 2; ++n) _Pragma("unroll") for (int k = 0; k < 2; ++k) \
        acc[ai][bj][m][n] = __builtin_amdgcn_mfma_f32_16x16x32_bf16(Bt[n][k], At[m][k], acc[ai][bj][m][n], 0, 0, 0); __builtin_amdgcn_s_setprio(0); } while (0)
#define PG8_WAIT_V(n) asm volatile("s_waitcnt vmcnt(" #n ")" ::: "memory")
#define PG8_WAIT_L(n) asm volatile("s_waitcnt lgkmcnt(" #n ")" ::: "memory")
#define PG8_BAR __builtin_amdgcn_s_barrier()
#define PG8_SCHED __builtin_amdgcn_sched_barrier(0)
    Unit cur, nxt; int ui = 0;
    if (!S.next(0, cur)) return;
    f32x4 acc[2][2][4][2];
#pragma unroll
    for (int a = 0; a < 2; ++a)
#pragma unroll
        for (int b = 0; b < 2; ++b)
#pragma unroll
            for (int m = 0; m < 4; ++m)
#pragma unroll
                for (int n = 0; n < 2; ++n) acc[a][b][m][n] = (f32x4){0.f, 0.f, 0.f, 0.f};
    bf16x8 At[4][2], B0[2][2], B1[2][2];
    const char* cA = cur.A; const char* cB = cur.B;
    PG8_STAGE(PG8_SB(0, 0), cB, voffB); PG8_STAGE(PG8_SB(0, 1), cB + hstep, voffB); PG8_STAGE(PG8_SA(0, 0), cA, voffA); PG8_STAGE(PG8_SA(0, 1), cA + hstep, voffA);
    if (wr == 1) PG8_BAR;
    PG8_WAIT_V(2); PG8_BAR;
    PG8_STAGE(PG8_SB(1, 0), cB + kstep, voffB); PG8_STAGE(PG8_SA(1, 0), cA + kstep, voffA); PG8_STAGE(PG8_SB(1, 1), cB + hstep + kstep, voffB);
    PG8_WAIT_V(6); PG8_BAR;
    for (;;) {
        const bool has_next = S.next(ui + 1, nxt);
        const char* nA = has_next ? nxt.A : cA; const char* nB = has_next ? nxt.B : cB;
#pragma unroll 1
        for (int t = 0; t < nt; t += 2) {
            const bool last = (t == nt - 2);
            const char* a1 = cA + (size_t)(t + 1) * kstep;
            const char* a2 = last ? nA : cA + (size_t)(t + 2) * kstep; const char* b2 = last ? nB : cB + (size_t)(t + 2) * kstep;
            const char* a3 = a2 + kstep; const char* b3 = b2 + kstep;
            PG8_LDB(B0, 0, 0); PG8_LDB(B1, 0, 1); PG8_SCHED; PG8_LDA(At, 0, 0); PG8_STAGE(PG8_SA(1, 1), a1 + hstep, voffA);
            PG8_WAIT_V(8); PG8_WAIT_L(0); PG8_BAR; PG8_MMA(0, 0, At, B0); PG8_MMA(0, 1, At, B1); PG8_BAR; PG8_SCHED;
            PG8_LDA(At, 0, 1); PG8_STAGE(PG8_SB(0, 0), b2, voffB); PG8_STAGE(PG8_SB(0, 1), b2 + hstep, voffB); PG8_STAGE(PG8_SA(0, 0), a2, voffA);
            PG8_WAIT_V(8); PG8_WAIT_L(0); PG8_BAR; PG8_MMA(1, 0, At, B0); PG8_MMA(1, 1, At, B1); PG8_BAR; PG8_SCHED;
            PG8_LDB(B0, 1, 0); PG8_LDB(B1, 1, 1); PG8_SCHED; PG8_LDA(At, 1, 0); PG8_STAGE(PG8_SA(0, 1), a2 + hstep, voffA);
            PG8_WAIT_V(8); PG8_WAIT_L(0); PG8_BAR; PG8_MMA(0, 0, At, B0); PG8_MMA(0, 1, At, B1); PG8_BAR; PG8_SCHED;
            PG8_LDA(At, 1, 1); PG8_STAGE(PG8_SB(1, 0), b3, voffB); PG8_STAGE(PG8_SB(1, 1), b3 + hstep, voffB); PG8_STAGE(PG8_SA(1, 0), a3, voffA);
            PG8_WAIT_V(8); PG8_WAIT_L(0); PG8_BAR; PG8_MMA(1, 0, At, B0); PG8_MMA(1, 1, At, B1); PG8_BAR; PG8_SCHED;
        }
        if (wr == 0) PG8_BAR;
        const bool keep = E(acc, cur, wr, wc, fr, fq);
        if (!has_next) break;
        if (!keep) {
#pragma unroll
            for (int a = 0; a < 2; ++a)
#pragma unroll
                for (int b = 0; b < 2; ++b)
#pragma unroll
                    for (int m = 0; m < 4; ++m)
#pragma unroll
                        for (int n = 0; n < 2; ++n) acc[a][b][m][n] = (f32x4){0.f, 0.f, 0.f, 0.f};
        }
        cur = nxt; cA = nA; cB = nB; ++ui;
        if (wr == 1) PG8_BAR;
    }
    PG8_WAIT_V(0);
    PG8_BAR;
#undef PG8_SA
#undef PG8_SB
#undef PG8_STAGE
#undef PG8_LDA
#undef PG8_LDB
#undef PG8_MMA
#undef PG8_WAIT_V
#undef PG8_WAIT_L
#undef PG8_BAR
#undef PG8_SCHED
}
}

struct Params {
    const float* x; const float* g_norm1; const float* w_in; const float* g_cq; const float* w_uq; const float* w_qidx; const float* lb_logits; const float* g_hnorm;
    const float* w_pa; const float* w_pb; const float* w_o; const float* g_norm2; const float* w_grp; const float* b_grp; const float* w_exp; const float* b_exp;
    const float* w_gate; const float* w_up; const float* w_down; const float* g_final;
    float* out; unsigned char* ws;
};

struct SchedDense {
    const char* A; const char* Bt; int nM, nN, G, c; size_t tstep;
    __device__ __forceinline__ bool next(int i, pg8::Unit& u) const {
        int pm, pn; if (!pg8::static_tile((long)i * G + c, nM, nN, pm, pn)) return false;
        u.pm = pm; u.pn = pn; u.aux = 0; u.A = A + (size_t)pm * tstep; u.B = Bt + (size_t)pn * tstep; return true;
    }
};
struct SchedMerged {
    const char* A0; const char* A1; const char* B0; const char* B1; int nM, nN, G, c; size_t tstep;
    __device__ __forceinline__ bool next(int i, pg8::Unit& u) const {
        int pm, pn; if (!pg8::static_tile((long)(i >> 1) * G + c, nM, nN, pm, pn)) return false;
        const int part = i & 1; u.pm = pm; u.pn = pn; u.aux = part;
        u.A = (part ? A1 : A0) + (size_t)pm * tstep; u.B = (part ? B1 : B0) + (size_t)pn * tstep; return true;
    }
};
struct SchedMoe {
    const char* A; const char* Bt; const int* tile_e; int ntiles, NCT, G, c; size_t tstep;
    __device__ __forceinline__ bool next(int i, pg8::Unit& u) const {
        const long L = (long)i * G + c; if (L >= (long)ntiles * NCT) return false;
        const int rt = (int)(L / NCT), ct = (int)(L % NCT); const int e = __builtin_amdgcn_readfirstlane(tile_e[rt]);
        u.pm = rt; u.pn = ct; u.aux = e; u.A = A + (size_t)rt * tstep; u.B = Bt + ((size_t)e * NCT + ct) * tstep; return true;
    }
};

typedef f32x4 Acc[2][2][4][2];
#define EPI_ROWS_BEGIN _Pragma("unroll") for (int ai = 0; ai < 2; ++ai) _Pragma("unroll") for (int m = 0; m < 4; ++m) { const int r = row0 + ai * 128 + m * 16;
#define EPI_ROWS_END }

struct EpiIn {
    unsigned char* ws; const float* rstd1; const float* lb; const float* ctab; const float* stab;
    __device__ __forceinline__ bool operator()(Acc& acc, const pg8::Unit& u, int wr, int wc, int fr, int fq) const {
        const int row0 = u.pm * 256 + wr * 64 + fr; const int colp = wc * 32 + 8 * fq; const int T = u.pn;
        if (T < 2) {
            bf16_t* cq = (bf16_t*)(ws + WS_CQ); float* part = (float*)(ws + WS_SSQCQ);
            EPI_ROWS_BEGIN { const float rs = rstd1[r]; float s = 0.f;
#pragma unroll
                for (int bj = 0; bj < 2; ++bj) { const f32x4 v0 = acc[ai][bj][m][0] * rs, v1 = acc[ai][bj][m][1] * rs;
                    s += (v0[0] * v0[0] + v0[1] * v0[1]) + (v0[2] * v0[2] + v0[3] * v0[3]) + (v1[0] * v1[0] + v1[1] * v1[1]) + (v1[2] * v1[2] + v1[3] * v1[3]);
                    u32x4 w; w.x = pk2(v0[0], v0[1]); w.y = pk2(v0[2], v0[3]); w.z = pk2(v1[0], v1[1]); w.w = pk2(v1[2], v1[3]);
                    *(u32x4*)(cq + (size_t)r * QR + T * 256 + bj * 128 + colp) = w; }
                s += shx(s, 16, fq * 16 + fr); s += shx(s, 32, fq * 16 + fr);
                if (fq == 0) part[(size_t)r * 8 + T * 4 + wc] = s; } EPI_ROWS_END
        } else if (T == 2) {
            bf16_t* dst = (bf16_t*)(ws + (wc >= 2 ? WS_KIR : WS_KR)); const int c = (colp & 63);
            EPI_ROWS_BEGIN { const float rs = rstd1[r]; const int pos = r & (SEQ - 1);
                const f32x4 c0 = *(const f32x4*)(ctab + pos * 64 + c), c1 = *(const f32x4*)(ctab + pos * 64 + c + 4), s0 = *(const f32x4*)(stab + pos * 64 + c), s1 = *(const f32x4*)(stab + pos * 64 + c + 4);
                const f32x4 a0 = acc[ai][0][m][0] * rs, a1 = acc[ai][0][m][1] * rs, b0 = acc[ai][1][m][0] * rs, b1 = acc[ai][1][m][1] * rs;
                const f32x4 o0 = a0 * c0 - b0 * s0, o1 = a1 * c1 - b1 * s1, p0 = b0 * c0 + a0 * s0, p1 = b1 * c1 + a1 * s1;
                u32x4 w; w.x = pk2(o0[0], o0[1]); w.y = pk2(o0[2], o0[3]); w.z = pk2(o1[0], o1[1]); w.w = pk2(o1[2], o1[3]);
                *(u32x4*)(dst + (size_t)r * 128 + c) = w;
                w.x = pk2(p0[0], p0[1]); w.y = pk2(p0[2], p0[3]); w.z = pk2(p1[0], p1[1]); w.w = pk2(p1[2], p1[3]);
                *(u32x4*)(dst + (size_t)r * 128 + 64 + c) = w; } EPI_ROWS_END
        } else if (T == 3) {
            bf16_t* vv = (bf16_t*)(ws + WS_VV); float* wi = (float*)(ws + WS_WI);
            EPI_ROWS_BEGIN { const float rs = rstd1[r];
                const f32x4 v0 = acc[ai][0][m][0] * rs, v1 = acc[ai][0][m][1] * rs;
                u32x4 w; w.x = pk2(v0[0], v0[1]); w.y = pk2(v0[2], v0[3]); w.z = pk2(v1[0], v1[1]); w.w = pk2(v1[2], v1[3]);
                *(u32x4*)(vv + (size_t)r * 128 + colp) = w;
                if (colp < 16) { const float sc = rs * 0.02209708691207961f;
                    *(f32x4*)(wi + (size_t)r * 16 + colp) = acc[ai][1][m][0] * sc; *(f32x4*)(wi + (size_t)r * 16 + colp + 4) = acc[ai][1][m][1] * sc; } } EPI_ROWS_END
        } else if (T < 20) {
            const int seg = (T - 4) >> 2; const int cbase = ((T - 4) & 3) * 256 + colp;
            if (seg == 1) {
                float* logf = (float*)(ws + WS_LOGF);
                EPI_ROWS_BEGIN { const float rs = rstd1[r];
#pragma unroll
                    for (int bj = 0; bj < 2; ++bj) { const int cc = cbase + bj * 128;
                        const f32x4 l0 = *(const f32x4*)(lb + cc), l1 = *(const f32x4*)(lb + cc + 4);
                        f32x4 v0 = acc[ai][bj][m][0] * rs, v1 = acc[ai][bj][m][1] * rs;
#pragma unroll
                        for (int e = 0; e < 4; ++e) { v0[e] = __logf(l0[e] + (1.0f - l0[e]) * sigmoidf_(v0[e])); v1[e] = __logf(l1[e] + (1.0f - l1[e]) * sigmoidf_(v1[e])); }
                        *(f32x4*)(logf + (size_t)r * 1024 + cc) = v0; *(f32x4*)(logf + (size_t)r * 1024 + cc + 4) = v1; } } EPI_ROWS_END
            } else {
                bf16_t* dst = (bf16_t*)(ws + (seg == 0 ? WS_QT : (seg == 2 ? WS_VH : WS_SG)));
                EPI_ROWS_BEGIN { const float rs = rstd1[r];
#pragma unroll
                    for (int bj = 0; bj < 2; ++bj) { f32x4 v0 = acc[ai][bj][m][0] * rs, v1 = acc[ai][bj][m][1] * rs;
                        if (seg != 2) {
#pragma unroll
                            for (int e = 0; e < 4; ++e) { v0[e] = siluf_(v0[e]); v1[e] = siluf_(v1[e]); } }
                        u32x4 w; w.x = pk2(v0[0], v0[1]); w.y = pk2(v0[2], v0[3]); w.z = pk2(v1[0], v1[1]); w.w = pk2(v1[2], v1[3]);
                        *(u32x4*)(dst + (size_t)r * 1024 + cbase + bj * 128) = w; } } EPI_ROWS_END
            }
        } else {
            bf16_t* Rg = (bf16_t*)(ws + WS_RG); bf16_t* Sb = (bf16_t*)(ws + WS_SB); const int cc = (T - 20) * 128 + colp;
            EPI_ROWS_BEGIN { const float rs = rstd1[r];
                f32x4 a0 = acc[ai][0][m][0] * rs, a1 = acc[ai][0][m][1] * rs, b0 = acc[ai][1][m][0] * rs, b1 = acc[ai][1][m][1] * rs;
#pragma unroll
                for (int e = 0; e < 4; ++e) { const float ea0 = __expf(-a0[e]), eb0 = __expf(-b0[e]), ea1 = __expf(-a1[e]), eb1 = __expf(-b1[e]);
                    a0[e] = (1.0f + eb0) * __builtin_amdgcn_rcpf(1.0f + ea0); b0[e] = __builtin_amdgcn_rcpf(1.0f + eb0);
                    a1[e] = (1.0f + eb1) * __builtin_amdgcn_rcpf(1.0f + ea1); b1[e] = __builtin_amdgcn_rcpf(1.0f + eb1); }
                u32x4 w; w.x = pk2(a0[0], a0[1]); w.y = pk2(a0[2], a0[3]); w.z = pk2(a1[0], a1[1]); w.w = pk2(a1[2], a1[3]);
                *(u32x4*)(Rg + (size_t)r * DM + cc) = w;
                w.x = pk2(b0[0], b0[1]); w.y = pk2(b0[2], b0[3]); w.z = pk2(b1[0], b1[1]); w.w = pk2(b1[2], b1[3]);
                *(u32x4*)(Sb + (size_t)r * DM + cc) = w; } EPI_ROWS_END
        }
        return false;
    }
};

struct EpiQ {
    unsigned char* ws; const float* ctab; const float* stab;
    __device__ __forceinline__ bool operator()(Acc& acc, const pg8::Unit& u, int wr, int wc, int fr, int fq) const {
        const int row0 = u.pm * 256 + wr * 64 + fr; const int colp = wc * 32 + 8 * fq; const int T = u.pn;
        const int head = 2 * T + (colp >> 6), c = colp & 63; const float* part = (const float*)(ws + WS_SSQCQ);
        bf16_t* dst; int pitch, hh; float osc;
        if (head < 8) { dst = (bf16_t*)(ws + WS_Q); pitch = 1024; hh = head; osc = 0.08838834764831845f; } else { dst = (bf16_t*)(ws + WS_QI); pitch = 2048; hh = head - 8; osc = 1.0f; }
        EPI_ROWS_BEGIN { const f32x4 pa = *(const f32x4*)(part + (size_t)r * 8), pb = *(const f32x4*)(part + (size_t)r * 8 + 4);
            const float ssq = ((pa[0] + pa[1]) + (pa[2] + pa[3])) + ((pb[0] + pb[1]) + (pb[2] + pb[3]));
            const float rs = __builtin_amdgcn_rsqf(ssq * (1.0f / QR) + EPS) * osc; const int pos = r & (SEQ - 1);
            const f32x4 c0 = *(const f32x4*)(ctab + pos * 64 + c), c1 = *(const f32x4*)(ctab + pos * 64 + c + 4), s0 = *(const f32x4*)(stab + pos * 64 + c), s1 = *(const f32x4*)(stab + pos * 64 + c + 4);
            const f32x4 a0 = acc[ai][0][m][0] * rs, a1 = acc[ai][0][m][1] * rs, b0 = acc[ai][1][m][0] * rs, b1 = acc[ai][1][m][1] * rs;
            const f32x4 o0 = a0 * c0 - b0 * s0, o1 = a1 * c1 - b1 * s1, p0 = b0 * c0 + a0 * s0, p1 = b1 * c1 + a1 * s1;
            u32x4 w; w.x = pk2(o0[0], o0[1]); w.y = pk2(o0[2], o0[3]); w.z = pk2(o1[0], o1[1]); w.w = pk2(o1[2], o1[3]);
            *(u32x4*)(dst + (size_t)r * pitch + hh * 128 + c) = w;
            w.x = pk2(p0[0], p0[1]); w.y = pk2(p0[2], p0[3]); w.z = pk2(p1[0], p1[1]); w.w = pk2(p1[2], p1[3]);
            *(u32x4*)(dst + (size_t)r * pitch + hh * 128 + 64 + c) = w; } EPI_ROWS_END
        return false;
    }
};

struct EpiMerged {
    unsigned char* ws;
    __device__ __forceinline__ bool operator()(Acc& acc, const pg8::Unit& u, int wr, int wc, int fr, int fq) const {
        const int row0 = u.pm * 256 + wr * 64 + fr; const int colp = wc * 32 + 8 * fq;
        if (u.aux == 0) {
            const bf16_t* Rg = (const bf16_t*)(ws + WS_RG);
            EPI_ROWS_BEGIN {
#pragma unroll
                for (int bj = 0; bj < 2; ++bj) { const u32x4 w = *(const u32x4*)(Rg + (size_t)r * DM + u.pn * 256 + bj * 128 + colp);
                    acc[ai][bj][m][0] *= (f32x4){bf2f(w.x & 0xffffu), bf2f(w.x >> 16), bf2f(w.y & 0xffffu), bf2f(w.y >> 16)};
                    acc[ai][bj][m][1] *= (f32x4){bf2f(w.z & 0xffffu), bf2f(w.z >> 16), bf2f(w.w & 0xffffu), bf2f(w.w >> 16)}; } } EPI_ROWS_END
            return true;
        }
        const bf16_t* Sb = (const bf16_t*)(ws + WS_SB); bf16_t* mg = (bf16_t*)(ws + WS_MERGED);
        EPI_ROWS_BEGIN {
#pragma unroll
            for (int bj = 0; bj < 2; ++bj) { const size_t o = (size_t)r * DM + u.pn * 256 + bj * 128 + colp; const u32x4 w = *(const u32x4*)(Sb + o);
                const f32x4 v0 = acc[ai][bj][m][0] * (f32x4){bf2f(w.x & 0xffffu), bf2f(w.x >> 16), bf2f(w.y & 0xffffu), bf2f(w.y >> 16)};
                const f32x4 v1 = acc[ai][bj][m][1] * (f32x4){bf2f(w.z & 0xffffu), bf2f(w.z >> 16), bf2f(w.w & 0xffffu), bf2f(w.w >> 16)};
                u32x4 q; q.x = pk2(v0[0], v0[1]); q.y = pk2(v0[2], v0[3]); q.z = pk2(v1[0], v1[1]); q.w = pk2(v1[2], v1[3]);
                *(u32x4*)(mg + o) = q; } } EPI_ROWS_END
        return false;
    }
};

struct EpiX1 {
    unsigned char* ws; const float* x; float* x1;
    __device__ __forceinline__ bool operator()(Acc& acc, const pg8::Unit& u, int wr, int wc, int fr, int fq) const {
        const int row0 = u.pm * 256 + wr * 64 + fr; const int colp = wc * 32 + 8 * fq;
        bf16_t* x1b = (bf16_t*)(ws + WS_X1B); float* part = (float*)(ws + WS_SSQ2);
        EPI_ROWS_BEGIN { float s = 0.f;
#pragma unroll
            for (int bj = 0; bj < 2; ++bj) { const size_t o = (size_t)r * DM + u.pn * 256 + bj * 128 + colp;
                const f32x4 v0 = acc[ai][bj][m][0] + *(const f32x4*)(x + o), v1 = acc[ai][bj][m][1] + *(const f32x4*)(x + o + 4);
                s += (v0[0] * v0[0] + v0[1] * v0[1]) + (v0[2] * v0[2] + v0[3] * v0[3]) + (v1[0] * v1[0] + v1[1] * v1[1]) + (v1[2] * v1[2] + v1[3] * v1[3]);
                u32x4 w; w.x = pk2(v0[0], v0[1]); w.y = pk2(v0[2], v0[3]); w.z = pk2(v1[0], v1[1]); w.w = pk2(v1[2], v1[3]);
                *(u32x4*)(x1b + o) = w; }
            s += shx(s, 16, fq * 16 + fr); s += shx(s, 32, fq * 16 + fr);
            if (fq == 0) part[(size_t)r * 32 + u.pn * 4 + wc] = s; } EPI_ROWS_END
        return false;
    }
};

struct EpiGateUp {
    unsigned char* ws;
    __device__ __forceinline__ bool operator()(Acc& acc, const pg8::Unit& u, int wr, int wc, int fr, int fq) const {
        const int row0 = u.pm * 256 + wr * 64 + fr; const int colp = wc * 32 + 8 * fq;
        const float* rss = (const float*)(ws + WS_RSS); bf16_t* act = (bf16_t*)(ws + WS_ACT);
        EPI_ROWS_BEGIN { const float rs = rss[r];
            f32x4 a0 = acc[ai][0][m][0] * rs, a1 = acc[ai][0][m][1] * rs; const f32x4 u0 = acc[ai][1][m][0] * rs, u1 = acc[ai][1][m][1] * rs;
#pragma unroll
            for (int e = 0; e < 4; ++e) { a0[e] = siluf_(a0[e]) * u0[e]; a1[e] = siluf_(a1[e]) * u1[e]; }
            u32x4 w; w.x = pk2(a0[0], a0[1]); w.y = pk2(a0[2], a0[3]); w.z = pk2(a1[0], a1[1]); w.w = pk2(a1[2], a1[3]);
            *(u32x4*)(act + (size_t)r * DEXP + u.pn * 128 + colp) = w; } EPI_ROWS_END
        return false;
    }
};

struct EpiDown {
    unsigned char* ws;
    __device__ __forceinline__ bool operator()(Acc& acc, const pg8::Unit& u, int wr, int wc, int fr, int fq) const {
        const int row0 = u.pm * 256 + wr * 64 + fr; const int colp = wc * 32 + 8 * fq;
        const float* gs = (const float*)(ws + WS_GS); bf16_t* ys = (bf16_t*)(ws + WS_YS);
        EPI_ROWS_BEGIN { const float g = gs[r];
#pragma unroll
            for (int bj = 0; bj < 2; ++bj) { const f32x4 v0 = acc[ai][bj][m][0] * g, v1 = acc[ai][bj][m][1] * g;
                u32x4 w; w.x = pk2(v0[0], v0[1]); w.y = pk2(v0[2], v0[3]); w.z = pk2(v1[0], v1[1]); w.w = pk2(v1[2], v1[3]);
                *(u32x4*)(ys + (size_t)r * DM + u.pn * 256 + bj * 128 + colp) = w; } } EPI_ROWS_END
        return false;
    }
};

struct EpiNull {
    __device__ __forceinline__ bool operator()(Acc& acc, const pg8::Unit& u, int wr, int wc, int fr, int fq) const {
#pragma unroll
        for (int ai = 0; ai < 2; ++ai)
#pragma unroll
            for (int bj = 0; bj < 2; ++bj)
#pragma unroll
                for (int m = 0; m < 4; ++m)
#pragma unroll
                    for (int n = 0; n < 2; ++n) asm volatile("" :: "v"(acc[ai][bj][m][n]));
        return false;
    }
};

struct Frame { LAS unsigned char* lds; int tid, lane, wave, G, gw, NGW; };
__device__ __forceinline__ Frame make_frame(LAS unsigned char* lds, int wave) { Frame F; F.lds = lds; F.lane = opaque_i(lane_id()); F.wave = wave; F.tid = wave * 64 + F.lane; F.G = gridDim.x; F.gw = blockIdx.x * 8 + F.wave; F.NGW = F.G * 8; return F; }
constexpr int LDS_PHASE_BYTES = 147456;
constexpr int LDS_BYTES = LDS_PHASE_BYTES + 256;

#define XB_TMO      128
#define XB_XCNT(j)  (256  + 64 * (j))
#define XB_XSUB(j)  (1280 + 64 * (j))
#define XB_XGEN(j)  (2304 + 64 * (j))
#define XB_TOP      3328
#define XB_TOPGEN   3392
#define XCD_BAR_WORDS 3456
#define XB_SPIN_CAP (1u << 22)
__device__ __forceinline__ unsigned xb_ld(unsigned* p)              { return __hip_atomic_load(p, __ATOMIC_RELAXED, __HIP_MEMORY_SCOPE_AGENT); }
__device__ __forceinline__ unsigned xb_add(unsigned* p, unsigned v) { return __hip_atomic_fetch_add(p, v, __ATOMIC_RELAXED, __HIP_MEMORY_SCOPE_AGENT); }
__device__ __forceinline__ unsigned xb_xcc_id() { return (unsigned)__builtin_amdgcn_s_getreg((3 << 11) | 20) & 0xFu; }
#define XB_SPIN(cond, bar) do { unsigned _sp = 0; while (cond) { __builtin_amdgcn_s_sleep(1); \
    if ((++_sp & 255u) == 0u) { if (xb_ld(&(bar)[XB_TMO])) break; if (_sp > XB_SPIN_CAP) { atomicAdd(&(bar)[XB_TMO], 1u); break; } } } } while (0)
struct XcdBarrier { unsigned* bar; unsigned x; volatile LAS unsigned* st; int wave; };
__device__ __forceinline__ XcdBarrier xcd_barrier_post(unsigned* bar, volatile LAS unsigned* st, int wave) {
    XcdBarrier b; b.bar = bar; b.x = xb_xcc_id(); b.st = st; b.wave = wave;
    if (wave == 0 && lane_id() == 0) (void)xb_add(&bar[XB_XCNT(b.x)], 1u);
    return b;
}
__device__ __forceinline__ void xcd_barrier_complete(unsigned* bar, unsigned x, unsigned& nloc, unsigned& nx) {
    const unsigned G = gridDim.x * gridDim.y * gridDim.z;
    unsigned sum, cnt, mine, sp = 0u;
    for (;;) {
        sum = 0u; cnt = 0u; mine = 0u;
#pragma unroll
        for (unsigned j = 0; j < 16; ++j) { const unsigned c = xb_ld(&bar[XB_XCNT(j)]); sum += c; cnt += (c > 0u) ? 1u : 0u; mine = (j == x) ? c : mine; }
        if (sum == G) break;
        __builtin_amdgcn_s_sleep(1);
        if ((++sp & 255u) == 0u) { if (xb_ld(&bar[XB_TMO])) break; if (sp > XB_SPIN_CAP) { atomicAdd(&bar[XB_TMO], 1u); break; } }
    }
    nloc = mine > 0u ? mine : 1u; nx = cnt > 0u ? cnt : 1u;
}
__device__ __forceinline__ void xcd_barrier(const XcdBarrier& b) {
    asm volatile("s_waitcnt vmcnt(0)" ::: "memory");
    __syncthreads();
    if (b.wave == 0 && lane_id() == 0) {
        unsigned* bar = b.bar;
        __builtin_amdgcn_s_waitcnt(0);
        unsigned nloc = b.st[0], nx = b.st[1];
        if (nloc == 0u) { xcd_barrier_complete(bar, b.x, nloc, nx); b.st[0] = nloc; b.st[1] = nx; }
        const unsigned old = xb_add(&bar[XB_XSUB(b.x)], 1u);
        const unsigned gen = old / nloc;
        if (old + 1u == (gen + 1u) * nloc) {
            __builtin_amdgcn_fence(__ATOMIC_RELEASE, "agent");
            asm volatile("s_waitcnt vmcnt(0)" ::: "memory");
            const unsigned og = xb_add(&bar[XB_TOP], 1u);
            const unsigned tg = og / nx;
            if (og + 1u == (tg + 1u) * nx) xb_add(&bar[XB_TOPGEN], 1u);
            else XB_SPIN(xb_ld(&bar[XB_TOPGEN]) == tg, bar);
            __builtin_amdgcn_fence(__ATOMIC_ACQUIRE, "agent");
            xb_add(&bar[XB_XGEN(b.x)], 1u);
            asm volatile("s_waitcnt vmcnt(0)" ::: "memory");
        } else {
            XB_SPIN(xb_ld(&bar[XB_XGEN(b.x)]) == gen, bar);
            __builtin_amdgcn_fence(__ATOMIC_ACQUIRE, "agent");
            asm volatile("s_waitcnt vmcnt(0)" ::: "memory");
        }
    }
    __syncthreads();
}

typedef short s16x4 __attribute__((ext_vector_type(4)));
__device__ __forceinline__ void tr_item(const float* src, int ld, int c0, int nvalid, const float* gain, bf16_t* dst, int Kd, int r0, int k0, LAS unsigned char* scr, int lane) {
    const int lg = lane >> 4, li = lane & 15;
    const bool ok = (4 * li) < nvalid;
    f32x4 v[16];
#pragma unroll
    for (int i = 0; i < 16; ++i) { const int k = 4 * i + lg; v[i] = ok ? *(const f32x4*)(src + (size_t)(k0 + k) * ld + c0 + 4 * li) : (f32x4){0.f, 0.f, 0.f, 0.f}; }
    if (gain) {
#pragma unroll
        for (int i = 0; i < 16; ++i) v[i] *= gain[k0 + 4 * i + lg]; }
#pragma unroll
    for (int i = 0; i < 16; ++i) { const int k = 4 * i + lg; u32x2 w; w.x = pk2(v[i][0], v[i][1]); w.y = pk2(v[i][2], v[i][3]);
        *(LAS u32x2*)(scr + k * 128 + ((((li >> 2) ^ (k & 3) ^ ((k >> 3) & 1)) << 5) | ((li & 3) * 8))) = w; }
    LDS_WAIT(); asm volatile("" ::: "memory");
    const int q = li >> 2, p = li & 3;
#pragma unroll
    for (int nb = 0; nb < 4; ++nb)
#pragma unroll
        for (int ch = 0; ch < 2; ++ch) { const int c = 4 * ch + lg; const int ka = 8 * c + q, kb = ka + 4;
            const s16x4 lo = __builtin_amdgcn_ds_read_tr16_b64_v4i16((LAS s16x4*)(scr + ka * 128 + ((nb ^ (ka & 3) ^ ((ka >> 3) & 1)) << 5) + 8 * p));
            const s16x4 hi = __builtin_amdgcn_ds_read_tr16_b64_v4i16((LAS s16x4*)(scr + kb * 128 + ((nb ^ (kb & 3) ^ ((kb >> 3) & 1)) << 5) + 8 * p));
            const u32x2 l2 = __builtin_bit_cast(u32x2, lo), h2 = __builtin_bit_cast(u32x2, hi); u32x4 o; o.x = l2.x; o.y = l2.y; o.z = h2.x; o.w = h2.y;
            *(u32x4*)(dst + (size_t)(r0 + 16 * nb + li) * Kd + k0 + 8 * c) = o; }
    LDS_WAIT(); asm volatile("" ::: "memory");
}
__device__ __forceinline__ void map_in(int G64, int& src0, int& nv) {
    nv = 64;
    if (G64 < 8) { src0 = 64 * G64; }
    else if (G64 < 12) { src0 = (G64 == 8) ? 512 : (G64 == 9) ? 768 : (G64 == 10) ? 576 : 832; }
    else if (G64 < 14) { src0 = 640 + 64 * (G64 - 12); }
    else if (G64 == 14) { src0 = 896; nv = 16; }
    else if (G64 == 15) { src0 = 0; nv = 0; }
    else if (G64 < 80) { src0 = 912 + 64 * (G64 - 16); }
    else { const int q = 64 * (G64 - 80); const int j = q >> 8, bj = (q >> 7) & 1, pos0 = q & 127; src0 = (bj ? 7056 : 5008) + 128 * j + pos0; }
}
__device__ __forceinline__ void sincos_d(float angf, float& c, float& s) {
    const double x = (double)angf; const double n = rint(x * 0.63661977236758134308);
    double r = fma(-n, 1.57079632679489655800e+00, x); r = fma(-n, 6.12323399573676603587e-17, r);
    const double r2 = r * r;
    double sp = 1.0 / 6227020800.0; sp = fma(sp, r2, -1.0 / 39916800.0); sp = fma(sp, r2, 1.0 / 362880.0); sp = fma(sp, r2, -1.0 / 5040.0); sp = fma(sp, r2, 1.0 / 120.0); sp = fma(sp, r2, -1.0 / 6.0);
    const double sn = fma(r * r2, sp, r);
    double cp = -1.0 / 87178291200.0; cp = fma(cp, r2, 1.0 / 479001600.0); cp = fma(cp, r2, -1.0 / 3628800.0); cp = fma(cp, r2, 1.0 / 40320.0); cp = fma(cp, r2, -1.0 / 720.0); cp = fma(cp, r2, 1.0 / 24.0); cp = fma(cp, r2, -0.5);
    const double cs = fma(r2, cp, 1.0);
    const int q = ((int)n) & 3;
    const double cc = (q == 0) ? cs : (q == 1) ? -sn : (q == 2) ? -cs : sn;
    const double ss = (q == 0) ? sn : (q == 1) ? cs : (q == 2) ? -sn : -cs;
    c = (float)cc; s = (float)ss;
}
__device__ __forceinline__ void p0_prep(const Frame& F, const Params& P) {
    unsigned char* ws = P.ws;
    LAS unsigned char* scr = F.lds + F.wave * 16384;
    const int gtid = blockIdx.x * 512 + F.tid, GT = F.G * 512;
    if (gtid < 1024) ((int*)(ws + WS_CTL))[gtid] = 0;
    if (gtid < 1024) ((float*)(ws + WS_LB))[gtid] = 1.0f / (1.0f + expf(P.lb_logits[1024 + gtid] - P.lb_logits[gtid]));
    for (int i = gtid; i < SEQ * 64; i += GT) { const int pos = i >> 6, j = i & 63;
        const float inv = (float)(1.0 / pow(10000.0, (double)(2 * j) / 128.0)); const float ang = (float)pos * inv; float c, s; sincos_d(ang, c, s);
        ((float*)(ws + WS_COS))[i] = c; ((float*)(ws + WS_SIN))[i] = s; }
    for (int i = gtid; i < 48 * DM; i += GT) { const int j = i / DM, k = i % DM;
        const float v = (j < 4) ? P.w_grp[k * 4 + j] : (j < 36) ? P.w_exp[k * 32 + (j - 4)] : 0.f;
        ((bf16_t*)(ws + WS_WRT))[i] = (bf16_t)f2bf(v * P.g_norm2[k]); }
    constexpr int I_IN = 32 * 144;
    for (int it = F.gw; it < I_IN; it += F.NGW) { const int kb = it / 144, nb = it % 144; int src0, nv; map_in(nb, src0, nv);
        tr_item(P.w_in, DIN, src0, nv, P.g_norm1, (bf16_t*)(ws + WS_WTIN), DM, 64 * nb, 64 * kb, scr, F.lane); }
    for (int m = F.gw; m < NTOK; m += F.NGW) {
        const f32x4* xr = (const f32x4*)(P.x + (size_t)m * DM) + F.lane; f32x4 v[8]; float s = 0.f;
#pragma unroll
        for (int j = 0; j < 8; ++j) { v[j] = xr[64 * j]; s += (v[j][0] * v[j][0] + v[j][1] * v[j][1]) + (v[j][2] * v[j][2] + v[j][3] * v[j][3]); }
        s = wave_sum(s, F.lane);
        if (F.lane == 0) ((float*)(ws + WS_RSTD1))[m] = 1.0f / sqrtf(s * (1.0f / DM) + EPS);
        u32x2* o = (u32x2*)((bf16_t*)(ws + WS_XB) + (size_t)m * DM) + F.lane;
#pragma unroll
        for (int j = 0; j < 8; ++j) { u32x2 w; w.x = pk2(v[j][0], v[j][1]); w.y = pk2(v[j][2], v[j][3]); o[64 * j] = w; }
    }
}
__device__ __forceinline__ void conv_gateup(const Frame& F, const Params& P, int lo, int hi) {
    LAS unsigned char* scr = F.lds + F.wave * 16384;
    for (int it = lo + F.gw; it < hi; it += F.NGW) { const int e = it >> 9, r = it & 511, kb = r >> 4, nb = r & 15;
        const int p0 = 64 * nb, T = p0 >> 8, bj = (p0 >> 7) & 1, pos = p0 & 127, col = 128 * T + pos;
        tr_item((bj ? P.w_up : P.w_gate) + (size_t)e * DM * DEXP, DEXP, col, 64, P.g_norm2, (bf16_t*)(P.ws + WS_WGUT) + (size_t)e * 1024 * DM, DM, p0, 64 * kb, scr, F.lane); }
}
__device__ __forceinline__ void conv_down(const Frame& F, const Params& P, int lo, int hi) {
    LAS unsigned char* scr = F.lds + F.wave * 16384;
    for (int it = lo + F.gw; it < hi; it += F.NGW) { const int e = it >> 8, r = it & 255, kb = r >> 5, nb = r & 31;
        tr_item(P.w_down + (size_t)e * DEXP * DM, DM, 64 * nb, 64, nullptr, (bf16_t*)(P.ws + WS_WDT) + (size_t)e * DM * DEXP, DEXP, 64 * nb, 64 * kb, scr, F.lane); }
}

__device__ __forceinline__ void conv_small(const Frame& F, const Params& P, int lo, int hi) {
    unsigned char* ws = P.ws; LAS unsigned char* scr = F.lds + F.wave * 16384;
    constexpr int I_QQ = 8 * 48, I_PA = 16 * 32, I_O = 32 * 32, NIT = I_QQ + 2 * I_PA + I_O;
    for (int it = lo + F.gw; it < hi && it < NIT; it += F.NGW) {
        int r = it;
        if (r < I_QQ) { const int kb = r / 48, nb = r % 48; const int p0 = 64 * nb, T = p0 >> 8, bj = (p0 >> 7) & 1, pos = p0 & 127, head = 2 * T + (pos >> 6), col = (pos & 63) + 64 * bj;
            if (head < 8) tr_item(P.w_uq, 1024, head * 128 + col, 64, P.g_cq, (bf16_t*)(ws + WS_WTQQ), QR, p0, 64 * kb, scr, F.lane);
            else tr_item(P.w_qidx, 2048, (head - 8) * 128 + col, 64, P.g_cq, (bf16_t*)(ws + WS_WTQQ), QR, p0, 64 * kb, scr, F.lane);
            continue; } r -= I_QQ;
        if (r < I_PA) { const int kb = r / 32, nb = r % 32; tr_item(P.w_pa, DM, 64 * nb, 64, nullptr, (bf16_t*)(ws + WS_WTPA), 1024, 64 * nb, 64 * kb, scr, F.lane); continue; } r -= I_PA;
        if (r < I_PA) { const int kb = r / 32, nb = r % 32; tr_item(P.w_pb, DM, 64 * nb, 64, nullptr, (bf16_t*)(ws + WS_WTPB), 1024, 64 * nb, 64 * kb, scr, F.lane); continue; } r -= I_PA;
        { const int kb = r / 32, nb = r % 32; tr_item(P.w_o, DM, 64 * nb, 64, nullptr, (bf16_t*)(ws + WS_WTO), DM, 64 * nb, 64 * kb, scr, F.lane); }
    }
}

__device__ __forceinline__ unsigned key16(unsigned u) { return (u & 0x8000u) ? (~u & 0xffffu) : (u | 0x8000u); }
__device__ __forceinline__ void p3_task(const Frame& F, const Params& P, int b, int blk, bool do_sel) {
    unsigned char* ws = P.ws; LAS unsigned char* lds = F.lds;
    const bf16_t* qi = (const bf16_t*)(ws + WS_QI); const bf16_t* kir = (const bf16_t*)(ws + WS_KIR); const float* wi = (const float*)(ws + WS_WI);
    unsigned short* sel = (unsigned short*)(ws + WS_SEL); int* nsel = (int*)(ws + WS_NSEL);
    const int lane = F.lane, w = F.wave, tid = F.tid; const int t0 = 16 * blk; const int hb = lane >> 5, r = lane & 31;
    LAS _Float16* sc = (LAS _Float16*)lds;
    LAS unsigned char* kb = lds + 131072;
    bf16x8 af[8];
    { const size_t tokA = (size_t)b * SEQ + t0 + 2 * w + ((r >> 2) & 1); const int head = (r & 3) + 4 * (r >> 3); const bf16_t* p = qi + (tokA * 16 + head) * 128 + 8 * hb;
#pragma unroll
      for (int s = 0; s < 8; ++s) af[s] = *(const bf16x8*)(p + 16 * s); }
    float wreg[16];
    { const float* p = wi + ((size_t)b * SEQ + t0 + 2 * w + hb) * 16;
#pragma unroll
      for (int q = 0; q < 4; ++q) { const f32x4 v = *(const f32x4*)(p + 4 * q); wreg[4 * q] = v[0]; wreg[4 * q + 1] = v[1]; wreg[4 * q + 2] = v[2]; wreg[4 * q + 3] = v[3]; } }
    const int ntiles = (t0 + 16 + 31) >> 5;
    const int skey = tid >> 4, schunk = tid & 15; const unsigned soff = (unsigned)(skey * 256 + ((schunk ^ (skey & 15)) * 16));
    const unsigned kgo = (unsigned)WS_KIR + (((unsigned)b * SEQ + skey) * 128u + 8u * schunk) * 2u;
    __syncthreads();
    u32x4 st0 = *(const u32x4*)(ws + kgo), st1 = st0, st2 = st0;
    if (1 < ntiles) st1 = *(const u32x4*)(ws + kgo + 8192u);
    if (2 < ntiles) st2 = *(const u32x4*)(ws + kgo + 16384u);
    *(LAS u32x4*)(kb + soff) = st0;
    if (3 < ntiles) st0 = *(const u32x4*)(ws + kgo + 3u * 8192u);
    bf16x8 bqA[8], bqB[8]; f32x16 accA, accB;
#pragma unroll
    for (int e = 0; e < 16; ++e) { accA[e] = 0.f; accB[e] = 0.f; }
#pragma unroll
    for (int s = 0; s < 8; ++s) { bqA[s] = (bf16x8){0, 0, 0, 0, 0, 0, 0, 0}; bqB[s] = (bf16x8){0, 0, 0, 0, 0, 0, 0, 0}; }
#define P3_EPI2(ACC, S0, SUM) { const f32x2 rl_ = (f32x2){__int_as_float(max(__float_as_int(ACC[2 * (S0)]), 0)), __int_as_float(max(__float_as_int(ACC[2 * (S0) + 1]), 0))};     \
        SUM = __builtin_elementwise_fma(rl_, (f32x2){wreg[2 * (S0)], wreg[2 * (S0) + 1]}, SUM); }
#define P3_ITER(IEXPR, BQR, BQU, ACCW, ACCE, ST) { const int i_ = (IEXPR); \
        __syncthreads(); \
        if (i_ + 1 < ntiles) *(LAS u32x4*)(kb + ((i_ + 1) & 1) * 8192 + soff) = ST; \
        { const int tl_ = (i_ + 4 < ntiles) ? (i_ + 4) : (ntiles - 1); ST = *(const u32x4*)(ws + kgo + (unsigned)tl_ * 8192u); } \
        { const int tr_ = (i_ < ntiles) ? i_ : (ntiles - 1); const LAS unsigned char* kc_ = kb + (tr_ & 1) * 8192; \
            _Pragma("unroll") for (int s = 0; s < 8; ++s) BQR[s] = *(const LAS bf16x8*)(kc_ + r * 256 + (((2 * s + hb) ^ (r & 15)) * 16)); } \
        { f32x2 s2_ = (f32x2){0.f, 0.f}; \
            _Pragma("unroll") for (int s = 0; s < 8; ++s) { \
                if (s == 0) ACCW = __builtin_amdgcn_mfma_f32_32x32x16_bf16(af[0], BQU[0], zero16, 0, 0, 0); \
                else ACCW = __builtin_amdgcn_mfma_f32_32x32x16_bf16(af[s], BQU[s], ACCW, 0, 0, 0); \
                P3_EPI2(ACCE, s, s2_) \
                __builtin_amdgcn_sched_group_barrier(0x008, 1, 0); __builtin_amdgcn_sched_group_barrier(0x002, 3, 0); } \
            if (i_ >= 2 && i_ - 2 < ntiles) sc[(2 * w + hb) * 4096 + 32 * (i_ - 2) + r] = (_Float16)(s2_[0] + s2_[1]); } \
        LDS_WAIT(); }
    f32x16 zero16;
#pragma unroll
    for (int e = 0; e < 16; ++e) zero16[e] = 0.f;
    for (int i = 0; i <= ntiles + 1; i += 6) {
        P3_ITER(i, bqA, bqB, accB, accA, st1)
        P3_ITER(i + 1, bqB, bqA, accA, accB, st2)
        P3_ITER(i + 2, bqA, bqB, accB, accA, st0)
        P3_ITER(i + 3, bqB, bqA, accA, accB, st1)
        P3_ITER(i + 4, bqA, bqB, accB, accA, st2)
        P3_ITER(i + 5, bqB, bqA, accA, accB, st0)
    }
#undef P3_ITER
#undef P3_EPI2
    if (!do_sel) return;
    typedef short s16x2 __attribute__((ext_vector_type(2)));
    for (int i = 0; i < 2; ++i) {
        const int t = t0 + 2 * w + i; const size_t tok = (size_t)b * SEQ + t; const int n = t + 1;
        unsigned short* so = sel + tok * 256;
        if (n <= 256) {
#pragma unroll
            for (int j = 0; j < 4; ++j) { const int s = 64 * j + lane; if (s < n) so[s] = (unsigned short)s; }
            if (lane == 0) nsel[tok] = n;
            continue;
        }
        LAS unsigned short* row = (LAS unsigned short*)(sc + (2 * w + i) * 4096);
        const int nceil = (n + 127) & ~127;
        for (int s = n + lane; s < nceil; s += 64) row[s] = 0xFC00u;
        LDS_WAIT(); __builtin_amdgcn_wave_barrier();
        s16x2 e[32];
#pragma unroll
        for (int j2 = 0; j2 < 32; ++j2) {
            if (128 * j2 < n) { const s16x2 u = *(const LAS s16x2*)(row + 128 * j2 + 2 * lane);
                const s16x2 m = u >> 15; const s16x2 k16 = u ^ (m | (s16x2){(short)0x8000, (short)0x8000});
                e[j2] = __builtin_bit_cast(s16x2, (__builtin_bit_cast(unsigned, k16) >> 1) & 0x7fff7fffu); }
            else e[j2] = (s16x2){0, 0};
        }
#define P3_COUNT_LT(C, OUT) { const s16x2 c2_ = (s16x2){(short)(C), (short)(C)}; s16x2 a_ = (s16x2){0, 0}; \
            _Pragma("unroll") for (int j2 = 0; j2 < 32; ++j2) { if (128 * j2 < n) a_ += (e[j2] - c2_) >> 15; } \
            OUT = -((int)a_[0] + (int)a_[1]); }
        const int nel = nceil;
        int thr = 0;
#pragma unroll 1
        for (int bit = 14; bit >= 0; --bit) { const int cand = thr | (1 << bit); int lt; P3_COUNT_LT(cand, lt);
            lt = wave_sum_i(lt, lane); if (nel - lt >= 256) thr = cand; }
        int lt0, lt1; P3_COUNT_LT(thr, lt0); P3_COUNT_LT(thr + 1, lt1);
#undef P3_COUNT_LT
        const int held = 2 * ((nceil + 127) >> 7);
        const int cgt = held - lt1, ceq = lt1 - lt0;
        int pg = cgt, pe = ceq;
#pragma unroll
        for (int o = 1; o < 64; o <<= 1) { const int a = shl_i(pg, lane - o, lane), c = shl_i(pe, lane - o, lane); if (lane >= o) { pg += a; pe += c; } }
        const int ngt = shl_i(pg, 63, lane); const int need = 256 - ngt;
        const int eqb = pe - ceq;
        const int take_eq = max(0, min(ceq, need - eqb));
        int pos = (pg - cgt) + min(eqb, need); int eqt = 0;
#pragma unroll
        for (int j2 = 0; j2 < 32; ++j2) {
            if (128 * j2 < n) {
#pragma unroll
                for (int h2 = 0; h2 < 2; ++h2) { const int k = (int)e[j2][h2];
                    const bool iseq = (k == thr); const bool take = (k > thr) || (iseq && eqt < take_eq);
                    if (take) { so[pos] = (unsigned short)(128 * j2 + 2 * lane + h2); ++pos; if (iseq) ++eqt; } }
            }
        }
        if (lane == 0) nsel[tok] = 256;
    }
}

__device__ __forceinline__ void p4_token(const Frame& F, const Params& P, int tok) {
    const unsigned char* ws = P.ws;
    const int lane = F.lane; const int fr = lane & 15, g = lane >> 4;
    LAS unsigned char* vb0 = F.lds + F.wave * 16384;
    LAS unsigned short* selL = (LAS unsigned short*)(F.lds + 131072 + F.wave * 512);
    const int n = ((const int*)(ws + WS_NSEL))[tok]; const unsigned bbase = (unsigned)(tok >> 12) * SEQ;
    { const u32x2 v = *(const u32x2*)(ws + (unsigned)WS_SEL + (unsigned)tok * 512u + 8u * lane); *(LAS u32x2*)(selL + 4 * lane) = v; }
    LDS_WAIT(); __builtin_amdgcn_wave_barrier();
    const int nch = (n + 31) >> 5;
#define P4_DMA(CH) do { LAS unsigned char* vb_ = vb0 + ((CH) & 1) * 8192; \
        _Pragma("unroll") for (int i_ = 0; i_ < 8; ++i_) { const int rho_ = 4 * i_ + g; const int slot_ = 32 * (CH) + rho_; const unsigned key_ = (slot_ < n) ? (unsigned)selL[slot_] : 0u; \
            __builtin_amdgcn_global_load_lds((const unsigned*)(ws + (unsigned)WS_VV + (bbase + key_) * 256u + 16u * (unsigned)(fr ^ (2 * (rho_ & 7)))), (LAS unsigned*)(vb_ + 1024 * i_), 16, 0, 0); } } while (0)
    P4_DMA(0); P4_DMA(1);
    bf16x8 qf[4];
#pragma unroll
    for (int s = 0; s < 4; ++s) { if (fr < 8) qf[s] = *(const bf16x8*)(ws + (unsigned)WS_Q + ((unsigned)tok * 1024u + fr * 128u + 32u * s + 8u * g) * 2u); else qf[s] = (bf16x8){0, 0, 0, 0, 0, 0, 0, 0}; }
    f32x4 acc[16];
#pragma unroll
    for (int T = 0; T < 16; ++T) { const int slot = 16 * T + fr; const unsigned key = (slot < n) ? (unsigned)selL[slot] : 0u;
        const unsigned ko = (unsigned)WS_KR + (bbase + key) * 256u + 16u * g; f32x4 a = (f32x4){0.f, 0.f, 0.f, 0.f};
#pragma unroll
        for (int s = 0; s < 4; ++s) a = __builtin_amdgcn_mfma_f32_16x16x32_bf16(*(const bf16x8*)(ws + ko + 64u * s), qf[s], a, 0, 0, 0);
        acc[T] = a; if ((T & 3) == 3) __builtin_amdgcn_sched_barrier(0); }
    float mx = -3.0e38f;
#pragma unroll
    for (int T = 0; T < 16; ++T)
#pragma unroll
        for (int e = 0; e < 4; ++e) { const int slot = 16 * T + 4 * g + e; const float v = (slot < n) ? acc[T][e] : -3.0e38f; acc[T][e] = v; mx = fmaxf(mx, v); }
    mx = fmaxf(mx, shx(mx, 16, lane)); mx = fmaxf(mx, shx(mx, 32, lane));
    float sum = 0.f; unsigned pb[8][4];
#pragma unroll
    for (int T = 0; T < 16; ++T) { float p[4];
#pragma unroll
        for (int e = 0; e < 4; ++e) { p[e] = __expf(acc[T][e] - mx); sum += p[e]; }
        pb[T >> 1][(T & 1) * 2] = pk2(p[0], p[1]); pb[T >> 1][(T & 1) * 2 + 1] = pk2(p[2], p[3]); }
    sum += shx(sum, 16, lane); sum += shx(sum, 32, lane);
    const float inv = 1.0f / sum;
    f32x4 o[8];
#pragma unroll
    for (int dt = 0; dt < 8; ++dt) o[dt] = (f32x4){0.f, 0.f, 0.f, 0.f};
    const int q4 = fr >> 2, p4 = fr & 3;
#pragma unroll
    for (int c = 0; c < 8; ++c) {
        if (c < nch) {
            if (c + 1 < 8) asm volatile("s_waitcnt vmcnt(8)" ::: "memory"); else asm volatile("s_waitcnt vmcnt(0)" ::: "memory");
            const LAS unsigned char* vb = vb0 + (c & 1) * 8192;
            u32x4 bw; bw.x = pb[c][0]; bw.y = pb[c][1]; bw.z = pb[c][2]; bw.w = pb[c][3]; const bf16x8 bfrag = __builtin_bit_cast(bf16x8, bw);
            const int r0 = 4 * g + q4, r1 = 16 + 4 * g + q4;
#pragma unroll
            for (int dt = 0; dt < 8; ++dt) {
                const int ch = 2 * dt + (p4 >> 1);
                const s16x4 lo = __builtin_amdgcn_ds_read_tr16_b64_v4i16((LAS s16x4*)(vb + r0 * 256 + ((ch ^ (2 * (r0 & 7))) * 16) + 8 * (p4 & 1)));
                const s16x4 hi = __builtin_amdgcn_ds_read_tr16_b64_v4i16((LAS s16x4*)(vb + r1 * 256 + ((ch ^ (2 * (r1 & 7))) * 16) + 8 * (p4 & 1)));
                const u32x2 l2 = __builtin_bit_cast(u32x2, lo), h2 = __builtin_bit_cast(u32x2, hi); u32x4 aw; aw.x = l2.x; aw.y = l2.y; aw.z = h2.x; aw.w = h2.y;
                o[dt] = __builtin_amdgcn_mfma_f32_16x16x32_bf16(__builtin_bit_cast(bf16x8, aw), bfrag, o[dt], 0, 0, 0); }
            LDS_WAIT();
            if (c + 2 < 8) { if (c + 2 < nch) P4_DMA(c + 2); else { P4_DMA(c + 2); } }
        }
    }
    asm volatile("s_waitcnt vmcnt(0)" ::: "memory");
#undef P4_DMA
    if (fr < 8) {
#pragma unroll
        for (int dt = 0; dt < 8; ++dt) { u32x2 w; w.x = pk2(o[dt][0] * inv, o[dt][1] * inv); w.y = pk2(o[dt][2] * inv, o[dt][3] * inv);
            *(u32x2*)(P.ws + (unsigned)WS_YATT + ((unsigned)tok * 1024u + fr * 128u + 16u * dt + 4u * g) * 2u) = w; }
    }
    __builtin_amdgcn_wave_barrier();
}

__device__ __forceinline__ void h1_pass(const Frame& F, const Params& P, int ubase, bool rep) {
    unsigned char* ws = P.ws; LAS unsigned char* lds = F.lds;
    const int us = F.tid >> 7, d = F.tid & 127; const int uidx = ubase + us;
    const int b = uidx >> 9, c = (uidx >> 3) & 63, h = uidx & 7; const unsigned tok0 = (unsigned)(b * SEQ + 64 * c); const unsigned col0 = 128u * h;
    LAS bf16_t* KtL = (LAS bf16_t*)(lds + us * 36864); LAS bf16_t* VtL = KtL + 128 * 72;
    const unsigned e0 = (tok0 * 1024u + col0 + d);
    __syncthreads();
    float cum[64];
#pragma unroll
    for (int t = 0; t < 64; ++t) cum[t] = *(const float*)(ws + (unsigned)WS_LOGF + (e0 + 1024u * t) * 4u);
#pragma unroll
    for (int t = 1; t < 64; ++t) cum[t] += cum[t - 1];
    const float cmid = cum[31], clast = cum[63];
#pragma unroll
    for (int tg = 0; tg < 64; tg += 8) {
        unsigned short qraw[8], vraw[8];
#pragma unroll
        for (int i = 0; i < 8; ++i) { const unsigned a = (e0 + 1024u * (tg + i)) * 2u; qraw[i] = *(const bf16_t*)(ws + (unsigned)WS_QT + a); vraw[i] = *(const bf16_t*)(ws + (unsigned)WS_VH + a); }
#pragma unroll
        for (int i = 0; i < 8; ++i) { const int t = tg + i; const float g = (t == 0) ? cum[0] : (cum[t] - cum[t - 1]);
            const float e = __expf(cum[t] - cmid), ei = __expf(cmid - cum[t]), el = __expf(clast - cum[t]); const float k1 = 1.0f - __expf(g);
            const unsigned a = (e0 + 1024u * t) * 2u;
            const bf16_t qb = (bf16_t)f2bf(bf2f(qraw[i]) * e);
            if (!rep) *(bf16_t*)(ws + (unsigned)WS_QT + a) = qb; else *(bf16_t*)(ws + (unsigned)WS_KT + a) = qb;
            *(bf16_t*)(ws + (unsigned)WS_KT + a) = (bf16_t)f2bf(k1 * ei);
            KtL[d * 72 + t] = (bf16_t)f2bf(k1 * el); VtL[d * 72 + t] = vraw[i]; }
        asm volatile("" ::: "memory");
    }
    ((float*)(ws + WS_AVEC))[(size_t)uidx * 128 + d] = __expf(cmid); ((float*)(ws + WS_DECAY))[(size_t)uidx * 128 + d] = __expf(clast);
    __syncthreads();
    const int lane2 = opaque_i(F.lane); const int fr = lane2 & 15, g = lane2 >> 4, wu = F.wave & 1;
    bf16x8 kf[8][2];
#pragma unroll
    for (int dt = 0; dt < 8; ++dt) { kf[dt][0] = *(const LAS bf16x8*)(KtL + (16 * dt + fr) * 72 + 8 * g); kf[dt][1] = *(const LAS bf16x8*)(KtL + (16 * dt + fr) * 72 + 32 + 8 * g); }
    bf16_t* KVb = (bf16_t*)(ws + WS_KV) + (size_t)uidx * 16384;
#pragma unroll
    for (int vi = 0; vi < 4; ++vi) { const int vt = 4 * wu + vi;
        const bf16x8 a0 = *(const LAS bf16x8*)(VtL + (16 * vt + fr) * 72 + 8 * g), a1 = *(const LAS bf16x8*)(VtL + (16 * vt + fr) * 72 + 32 + 8 * g);
#pragma unroll
        for (int dt = 0; dt < 8; ++dt) { f32x4 acc = (f32x4){0.f, 0.f, 0.f, 0.f};
            acc = __builtin_amdgcn_mfma_f32_16x16x32_bf16(a0, kf[dt][0], acc, 0, 0, 0); acc = __builtin_amdgcn_mfma_f32_16x16x32_bf16(a1, kf[dt][1], acc, 0, 0, 0);
#pragma unroll
            for (int e = 0; e < 4; ++e) KVb[(16 * vt + 4 * g + e) * 128 + 16 * dt + fr] = (bf16_t)f2bf(acc[e]); } }
}
__device__ __forceinline__ void h2_scan(const Frame& F, const Params& P) {
    unsigned char* ws = P.ws; bf16_t* KV = (bf16_t*)(ws + WS_KV); const float* decay = (const float*)(ws + WS_DECAY);
    for (int idx = blockIdx.x * 512 + F.tid; idx < 32 * 2048; idx += F.G * 512) {
    const int bh = idx >> 11, rem = idx & 2047, v = rem >> 4, d8 = rem & 15; const int b = bh >> 3, h = bh & 7;
    float S[8];
#pragma unroll
    for (int e = 0; e < 8; ++e) S[e] = 0.f;
    for (int c0 = 0; c0 < 64; c0 += 8) {
        u32x4 kv[8]; f32x4 dc0[8], dc1[8];
#pragma unroll
        for (int j = 0; j < 8; ++j) { const size_t u = (size_t)((b * 64 + c0 + j) * 8 + h); kv[j] = *(const u32x4*)(KV + u * 16384 + v * 128 + 8 * d8); dc0[j] = *(const f32x4*)(decay + u * 128 + 8 * d8); dc1[j] = *(const f32x4*)(decay + u * 128 + 8 * d8 + 4); }
#pragma unroll
        for (int j = 0; j < 8; ++j) { const size_t u = (size_t)((b * 64 + c0 + j) * 8 + h);
            u32x4 o; o.x = pk2(S[0], S[1]); o.y = pk2(S[2], S[3]); o.z = pk2(S[4], S[5]); o.w = pk2(S[6], S[7]);
            *(u32x4*)(KV + u * 16384 + v * 128 + 8 * d8) = o;
            S[0] = dc0[j][0] * S[0] + bf2f(kv[j].x & 0xffffu); S[1] = dc0[j][1] * S[1] + bf2f(kv[j].x >> 16); S[2] = dc0[j][2] * S[2] + bf2f(kv[j].y & 0xffffu); S[3] = dc0[j][3] * S[3] + bf2f(kv[j].y >> 16);
            S[4] = dc1[j][0] * S[4] + bf2f(kv[j].z & 0xffffu); S[5] = dc1[j][1] * S[5] + bf2f(kv[j].z >> 16); S[6] = dc1[j][2] * S[6] + bf2f(kv[j].w & 0xffffu); S[7] = dc1[j][3] * S[7] + bf2f(kv[j].w >> 16); }
    }
    }
}
__device__ __forceinline__ void h3_unit(const Frame& F, const Params& P, int bc) {
    const unsigned char* ws = P.ws; LAS unsigned char* lds = F.lds;
    const int lane = F.lane, fr = lane & 15, g = lane >> 4, h = F.wave; const int b = bc >> 6, c = bc & 63; const int uidx = bc * 8 + h;
    const unsigned tok0 = (unsigned)(b * SEQ + 64 * c); const unsigned col0 = 128u * h;
    const unsigned rowoff = ((tok0 + fr) * 1024u + col0 + 8u * g) * 2u;
    LAS unsigned char* Vt = lds + h * 16384; LAS float* ex = (LAS float*)(lds + 131072);
    __syncthreads();
    { const unsigned vo = (unsigned)WS_VH + ((tok0 + (lane >> 4)) * 1024u + col0 + 8u * (lane & 15)) * 2u;
#pragma unroll 4
      for (int it = 0; it < 16; ++it) { const int t = 4 * it + (lane >> 4), chunk = lane & 15;
        const u32x4 wv = *(const u32x4*)(ws + vo + (unsigned)it * 4u * 2048u);
#pragma unroll
        for (int e = 0; e < 8; ++e) { const int v = 8 * chunk + e; const unsigned wd = ((const unsigned*)&wv)[e >> 1]; const unsigned short val = (e & 1) ? (unsigned short)(wd >> 16) : (unsigned short)(wd & 0xffffu);
            *(LAS unsigned short*)(Vt + v * 128 + (((t >> 2) ^ (v & 15)) * 8) + (t & 3) * 2) = val; } } }
    LDS_WAIT(); __builtin_amdgcn_wave_barrier();
    const unsigned soff = (unsigned)WS_KV + ((unsigned)uidx * 16384u + (unsigned)fr * 128u + 8u * g) * 2u;
    const unsigned aoff = (unsigned)WS_AVEC + ((unsigned)uidx * 128u + 8u * g) * 4u;
#pragma unroll 1
    for (int jh = 0; jh < 2; ++jh) {
        bf16x8 qf[2][4];
#pragma unroll
        for (int jj = 0; jj < 2; ++jj)
#pragma unroll
            for (int ks = 0; ks < 4; ++ks) qf[jj][ks] = *(const bf16x8*)(ws + (unsigned)WS_QT + rowoff + (unsigned)(16 * (2 * jh + jj)) * 2048u + 64u * ks);
        unsigned bfr[2][2][4];
#pragma unroll
        for (int jj = 0; jj < 2; ++jj)
#pragma unroll
            for (int p = 0; p < 2; ++p)
#pragma unroll
                for (int e = 0; e < 4; ++e) bfr[jj][p][e] = 0u;
#pragma unroll
        for (int i = 0; i < 4; ++i) {
            if (i <= 2 * jh + 1) {
                bf16x8 kf[4];
#pragma unroll
                for (int ks = 0; ks < 4; ++ks) kf[ks] = *(const bf16x8*)(ws + (unsigned)WS_KT + rowoff + (unsigned)(16 * i) * 2048u + 64u * ks);
#pragma unroll
                for (int jj = 0; jj < 2; ++jj) { const int j = 2 * jh + jj;
                    if (i <= j) { f32x4 st = (f32x4){0.f, 0.f, 0.f, 0.f};
#pragma unroll
                        for (int ks = 0; ks < 4; ++ks) st = __builtin_amdgcn_mfma_f32_16x16x32_bf16(kf[ks], qf[jj][ks], st, 0, 0, 0);
                        if (i == j) {
#pragma unroll
                            for (int e = 0; e < 4; ++e) st[e] = (4 * g + e <= fr) ? st[e] : 0.f; }
                        bfr[jj][i >> 1][(i & 1) * 2] = pk2(st[0], st[1]); bfr[jj][i >> 1][(i & 1) * 2 + 1] = pk2(st[2], st[3]); } }
            }
        }
#pragma unroll
        for (int ks = 0; ks < 4; ++ks) { const f32x4 a0 = *(const f32x4*)(ws + aoff + 128u * ks), a1 = *(const f32x4*)(ws + aoff + 128u * ks + 16u);
#pragma unroll
            for (int jj = 0; jj < 2; ++jj) { const u32x4 qw = __builtin_bit_cast(u32x4, qf[jj][ks]); u32x4 o;
                o.x = pk2(bf2f(qw.x & 0xffffu) * a0[0], bf2f(qw.x >> 16) * a0[1]); o.y = pk2(bf2f(qw.y & 0xffffu) * a0[2], bf2f(qw.y >> 16) * a0[3]);
                o.z = pk2(bf2f(qw.z & 0xffffu) * a1[0], bf2f(qw.z >> 16) * a1[1]); o.w = pk2(bf2f(qw.w & 0xffffu) * a1[2], bf2f(qw.w >> 16) * a1[3]);
                qf[jj][ks] = __builtin_bit_cast(bf16x8, o); } }
        f32x4 acc[8][2];
#pragma unroll
        for (int vt = 0; vt < 8; ++vt) { acc[vt][0] = (f32x4){0.f, 0.f, 0.f, 0.f}; acc[vt][1] = (f32x4){0.f, 0.f, 0.f, 0.f}; }
#pragma unroll
        for (int vt = 0; vt < 8; ++vt) {
            const int v = 16 * vt + fr;
#pragma unroll
            for (int p = 0; p < 2; ++p) {
                if (p <= jh) {
                    const u32x2 lo = *(const LAS u32x2*)(Vt + v * 128 + (((8 * p + g) ^ (v & 15)) * 8)), hi = *(const LAS u32x2*)(Vt + v * 128 + (((8 * p + 4 + g) ^ (v & 15)) * 8));
                    u32x4 aw; aw.x = lo.x; aw.y = lo.y; aw.z = hi.x; aw.w = hi.y; const bf16x8 af = __builtin_bit_cast(bf16x8, aw);
#pragma unroll
                    for (int jj = 0; jj < 2; ++jj) { u32x4 bw; bw.x = bfr[jj][p][0]; bw.y = bfr[jj][p][1]; bw.z = bfr[jj][p][2]; bw.w = bfr[jj][p][3];
                        acc[vt][jj] = __builtin_amdgcn_mfma_f32_16x16x32_bf16(af, __builtin_bit_cast(bf16x8, bw), acc[vt][jj], 0, 0, 0); }
                }
            }
#pragma unroll
            for (int ks = 0; ks < 4; ++ks) {
                const bf16x8 af = *(const bf16x8*)(ws + soff + (unsigned)(16 * vt) * 256u + 64u * ks);
#pragma unroll
                for (int jj = 0; jj < 2; ++jj) acc[vt][jj] = __builtin_amdgcn_mfma_f32_16x16x32_bf16(af, qf[jj][ks], acc[vt][jj], 0, 0, 0);
            }
            if (vt & 1) asm volatile("" ::: "memory");
        }
#pragma unroll
        for (int jj = 0; jj < 2; ++jj) { float s = 0.f;
#pragma unroll
            for (int vt = 0; vt < 8; ++vt) s += (acc[vt][jj][0] * acc[vt][jj][0] + acc[vt][jj][1] * acc[vt][jj][1]) + (acc[vt][jj][2] * acc[vt][jj][2] + acc[vt][jj][3] * acc[vt][jj][3]);
            s += shx(s, 16, lane); s += shx(s, 32, lane);
            if (g == 0) ex[(16 * (2 * jh + jj) + fr) * 8 + h] = s; }
        __syncthreads();
        const unsigned ooff = ((tok0 + fr) * 1024u + col0 + 4u * g) * 2u;
#pragma unroll
        for (int jj = 0; jj < 2; ++jj) { const int t = 16 * (2 * jh + jj) + fr;
            const f32x4 e0 = *(const LAS f32x4*)(ex + t * 8), e1 = *(const LAS f32x4*)(ex + t * 8 + 4);
            const float rs = __builtin_amdgcn_rsqf((((e0[0] + e0[1]) + (e0[2] + e0[3])) + ((e1[0] + e1[1]) + (e1[2] + e1[3]))) * (1.0f / 1024.0f) + EPS);
#pragma unroll
            for (int vt = 0; vt < 8; ++vt) { const unsigned o = ooff + (unsigned)(16 * (2 * jh + jj)) * 2048u + 32u * vt;
                const u32x2 sgw = *(const u32x2*)(ws + (unsigned)WS_SG + o); const f32x4 gh = *(const f32x4*)(P.g_hnorm + col0 + 16 * vt + 4 * g);
                const float y0 = acc[vt][jj][0] * rs * gh[0] * bf2f(sgw.x & 0xffffu), y1 = acc[vt][jj][1] * rs * gh[1] * bf2f(sgw.x >> 16);
                const float y2 = acc[vt][jj][2] * rs * gh[2] * bf2f(sgw.y & 0xffffu), y3 = acc[vt][jj][3] * rs * gh[3] * bf2f(sgw.y >> 16);
                u32x2 w; w.x = pk2(y0, y1); w.y = pk2(y2, y3); *(u32x2*)(P.ws + (unsigned)WS_YREC + o) = w; } }
        __syncthreads();
    }
}

__device__ __forceinline__ void p7_pass(const Frame& F, const Params& P, int task0, bool rep) {
    unsigned char* ws = P.ws; const bf16_t* x1b = (const bf16_t*)(ws + WS_X1B); const bf16_t* wrt = (const bf16_t*)(ws + WS_WRT);
    const int lane = F.lane, fr = lane & 15, g = lane >> 4; const int pair = F.wave >> 1, kh = F.wave & 1; const int task = task0 + pair; const size_t tok0 = (size_t)task * 16;
    LAS float* lg = (LAS float*)(F.lds + F.wave * 4096);
    f32x4 acc[3];
#pragma unroll
    for (int nt = 0; nt < 3; ++nt) acc[nt] = (f32x4){0.f, 0.f, 0.f, 0.f};
    if (task < NTOK / 16) {
        const bf16_t* ap = x1b + (tok0 + fr) * DM + 1024 * kh + 8 * g; const bf16_t* bp = wrt + (size_t)fr * DM + 1024 * kh + 8 * g;
#pragma unroll 8
        for (int s = 0; s < 32; ++s) { const bf16x8 a = *(const bf16x8*)(ap + 32 * s);
#pragma unroll
            for (int nt = 0; nt < 3; ++nt) acc[nt] = __builtin_amdgcn_mfma_f32_16x16x32_bf16(a, *(const bf16x8*)(bp + (size_t)nt * 16 * DM + 32 * s), acc[nt], 0, 0, 0); }
    }
#pragma unroll
    for (int nt = 0; nt < 3; ++nt)
#pragma unroll
        for (int e = 0; e < 4; ++e) lg[(4 * g + e) * 48 + 16 * nt + fr] = acc[nt][e];
    __syncthreads();
    if (kh == 0 && lane < 16 && task < NTOK / 16) {
        const size_t tok = tok0 + lane; const float* part = (const float*)(ws + WS_SSQ2) + tok * 32; float ssq = 0.f;
#pragma unroll
        for (int q = 0; q < 8; ++q) { const f32x4 v = *(const f32x4*)(part + 4 * q); ssq += (v[0] + v[1]) + (v[2] + v[3]); }
        const float rs = 1.0f / sqrtf(ssq * (1.0f / DM) + EPS);
        const LAS float* l = lg + lane * 48; const LAS float* l2 = l + 1024;
        float gl0 = (l[0] + l2[0]) * rs + P.b_grp[0]; int grp = 0; float gmax = gl0; float glv[4]; glv[0] = gl0;
#pragma unroll
        for (int j = 1; j < 4; ++j) { const float v = (l[j] + l2[j]) * rs + P.b_grp[j]; glv[j] = v; if (v > gmax) { gmax = v; grp = j; } }
        float gsum = 0.f;
#pragma unroll
        for (int j = 0; j < 4; ++j) gsum += expf(glv[j] - gmax);
        const float pg = 1.0f / gsum;
        float m1 = -3.0e38f, m2 = -3.0e38f; int i1 = 0, i2 = 0;
#pragma unroll
        for (int i = 0; i < 8; ++i) { const float v = (l[4 + 8 * grp + i] + l2[4 + 8 * grp + i]) * rs + P.b_exp[8 * grp + i];
            if (v > m1) { m2 = m1; i2 = i1; m1 = v; i1 = i; } else if (v > m2) { m2 = v; i2 = i; } }
        const float r2 = expf(m2 - m1); const float g0 = pg / (1.0f + r2), g1 = pg * r2 / (1.0f + r2);
        const int e0 = grp * 8 + i1, e1 = grp * 8 + i2;
        ((int*)(ws + WS_ROUTE_E))[tok * 2] = e0; ((int*)(ws + WS_ROUTE_E))[tok * 2 + 1] = e1;
        ((float*)(ws + WS_ROUTE_G))[tok * 2] = g0; ((float*)(ws + WS_ROUTE_G))[tok * 2 + 1] = g1;
        ((float*)(ws + WS_RSTD1))[tok] = rs;
        int* cnt = (int*)(ws + WS_CTL);
        if (!rep) { atomicAdd(cnt + e0, 1); atomicAdd(cnt + e1, 1); }
    }
    __syncthreads();
}

__device__ __forceinline__ void p7b_gather(const Frame& F, const Params& P, bool rep) {
    unsigned char* ws = P.ws; int* ctl = (int*)(ws + WS_CTL); const int lane = F.lane;
    const int c = (lane < 32) ? __hip_atomic_load(ctl + lane, __ATOMIC_RELAXED, __HIP_MEMORY_SCOPE_AGENT) : 0; const int pad = (c + 255) & ~255;
    int incl = pad;
#pragma unroll
    for (int o = 1; o < 64; o <<= 1) { const int t = shl_i(incl, lane - o, lane); if (lane >= o) incl += t; }
    const int basev = incl - pad;
    if (blockIdx.x == 0 && F.wave == 0 && !rep) {
        const int total = shl_i(incl, 31, lane); if (lane == 0) ctl[128] = total >> 8;
        if (lane < 32) { for (int r = basev >> 8; r < (incl >> 8); ++r) ctl[256 + r] = lane; }
    }
    const bf16_t* x1b = (const bf16_t*)(ws + WS_X1B); bf16_t* xs = (bf16_t*)(ws + WS_XS);
    for (int tok = F.gw; tok < NTOK; tok += F.NGW) {
        const int e0 = ((const int*)(ws + WS_ROUTE_E))[tok * 2], e1 = ((const int*)(ws + WS_ROUTE_E))[tok * 2 + 1];
        int s0 = 0, s1 = 0;
        if (lane == 0 && !rep) { s0 = atomicAdd(ctl + 32 + e0, 1); s1 = atomicAdd(ctl + 32 + e1, 1); }
        s0 = shl_i(s0, 0, lane); s1 = shl_i(s1, 0, lane);
        int d0 = shl_i(basev, e0, lane) + s0, d1 = shl_i(basev, e1, lane) + s1;
        if (rep) { d0 = ((const int*)(ws + WS_DEST))[tok * 2]; d1 = ((const int*)(ws + WS_DEST))[tok * 2 + 1]; }
        const u32x4* src = (const u32x4*)(x1b + (size_t)tok * DM) + lane; u32x4* o0 = (u32x4*)(xs + (size_t)d0 * DM) + lane; u32x4* o1 = (u32x4*)(xs + (size_t)d1 * DM) + lane;
#pragma unroll
        for (int j = 0; j < 4; ++j) { const u32x4 v = src[64 * j]; o0[64 * j] = v; o1[64 * j] = v; }
        if (lane == 0) { const float rs = ((const float*)(ws + WS_RSTD1))[tok];
            ((float*)(ws + WS_RSS))[d0] = rs; ((float*)(ws + WS_RSS))[d1] = rs;
            ((float*)(ws + WS_GS))[d0] = ((const float*)(ws + WS_ROUTE_G))[tok * 2]; ((float*)(ws + WS_GS))[d1] = ((const float*)(ws + WS_ROUTE_G))[tok * 2 + 1];
            ((int*)(ws + WS_DEST))[tok * 2] = d0; ((int*)(ws + WS_DEST))[tok * 2 + 1] = d1; }
    }
}

__device__ __forceinline__ void p9_final(const Frame& F, const Params& P) {
    unsigned char* ws = P.ws; const bf16_t* ys = (const bf16_t*)(ws + WS_YS); const bf16_t* x1b = (const bf16_t*)(ws + WS_X1B); const int lane = F.lane;
    for (int tok = F.gw; tok < NTOK; tok += F.NGW) {
        const int d0 = ((const int*)(ws + WS_DEST))[tok * 2], d1 = ((const int*)(ws + WS_DEST))[tok * 2 + 1];
        f32x4* xr = (f32x4*)(P.out + (size_t)tok * DM) + lane; const u32x2* x0 = (const u32x2*)(x1b + (size_t)tok * DM) + lane;
        const u32x2* y0 = (const u32x2*)(ys + (size_t)d0 * DM) + lane; const u32x2* y1 = (const u32x2*)(ys + (size_t)d1 * DM) + lane;
        f32x4 v[8]; float s = 0.f;
#pragma unroll
        for (int j = 0; j < 8; ++j) { const u32x2 x = x0[64 * j], a = y0[64 * j], b = y1[64 * j];
            v[j][0] = bf2f(x.x & 0xffffu) + (bf2f(a.x & 0xffffu) + bf2f(b.x & 0xffffu)); v[j][1] = bf2f(x.x >> 16) + (bf2f(a.x >> 16) + bf2f(b.x >> 16));
            v[j][2] = bf2f(x.y & 0xffffu) + (bf2f(a.y & 0xffffu) + bf2f(b.y & 0xffffu)); v[j][3] = bf2f(x.y >> 16) + (bf2f(a.y >> 16) + bf2f(b.y >> 16));
            s += (v[j][0] * v[j][0] + v[j][1] * v[j][1]) + (v[j][2] * v[j][2] + v[j][3] * v[j][3]); }
        s = wave_sum(s, lane); const float rs = 1.0f / sqrtf(s * (1.0f / DM) + EPS);
#pragma unroll
        for (int j = 0; j < 8; ++j) { const f32x4 gf = *((const f32x4*)P.g_final + 64 * j + lane); xr[64 * j] = v[j] * rs * gf; }
    }
}

#ifndef PHMASK
#define PHMASK 0xFFFFFF
#endif
#ifndef SELREP
#define SELREP 0
#endif
#ifndef REPMASK
#define REPMASK 0
#endif
#define PH(k) for (int _rep = 0; _rep < 1 + ((REPMASK >> (k)) & 1); ++_rep) if constexpr ((PHMASK >> (k)) & 1)
__global__ void __launch_bounds__(512, 2) mega_fwd(Params P) {
    extern __shared__ __attribute__((aligned(16))) unsigned char lds_raw[];
    cg::grid_group grid = cg::this_grid();
    LAS unsigned char* lds = (LAS unsigned char*)lds_raw; const int G = gridDim.x;
    const int wave_id = __builtin_amdgcn_readfirstlane((int)(threadIdx.x >> 6));
    unsigned char* ws = P.ws;
    const float* ctab = (const float*)(ws + WS_COS); const float* stab = (const float*)(ws + WS_SIN);
    volatile LAS unsigned* bst = (volatile LAS unsigned*)(lds + LDS_PHASE_BYTES);
    if (wave_id == 0 && lane_id() < 2) bst[lane_id()] = 0u;
    __syncthreads();
    const XcdBarrier xbar = xcd_barrier_post((unsigned*)(ws + WS_BAR), bst, wave_id);
    if (ws == nullptr) grid.sync();
    PH(0) { const Frame F = make_frame(lds, wave_id); p0_prep(F, P); }
    xcd_barrier(xbar);
    const int skew = (blockIdx.x >> 3) & 3;
    const bool skew_first = skew != 0;
    if (skew_first) { const Frame F = make_frame(lds, wave_id); conv_small(F, P, 0, skew == 3 ? 2432 : 2048); __syncthreads(); }
    PH(1) { SchedDense S; S.A = (const char*)(ws + WS_XB); S.Bt = (const char*)(ws + WS_WTIN); S.nM = NTOK / 256; S.nN = NP1 / 256; S.G = G; S.c = blockIdx.x; S.tstep = (size_t)256 * DM * 2;
      EpiIn E; E.ws = ws; E.rstd1 = (const float*)(ws + WS_RSTD1); E.lb = (const float*)(ws + WS_LB); E.ctab = ctab; E.stab = stab;
      if (_rep == 0) pg8::gemm_phase(lds, DM, S, E, wave_id); else { EpiNull E0; pg8::gemm_phase(lds, DM, S, E0, wave_id); } }
    if (skew != 3) { const Frame F = make_frame(lds, wave_id); conv_small(F, P, skew == 0 ? 0 : 2048, 2432); }
    xcd_barrier(xbar);
    PH(2) { SchedDense S; S.A = (const char*)(ws + WS_CQ); S.Bt = (const char*)(ws + WS_WTQQ); S.nM = NTOK / 256; S.nN = 3072 / 256; S.G = G; S.c = blockIdx.x; S.tstep = (size_t)256 * QR * 2;
      EpiQ E; E.ws = ws; E.ctab = ctab; E.stab = stab;
      pg8::gemm_phase(lds, QR, S, E, wave_id); }
    PH(3) { const Frame F = make_frame(lds, wave_id); for (int u = 4 * blockIdx.x; u < 2048; u += 4 * G) h1_pass(F, P, u, _rep != 0); }
    xcd_barrier(xbar);
    PH(4) { const Frame F = make_frame(lds, wave_id); for (int task = blockIdx.x; task < 1024; task += G) { const int bb = task >> 8, j = task & 255; p3_task(F, P, bb, (bb & 1) ? 255 - j : j, (_rep == 0) || SELREP); } }
    __syncthreads();
    PH(5) { const Frame F = make_frame(lds, wave_id); h2_scan(F, P); }
    xcd_barrier(xbar);
#if defined(DUMP) && DUMP == 3
    { const Frame F = make_frame(lds, wave_id); const float* src = (const float*)(ws + WS_KV);
      for (size_t i = (size_t)blockIdx.x * 512 + F.tid; i < (size_t)NTOK * DM; i += (size_t)G * 512) P.out[i] = src[i];
      return; }
#endif
#if defined(DUMP) && DUMP == 2
    { const Frame F = make_frame(lds, wave_id); const bf16_t* s0 = (const bf16_t*)(ws + WS_QT); const bf16_t* s1 = (const bf16_t*)(ws + WS_KT);
      for (size_t i = (size_t)blockIdx.x * 512 + F.tid; i < (size_t)NTOK * DM; i += (size_t)G * 512) { const size_t r = i / DM, c = i % DM; P.out[i] = bf2f((c < 1024 ? s0 : s1)[r * 1024 + (c & 1023)]); }
      return; }
#endif
    PH(6) { const Frame F = make_frame(lds, wave_id); for (int tok = F.gw; tok < NTOK; tok += F.NGW) p4_token(F, P, tok); }
    PH(7) { const Frame F = make_frame(lds, wave_id); for (int bc = blockIdx.x; bc < 256; bc += G) h3_unit(F, P, bc); }
    xcd_barrier(xbar);
#ifdef DUMP
    { const Frame F = make_frame(lds, wave_id); const bf16_t* src = (const bf16_t*)(ws + (DUMP == 0 ? WS_YATT : WS_YREC));
      for (size_t i = (size_t)blockIdx.x * 512 + F.tid; i < (size_t)NTOK * DM; i += (size_t)G * 512) { const size_t r = i / DM, c = i % DM; P.out[i] = bf2f(src[r * 1024 + (c & 1023)]); }
      return; }
#endif
    if (skew_first) { PH(9) { const Frame F = make_frame(lds, wave_id); conv_gateup(F, P, 0, 2048 * ((8 * skew) / 3)); } __syncthreads(); }
    PH(8) { SchedMerged S; S.A0 = (const char*)(ws + WS_YATT); S.A1 = (const char*)(ws + WS_YREC); S.B0 = (const char*)(ws + WS_WTPA); S.B1 = (const char*)(ws + WS_WTPB);
      S.nM = NTOK / 256; S.nN = DM / 256; S.G = G; S.c = blockIdx.x; S.tstep = (size_t)256 * 1024 * 2;
      EpiMerged E; E.ws = ws;
      pg8::gemm_phase(lds, 1024, S, E, wave_id); }
    if (skew != 3) { PH(9) { const Frame F = make_frame(lds, wave_id); conv_gateup(F, P, 2048 * ((8 * skew) / 3), 16384); } }
    xcd_barrier(xbar);
    if (skew_first) { PH(11) { const Frame F = make_frame(lds, wave_id); conv_down(F, P, 0, 2048 * ((4 * skew) / 3)); } __syncthreads(); }
    PH(10) { SchedDense S; S.A = (const char*)(ws + WS_MERGED); S.Bt = (const char*)(ws + WS_WTO); S.nM = NTOK / 256; S.nN = DM / 256; S.G = G; S.c = blockIdx.x; S.tstep = (size_t)256 * DM * 2;
      EpiX1 E; E.ws = ws; E.x = P.x; E.x1 = P.out;
      pg8::gemm_phase(lds, DM, S, E, wave_id); }
    if (skew != 3) { PH(11) { const Frame F = make_frame(lds, wave_id); conv_down(F, P, 2048 * ((4 * skew) / 3), 8192); } }
    xcd_barrier(xbar);
    PH(12) { const Frame F = make_frame(lds, wave_id); for (int t = 4 * blockIdx.x; t < NTOK / 16; t += 4 * G) p7_pass(F, P, t, _rep != 0); }
    xcd_barrier(xbar);
    PH(13) { const Frame F = make_frame(lds, wave_id); p7b_gather(F, P, _rep != 0); }
    xcd_barrier(xbar);
    const int* ctl = (const int*)(ws + WS_CTL);
    PH(14) { SchedMoe S; S.A = (const char*)(ws + WS_XS); S.Bt = (const char*)(ws + WS_WGUT); S.tile_e = ctl + 256; S.ntiles = __builtin_amdgcn_readfirstlane(ctl[128]); S.NCT = 4; S.G = G; S.c = blockIdx.x; S.tstep = (size_t)256 * DM * 2;
      EpiGateUp E; E.ws = ws;
      pg8::gemm_phase(lds, DM, S, E, wave_id); }
    xcd_barrier(xbar);
    PH(15) { SchedMoe S; S.A = (const char*)(ws + WS_ACT); S.Bt = (const char*)(ws + WS_WDT); S.tile_e = ctl + 256; S.ntiles = __builtin_amdgcn_readfirstlane(ctl[128]); S.NCT = 8; S.G = G; S.c = blockIdx.x; S.tstep = (size_t)256 * DEXP * 2;
      EpiDown E; E.ws = ws;
      pg8::gemm_phase(lds, DEXP, S, E, wave_id); }
    xcd_barrier(xbar);
    PH(16) { const Frame F = make_frame(lds, wave_id); p9_final(F, P); }
}

extern "C" void kernel_launch(void* const* d_in, const int* in_sizes, int n_in, void* d_out, int out_size, void* d_ws, size_t ws_size, hipStream_t stream) {
    static int grid = 0;
    if (grid == 0) {
        if (n_in != 20 || out_size != NTOK * DM || ws_size < WS_END) { fprintf(stderr, "kernel_launch: unexpected shapes (n_in %d out %d ws %zu, need %zu)\n", n_in, out_size, ws_size, (size_t)WS_END); grid = -1; return; }
        int dev = 0, cus = 0, per_cu = 0;
        if (hipGetDevice(&dev) != hipSuccess || hipDeviceGetAttribute(&cus, hipDeviceAttributeMultiprocessorCount, dev) != hipSuccess) { grid = -1; return; }
        if (hipFuncSetAttribute((const void*)mega_fwd, hipFuncAttributeMaxDynamicSharedMemorySize, LDS_BYTES) != hipSuccess) { fprintf(stderr, "kernel_launch: hipFuncSetAttribute failed\n"); grid = -1; return; }
        if (hipOccupancyMaxActiveBlocksPerMultiprocessor(&per_cu, (const void*)mega_fwd, 512, LDS_BYTES) != hipSuccess || per_cu < 1) { fprintf(stderr, "kernel_launch: occupancy query says %d\n", per_cu); (void)hipGetLastError(); grid = -1; return; }
        grid = cus;
        if (grid > 256) grid = 256;
    }
    if (grid < 0) return;
    if (hipMemsetAsync((unsigned char*)d_ws + WS_BAR, 0, 16384, stream) != hipSuccess) { fprintf(stderr, "kernel_launch: memset of the barrier words failed\n"); return; }
    Params p{};
    const float** pp = (const float**)&p;
    for (int i = 0; i < 20; ++i) pp[i] = (const float*)d_in[i];
    p.out = (float*)d_out; p.ws = (unsigned char*)d_ws;
    void* args[] = {&p};
    hipError_t e = hipLaunchCooperativeKernel((const void*)mega_fwd, dim3(grid), dim3(512), args, LDS_BYTES, stream);
    if (e != hipSuccess) fprintf(stderr, "cooperative launch failed: %s (grid %d)\n", hipGetErrorString(e), grid);
}
```

```cpp
#include <hip/hip_runtime.h>
#include <hip/hip_cooperative_groups.h>
#include <cstdio>
#include <cstdint>
namespace cg = cooperative_groups;

#define LAS __attribute__((address_space(3)))
typedef unsigned short bf16_t;
typedef short bf16x8 __attribute__((ext_vector_type(8)));
typedef float f32x4 __attribute__((ext_vector_type(4)));
typedef float f32x2 __attribute__((ext_vector_type(2)));
typedef float f32x16 __attribute__((ext_vector_type(16)));
typedef unsigned u32x4 __attribute__((ext_vector_type(4)));
typedef unsigned u32x2 __attribute__((ext_vector_type(2)));

constexpr int NTOK = 16384, DM = 2048, SEQ = 4096, NBATCH = 4;
constexpr int DIN = 9104, NP1 = 9216;
constexpr int QR = 512;
constexpr int NEXP = 32, DEXP = 512;
constexpr int XS_ROWS = 40704;
constexpr float EPS = 1e-6f;

constexpr size_t MiB = 1u << 20;
constexpr size_t WS_R0 = 0;
constexpr size_t WS_R1 = 64 * MiB;
constexpr size_t WS_R2 = 100 * MiB;
constexpr size_t WS_R3 = 228 * MiB;
constexpr size_t WS_R4 = 292 * MiB;
constexpr size_t WS_R5 = 420 * MiB;
constexpr size_t WS_R6 = 452 * MiB;
constexpr size_t WS_R7 = 484 * MiB;
constexpr size_t WS_R8 = 516 * MiB;
constexpr size_t WS_R9 = 548 * MiB;
constexpr size_t WS_R10 = 564 * MiB;
constexpr size_t WS_R11 = 580 * MiB;
constexpr size_t WS_MISC = 599 * MiB;
constexpr size_t WS_END = 607 * MiB;

constexpr size_t WS_XB = WS_R0, WS_QI = WS_R0, WS_YATT = WS_R0, WS_YREC = WS_R0 + 32 * MiB, WS_X1B = WS_R0, WS_ACT = WS_R3;
constexpr size_t WS_WTIN = WS_R1, WS_Q = WS_R1;
constexpr size_t WS_RG = WS_R2, WS_SB = WS_R2 + 64 * MiB, WS_WGUT = WS_R2;
constexpr size_t WS_LOGF = WS_R3, WS_SEL = WS_R3, WS_MERGED = WS_R3;
constexpr size_t WS_KV = WS_R4, WS_WDT = WS_R4 + 64 * MiB;
constexpr size_t WS_QT = WS_R5, WS_XS = WS_R5, WS_YS = WS_R5;
constexpr size_t WS_VH = WS_R6, WS_SG = WS_R7, WS_KT = WS_R8, WS_CQ = WS_R9;
constexpr size_t WS_KR = WS_R10, WS_KIR = WS_R10 + 4 * MiB, WS_VV = WS_R10 + 8 * MiB, WS_WI = WS_R10 + 12 * MiB, WS_COS = WS_R10 + 13 * MiB, WS_SIN = WS_R10 + 14 * MiB;
constexpr size_t WS_WTQQ = WS_R11, WS_WTPA = WS_R11 + 3 * MiB, WS_WTPB = WS_R11 + 7 * MiB, WS_WTO = WS_R11 + 11 * MiB;
constexpr size_t WS_RSTD1 = WS_MISC;
constexpr size_t WS_SSQCQ = WS_MISC + 64 * 1024;
constexpr size_t WS_SSQ2 = WS_MISC + 576 * 1024;
constexpr size_t WS_NSEL = WS_MISC + 2624 * 1024;
constexpr size_t WS_LB = WS_MISC + 2688 * 1024;
constexpr size_t WS_AVEC = WS_MISC + 2692 * 1024;
constexpr size_t WS_DECAY = WS_MISC + 3716 * 1024;
constexpr size_t WS_ROUTE_E = WS_MISC + 4740 * 1024;
constexpr size_t WS_ROUTE_G = WS_MISC + 4868 * 1024;
constexpr size_t WS_DEST = WS_MISC + 4996 * 1024;
constexpr size_t WS_RSS = WS_MISC + 5124 * 1024;
constexpr size_t WS_GS = WS_MISC + 5284 * 1024;
constexpr size_t WS_WRT = WS_MISC + 5444 * 1024;
constexpr size_t WS_CTL = WS_MISC + 5636 * 1024;
constexpr size_t WS_BAR = WS_MISC + 5640 * 1024;
constexpr size_t WS_TOKROW = WS_MISC + 5656 * 1024;
constexpr size_t WS_CNTB = WS_MISC + 5824 * 1024;
static_assert(WS_TOKROW + 163840 <= WS_CNTB && WS_CNTB + 32768 <= WS_END, "ws map");

__device__ __forceinline__ float bf2f(unsigned b) { return __uint_as_float(b << 16); }
__device__ __forceinline__ unsigned f2bf(float f) { unsigned u = __float_as_uint(f); return (u + 0x7fffu + ((u >> 16) & 1u)) >> 16; }
typedef __bf16 bf16v2 __attribute__((ext_vector_type(2)));
__device__ __forceinline__ unsigned pk2(float lo, float hi) { f32x2 v = {lo, hi}; bf16v2 b = __builtin_convertvector(v, bf16v2); return __builtin_bit_cast(unsigned, b); }
__device__ __forceinline__ float shx(float v, int m, int lane) { return __int_as_float(__builtin_amdgcn_ds_bpermute((lane ^ m) << 2, __float_as_int(v))); }
__device__ __forceinline__ int shx_i(int v, int m, int lane) { return __builtin_amdgcn_ds_bpermute((lane ^ m) << 2, v); }
__device__ __forceinline__ int shl_i(int v, int src, int) { return __builtin_amdgcn_ds_bpermute(src << 2, v); }
__device__ __forceinline__ float wave_sum(float v, int lane) {
#pragma unroll
    for (int o = 1; o < 64; o <<= 1) v += shx(v, o, lane);
    return v;
}
__device__ __forceinline__ int wave_sum_i(int v, int lane) {
#pragma unroll
    for (int o = 1; o < 64; o <<= 1) v += shx_i(v, o, lane);
    return v;
}
__device__ __forceinline__ float sigmoidf_(float x) { return __builtin_amdgcn_rcpf(1.0f + __expf(-x)); }
__device__ __forceinline__ float siluf_(float x) { return x * sigmoidf_(x); }
__device__ __forceinline__ int opaque_i(int x) { asm volatile("" : "+v"(x)); return x; }
__device__ __forceinline__ int lane_id() { int x; asm volatile("v_mbcnt_lo_u32_b32 %0, -1, 0\n\tv_mbcnt_hi_u32_b32 %0, -1, %0" : "=v"(x)); return x; }
#define LDS_WAIT() asm volatile("s_waitcnt lgkmcnt(0)" ::: "memory")
#define VM_WAIT() asm volatile("s_waitcnt vmcnt(0)" ::: "memory")

namespace pg8 {
constexpr int BM = 256, BK = 64, HALF = 128, HTB = HALF * BK * 2, STAGE_BYTES = 8 * HTB, NXCD = 8, WGM = 8;
__host__ __device__ __forceinline__ int lds_byte(int r, int c) { const int st = (r >> 4) * 2 + (c >> 5), rr = r & 15, cc = c & 31, ob = rr * 64 + cc * 2; return st * 1024 + (ob ^ (((ob >> 9) & 1) << 5)); }
__host__ __device__ __forceinline__ void stage_rc(int b, int& R, int& C) { const int st = b / 1024, sb = b % 1024, swz = sb ^ (((sb >> 9) & 1) << 5); R = (st >> 1) * 16 + swz / 64; C = (st & 1) * 32 + (swz % 64) / 2; }
__host__ __device__ __forceinline__ int perm32(int rho) { const int n = rho >> 4, i = rho & 15; return 8 * (i >> 2) + 4 * n + (i & 3); }

struct Unit { const char* A; const char* B; int pm, pn, aux; };

__device__ __forceinline__ bool static_tile(long L, int nM, int nN, int& pm, int& pn) {
    const int nwg = nM * nN; if (L >= nwg) return false;
    int wgid = (int)L; { const int q = nwg / NXCD, r = nwg % NXCD, xcd = wgid % NXCD, off = wgid / NXCD; wgid = (xcd < r ? xcd * (q + 1) : r * (q + 1) + (xcd - r) * q) + off; }
    const int nig = WGM * nN, gid = wgid / nig, fm = gid * WGM, gsz = (nM - fm) < WGM ? (nM - fm) : WGM;
    pm = fm + ((wgid % nig) % gsz); pn = (wgid % nig) / gsz; return true;
}

template <class Epi, class Sched, bool GATHER = false>
__device__ __forceinline__ void gemm_phase(LAS unsigned char* lds, const int K, const Sched& S, const Epi& E, const int wid) {
    const int lane = opaque_i(lane_id()), tid = wid * 64 + lane, wr = wid >> 2, wc = wid & 3, fr = lane & 15, fq = lane >> 4;
    const int nt = K / BK;
    unsigned voffA[2], voffB[2]; int rowA[2]; unsigned colA2[2];
#pragma unroll
    for (int i = 0; i < 2; ++i) { int R, C; stage_rc(tid * 16 + i * 8192, R, C); const int Rb = (R & ~31) + perm32(R & 31);
        voffA[i] = (unsigned)(R * K + C) * 2u; voffB[i] = (unsigned)(Rb * K + C) * 2u; rowA[i] = R; colA2[i] = (unsigned)C * 2u; }
    unsigned gC[2][2], gN[2][2];
    const size_t kstep = (size_t)(BK * 2);
    const size_t hstep = (size_t)HALF * K * 2;
    const unsigned ldsw = (unsigned)wid * 1024u;
    const int aoff = lds_byte(wr * 64 + fr, fq * 8), boff = lds_byte(wc * 32 + fr, fq * 8);
#define PG8_SA(b, h) (((b) * 2 + (h)) * HTB)
#define PG8_SB(b, h) ((4 + (b) * 2 + (h)) * HTB)
#define PG8_STAGE(bufoff, gbase, voff) do { _Pragma("unroll") for (int _i = 0; _i < 2; ++_i) \
        __builtin_amdgcn_global_load_lds((const unsigned*)((const char*)(gbase) + (voff)[_i]), (LAS unsigned*)(lds + (bufoff) + ldsw + _i * 8192), 16, 0, 0); } while (0)
#define PG8_GLOAD(dst, U) do { _Pragma("unroll") for (int _h = 0; _h < 2; ++_h) _Pragma("unroll") for (int _i = 0; _i < 2; ++_i) \
        dst[_h][_i] = (unsigned)S.tokrow[(U).pm * 256 + 128 * _h + rowA[_i]] * (unsigned)(K * 2) + colA2[_i]; } while (0)
#define PG8_STAGE_A(bufoff, nx, h, kt) do { if constexpr (GATHER) { _Pragma("unroll") for (int _i = 0; _i < 2; ++_i) \
            __builtin_amdgcn_global_load_lds((const unsigned*)(S.gA + ((nx) ? gN[h][_i] : gC[h][_i]) + (size_t)(kt) * kstep), (LAS unsigned*)(lds + (bufoff) + ldsw + _i * 8192), 16, 0, 0); } \
        else { PG8_STAGE(bufoff, ((nx) ? nA : cA) + (size_t)(h) * hstep + (size_t)(kt) * kstep, voffA); } } while (0)
#define PG8_LDA(dst, b, h) do { _Pragma("unroll") for (int m = 0; m < 4; ++m) _Pragma("unroll") for (int k = 0; k < 2; ++k) dst[m][k] = *(const LAS bf16x8*)(lds + PG8_SA(b, h) + aoff + m * 2048 + k * 1024); } while (0)
#define PG8_LDB(dst, b, h) do { _Pragma("unroll") for (int n = 0; n < 2; ++n) _Pragma("unroll") for (int k = 0; k < 2; ++k) dst[n][k] = *(const LAS bf16x8*)(lds + PG8_SB(b, h) + boff + n * 2048 + k * 1024); } while (0)
#define PG8_MMA(ai, bj, At, Bt) do { __builtin_amdgcn_s_setprio(1); _Pragma("unroll") for (int m = 0; m < 4; ++m) _Pragma("unroll") for (int n = 0; n < 2; ++n) _Pragma("unroll") for (int k = 0; k < 2; ++k) \
        acc[ai][bj][m][n] = __builtin_amdgcn_mfma_f32_16x16x32_bf16(Bt[n][k], At[m][k], acc[ai][bj][m][n], 0, 0, 0); __builtin_amdgcn_s_setprio(0); } while (0)
#define PG8_WAIT_V(n) asm volatile("s_waitcnt vmcnt(" #n ")" ::: "memory")
#define PG8_WAIT_L(n) asm volatile("s_waitcnt lgkmcnt(" #n ")" ::: "memory")
#define PG8_BAR __builtin_amdgcn_s_barrier()
#define PG8_SCHED __builtin_amdgcn_sched_barrier(0)
    Unit cur, nxt; int ui = 0;
    if (!S.next(0, cur)) return;
    f32x4 acc[2][2][4][2];
#pragma unroll
    for (int a = 0; a < 2; ++a)
#pragma unroll
        for (int b = 0; b < 2; ++b)
#pragma unroll
            for (int m = 0; m < 4; ++m)
#pragma unroll
                for (int n = 0; n < 2; ++n) acc[a][b][m][n] = (f32x4){0.f, 0.f, 0.f, 0.f};
    bf16x8 At[4][2], B0[2][2], B1[2][2];
    const char* cA = cur.A; const char* cB = cur.B; const char* nA = cA;
    if constexpr (GATHER) { PG8_GLOAD(gC, cur); }
    PG8_STAGE(PG8_SB(0, 0), cB, voffB); PG8_STAGE(PG8_SB(0, 1), cB + hstep, voffB); PG8_STAGE_A(PG8_SA(0, 0), false, 0, 0); PG8_STAGE_A(PG8_SA(0, 1), false, 1, 0);
    if (wr == 1) PG8_BAR;
    PG8_WAIT_V(2); PG8_BAR;
    PG8_STAGE(PG8_SB(1, 0), cB + kstep, voffB); PG8_STAGE_A(PG8_SA(1, 0), false, 0, 1); PG8_STAGE(PG8_SB(1, 1), cB + hstep + kstep, voffB);
    PG8_WAIT_V(6); PG8_BAR;
    for (;;) {
        const bool has_next = S.next(ui + 1, nxt);
        nA = has_next ? nxt.A : cA; const char* nB = has_next ? nxt.B : cB;
        if constexpr (GATHER) { if (has_next) { PG8_GLOAD(gN, nxt); } else {
#pragma unroll
            for (int _h = 0; _h < 2; ++_h)
#pragma unroll
                for (int _i = 0; _i < 2; ++_i) gN[_h][_i] = gC[_h][_i]; } }
#pragma unroll 1
        for (int t = 0; t < nt; t += 2) {
            const bool last = (t == nt - 2);
            const char* b2 = last ? nB : cB + (size_t)(t + 2) * kstep; const char* b3 = b2 + kstep;
            const int t2 = last ? 0 : t + 2;
            PG8_LDB(B0, 0, 0); PG8_LDB(B1, 0, 1); PG8_SCHED; PG8_LDA(At, 0, 0); PG8_STAGE_A(PG8_SA(1, 1), false, 1, t + 1);
            PG8_WAIT_V(8); PG8_WAIT_L(0); PG8_BAR; PG8_MMA(0, 0, At, B0); PG8_MMA(0, 1, At, B1); PG8_BAR; PG8_SCHED;
            PG8_LDA(At, 0, 1); PG8_STAGE(PG8_SB(0, 0), b2, voffB); PG8_STAGE(PG8_SB(0, 1), b2 + hstep, voffB); PG8_STAGE_A(PG8_SA(0, 0), last, 0, t2);
            PG8_WAIT_V(8); PG8_WAIT_L(0); PG8_BAR; PG8_MMA(1, 0, At, B0); PG8_MMA(1, 1, At, B1); PG8_BAR; PG8_SCHED;
            PG8_LDB(B0, 1, 0); PG8_LDB(B1, 1, 1); PG8_SCHED; PG8_LDA(At, 1, 0); PG8_STAGE_A(PG8_SA(0, 1), last, 1, t2);
            PG8_WAIT_V(8); PG8_WAIT_L(0); PG8_BAR; PG8_MMA(0, 0, At, B0); PG8_MMA(0, 1, At, B1); PG8_BAR; PG8_SCHED;
            PG8_LDA(At, 1, 1); PG8_STAGE(PG8_SB(1, 0), b3, voffB); PG8_STAGE(PG8_SB(1, 1), b3 + hstep, voffB); PG8_STAGE_A(PG8_SA(1, 0), last, 0, t2 + 1);
            PG8_WAIT_V(8); PG8_WAIT_L(0); PG8_BAR; PG8_MMA(1, 0, At, B0); PG8_MMA(1, 1, At, B1); PG8_BAR; PG8_SCHED;
        }
        if (wr == 0) PG8_BAR;
        const bool keep = E(acc, cur, wr, wc, fr, fq);
        if (!has_next) break;
        if (!keep) {
#pragma unroll
            for (int a = 0; a < 2; ++a)
#pragma unroll
                for (int b = 0; b < 2; ++b)
#pragma unroll
                    for (int m = 0; m < 4; ++m)
#pragma unroll
                        for (int n = 0; n < 2; ++n) acc[a][b][m][n] = (f32x4){0.f, 0.f, 0.f, 0.f};
        }
        cur = nxt; cA = nA; cB = nB; ++ui;
        if constexpr (GATHER) {
#pragma unroll
            for (int _h = 0; _h < 2; ++_h)
#pragma unroll
                for (int _i = 0; _i < 2; ++_i) gC[_h][_i] = gN[_h][_i]; }
        if (wr == 1) PG8_BAR;
    }
    PG8_WAIT_V(0);
    PG8_BAR;
#undef PG8_SA
#undef PG8_SB
#undef PG8_STAGE
#undef PG8_STAGE_A
#undef PG8_GLOAD
#undef PG8_LDA
#undef PG8_LDB
#undef PG8_MMA
#undef PG8_WAIT_V
#undef PG8_WAIT_L
#undef PG8_BAR
#undef PG8_SCHED
}
}

struct Params {
    const float* x; const float* g_norm1; const float* w_in; const float* g_cq; const float* w_uq; const float* w_qidx; const float* lb_logits; const float* g_hnorm;
    const float* w_pa; const float* w_pb; const float* w_o; const float* g_norm2; const float* w_grp; const float* b_grp; const float* w_exp; const float* b_exp;
    const float* w_gate; const float* w_up; const float* w_down; const float* g_final;
    float* out; unsigned char* ws;
};

struct SchedDense {
    const char* A; const char* Bt; int nM, nN, G, c; size_t tstep;
    __device__ __forceinline__ bool next(int i, pg8::Unit& u) const {
        int pm, pn; if (!pg8::static_tile((long)i * G + c, nM, nN, pm, pn)) return false;
        u.pm = pm; u.pn = pn; u.aux = 0; u.A = A + (size_t)pm * tstep; u.B = Bt + (size_t)pn * tstep; return true;
    }
};
struct SchedMerged {
    const char* A0; const char* A1; const char* B0; const char* B1; int nM, nN, G, c; size_t tstep;
    __device__ __forceinline__ bool next(int i, pg8::Unit& u) const {
        int pm, pn; if (!pg8::static_tile((long)(i >> 1) * G + c, nM, nN, pm, pn)) return false;
        const int part = i & 1; u.pm = pm; u.pn = pn; u.aux = part;
        u.A = (part ? A1 : A0) + (size_t)pm * tstep; u.B = (part ? B1 : B0) + (size_t)pn * tstep; return true;
    }
};
struct SchedMoe {
    const char* A; const char* Bt; const int* tile_e; int ntiles, NCT, G, c; size_t tstep;
    __device__ __forceinline__ bool next(int i, pg8::Unit& u) const {
        const long L = (long)i * G + c; if (L >= (long)ntiles * NCT) return false;
        const int rt = (int)(L / NCT), ct = (int)(L % NCT); const int e = __builtin_amdgcn_readfirstlane(tile_e[rt]);
        u.pm = rt; u.pn = ct; u.aux = e; u.A = A + (size_t)rt * tstep; u.B = Bt + ((size_t)e * NCT + ct) * tstep; return true;
    }
};

struct SchedMoeG {
    const char* gA; const int* tokrow; const char* Bt; const int* tile_e; int ntiles, NCT, G, c; size_t tstep;
    __device__ __forceinline__ bool next(int i, pg8::Unit& u) const {
        const long L = (long)i * G + c; if (L >= (long)ntiles * NCT) return false;
        const int rt = (int)(L / NCT), ct = (int)(L % NCT); const int e = __builtin_amdgcn_readfirstlane(tile_e[rt]);
        u.pm = rt; u.pn = ct; u.aux = e; u.A = gA; u.B = Bt + ((size_t)e * NCT + ct) * tstep; return true;
    }
};

typedef f32x4 Acc[2][2][4][2];
#define EPI_ROWS_BEGIN _Pragma("unroll") for (int ai = 0; ai < 2; ++ai) _Pragma("unroll") for (int m = 0; m < 4; ++m) { const int r = row0 + ai * 128 + m * 16;
#define EPI_ROWS_END }

struct EpiIn {
    unsigned char* ws; const float* rstd1; const float* lb; const float* ctab; const float* stab;
    __device__ __forceinline__ bool operator()(Acc& acc, const pg8::Unit& u, int wr, int wc, int fr, int fq) const {
        const int row0 = u.pm * 256 + wr * 64 + fr; const int colp = wc * 32 + 8 * fq; const int T = u.pn;
        float rs8[2][4];
#pragma unroll
        for (int ai = 0; ai < 2; ++ai)
#pragma unroll
            for (int m = 0; m < 4; ++m) rs8[ai][m] = rstd1[row0 + ai * 128 + m * 16];
        if (T < 2) {
            bf16_t* cq = (bf16_t*)(ws + WS_CQ); float* part = (float*)(ws + WS_SSQCQ);
            EPI_ROWS_BEGIN { const float rs = rs8[ai][m]; float s = 0.f;
#pragma unroll
                for (int bj = 0; bj < 2; ++bj) { const f32x4 v0 = acc[ai][bj][m][0] * rs, v1 = acc[ai][bj][m][1] * rs;
                    s += (v0[0] * v0[0] + v0[1] * v0[1]) + (v0[2] * v0[2] + v0[3] * v0[3]) + (v1[0] * v1[0] + v1[1] * v1[1]) + (v1[2] * v1[2] + v1[3] * v1[3]);
                    u32x4 w; w.x = pk2(v0[0], v0[1]); w.y = pk2(v0[2], v0[3]); w.z = pk2(v1[0], v1[1]); w.w = pk2(v1[2], v1[3]);
                    *(u32x4*)(cq + (size_t)r * QR + T * 256 + bj * 128 + colp) = w; }
                s += shx(s, 16, fq * 16 + fr); s += shx(s, 32, fq * 16 + fr);
                if (fq == 0) part[(size_t)r * 8 + T * 4 + wc] = s; } EPI_ROWS_END
        } else if (T == 2) {
            bf16_t* dst = (bf16_t*)(ws + (wc >= 2 ? WS_KIR : WS_KR)); const int c = (colp & 63);
            EPI_ROWS_BEGIN { const float rs = rs8[ai][m]; const int pos = r & (SEQ - 1);
                const f32x4 c0 = *(const f32x4*)(ctab + pos * 64 + c), c1 = *(const f32x4*)(ctab + pos * 64 + c + 4), s0 = *(const f32x4*)(stab + pos * 64 + c), s1 = *(const f32x4*)(stab + pos * 64 + c + 4);
                const f32x4 a0 = acc[ai][0][m][0] * rs, a1 = acc[ai][0][m][1] * rs, b0 = acc[ai][1][m][0] * rs, b1 = acc[ai][1][m][1] * rs;
                const f32x4 o0 = a0 * c0 - b0 * s0, o1 = a1 * c1 - b1 * s1, p0 = b0 * c0 + a0 * s0, p1 = b1 * c1 + a1 * s1;
                u32x4 w; w.x = pk2(o0[0], o0[1]); w.y = pk2(o0[2], o0[3]); w.z = pk2(o1[0], o1[1]); w.w = pk2(o1[2], o1[3]);
                *(u32x4*)(dst + (size_t)r * 128 + c) = w;
                w.x = pk2(p0[0], p0[1]); w.y = pk2(p0[2], p0[3]); w.z = pk2(p1[0], p1[1]); w.w = pk2(p1[2], p1[3]);
                *(u32x4*)(dst + (size_t)r * 128 + 64 + c) = w; } EPI_ROWS_END
        } else if (T == 3) {
            bf16_t* vv = (bf16_t*)(ws + WS_VV); float* wi = (float*)(ws + WS_WI);
            EPI_ROWS_BEGIN { const float rs = rs8[ai][m];
                const f32x4 v0 = acc[ai][0][m][0] * rs, v1 = acc[ai][0][m][1] * rs;
                u32x4 w; w.x = pk2(v0[0], v0[1]); w.y = pk2(v0[2], v0[3]); w.z = pk2(v1[0], v1[1]); w.w = pk2(v1[2], v1[3]);
                *(u32x4*)(vv + (size_t)r * 128 + colp) = w;
                if (colp < 16) { const float sc = rs * 0.02209708691207961f;
                    *(f32x4*)(wi + (size_t)r * 16 + colp) = acc[ai][1][m][0] * sc; *(f32x4*)(wi + (size_t)r * 16 + colp + 4) = acc[ai][1][m][1] * sc; } } EPI_ROWS_END
        } else if (T < 20) {
            const int seg = (T - 4) >> 2; const int cbase = ((T - 4) & 3) * 256 + colp;
            if (seg == 1) {
                float* logf = (float*)(ws + WS_LOGF);
                f32x4 lbv[2][2];
#pragma unroll
                for (int bj = 0; bj < 2; ++bj) { lbv[bj][0] = *(const f32x4*)(lb + cbase + bj * 128); lbv[bj][1] = *(const f32x4*)(lb + cbase + bj * 128 + 4); }
                EPI_ROWS_BEGIN { const float rs = rs8[ai][m];
#pragma unroll
                    for (int bj = 0; bj < 2; ++bj) { const int cc = cbase + bj * 128;
                        const f32x4 l0 = lbv[bj][0], l1 = lbv[bj][1];
                        f32x4 v0 = acc[ai][bj][m][0] * rs, v1 = acc[ai][bj][m][1] * rs;
#pragma unroll
                        for (int e = 0; e < 4; ++e) { v0[e] = __logf(l0[e] + (1.0f - l0[e]) * sigmoidf_(v0[e])); v1[e] = __logf(l1[e] + (1.0f - l1[e]) * sigmoidf_(v1[e])); }
                        *(f32x4*)(logf + (size_t)r * 1024 + cc) = v0; *(f32x4*)(logf + (size_t)r * 1024 + cc + 4) = v1; } } EPI_ROWS_END
            } else {
                bf16_t* dst = (bf16_t*)(ws + (seg == 0 ? WS_QT : (seg == 2 ? WS_VH : WS_SG)));
                EPI_ROWS_BEGIN { const float rs = rs8[ai][m];
#pragma unroll
                    for (int bj = 0; bj < 2; ++bj) { f32x4 v0 = acc[ai][bj][m][0] * rs, v1 = acc[ai][bj][m][1] * rs;
                        if (seg != 2) {
#pragma unroll
                            for (int e = 0; e < 4; ++e) { v0[e] = siluf_(v0[e]); v1[e] = siluf_(v1[e]); } }
                        u32x4 w; w.x = pk2(v0[0], v0[1]); w.y = pk2(v0[2], v0[3]); w.z = pk2(v1[0], v1[1]); w.w = pk2(v1[2], v1[3]);
                        *(u32x4*)(dst + (size_t)r * 1024 + cbase + bj * 128) = w; } } EPI_ROWS_END
            }
        } else {
            bf16_t* Rg = (bf16_t*)(ws + WS_RG); bf16_t* Sb = (bf16_t*)(ws + WS_SB); const int cc = (T - 20) * 128 + colp;
            EPI_ROWS_BEGIN { const float rs = rs8[ai][m];
                f32x4 a0 = acc[ai][0][m][0] * rs, a1 = acc[ai][0][m][1] * rs, b0 = acc[ai][1][m][0] * rs, b1 = acc[ai][1][m][1] * rs;
#pragma unroll
                for (int e = 0; e < 4; ++e) { const float ea0 = __expf(-a0[e]), eb0 = __expf(-b0[e]), ea1 = __expf(-a1[e]), eb1 = __expf(-b1[e]);
                    a0[e] = (1.0f + eb0) * __builtin_amdgcn_rcpf(1.0f + ea0); b0[e] = __builtin_amdgcn_rcpf(1.0f + eb0);
                    a1[e] = (1.0f + eb1) * __builtin_amdgcn_rcpf(1.0f + ea1); b1[e] = __builtin_amdgcn_rcpf(1.0f + eb1); }
                u32x4 w; w.x = pk2(a0[0], a0[1]); w.y = pk2(a0[2], a0[3]); w.z = pk2(a1[0], a1[1]); w.w = pk2(a1[2], a1[3]);
                *(u32x4*)(Rg + (size_t)r * DM + cc) = w;
                w.x = pk2(b0[0], b0[1]); w.y = pk2(b0[2], b0[3]); w.z = pk2(b1[0], b1[1]); w.w = pk2(b1[2], b1[3]);
                *(u32x4*)(Sb + (size_t)r * DM + cc) = w; } EPI_ROWS_END
        }
        return false;
    }
};

struct EpiQ {
    unsigned char* ws;
    __device__ __forceinline__ bool operator()(Acc& acc, const pg8::Unit& u, int wr, int wc, int fr, int fq) const {
        const int row0 = u.pm * 256 + wr * 64 + fr; const int colp = wc * 32 + 8 * fq; const int T = u.pn;
        const int head = 2 * T + (colp >> 6), c = colp & 63;
        unsigned dbase, pitchb; float osc;
        if (head < 8) { dbase = (unsigned)WS_Q + (unsigned)(head * 128 + c) * 2u; pitchb = 2048u; osc = 0.08838834764831845f; } else { dbase = (unsigned)WS_QI + (unsigned)((head - 8) * 128 + c) * 2u; pitchb = 4096u; osc = 1.0f; }
        float rs8[2][4];
#pragma unroll
        for (int ai = 0; ai < 2; ++ai) { f32x4 pa[4], pb[4];
#pragma unroll
            for (int m = 0; m < 4; ++m) { const unsigned o = (unsigned)WS_SSQCQ + (unsigned)(row0 + ai * 128 + m * 16) * 32u; pa[m] = *(const f32x4*)(ws + o); pb[m] = *(const f32x4*)(ws + o + 16u); }
#pragma unroll
            for (int m = 0; m < 4; ++m) { const float ssq = ((pa[m][0] + pa[m][1]) + (pa[m][2] + pa[m][3])) + ((pb[m][0] + pb[m][1]) + (pb[m][2] + pb[m][3]));
                rs8[ai][m] = __builtin_amdgcn_rsqf(ssq * (1.0f / QR) + EPS) * osc; } }
#pragma unroll
        for (int ai = 0; ai < 2; ++ai)
#pragma unroll
        for (int mp = 0; mp < 2; ++mp) {
            f32x4 c0[2], c1[2], s0[2], s1[2];
#pragma unroll
            for (int mm = 0; mm < 2; ++mm) { const unsigned to = (unsigned)(((row0 + ai * 128 + (2 * mp + mm) * 16) & (SEQ - 1)) * 64 + c) * 4u;
                c0[mm] = *(const f32x4*)(ws + ((unsigned)WS_COS + to)); c1[mm] = *(const f32x4*)(ws + ((unsigned)WS_COS + to + 16u)); s0[mm] = *(const f32x4*)(ws + ((unsigned)WS_SIN + to)); s1[mm] = *(const f32x4*)(ws + ((unsigned)WS_SIN + to + 16u)); }
#pragma unroll
            for (int mm = 0; mm < 2; ++mm) { const int m = 2 * mp + mm; const unsigned r = (unsigned)(row0 + ai * 128 + m * 16); const float rs = rs8[ai][m];
                const f32x4 a0 = acc[ai][0][m][0] * rs, a1 = acc[ai][0][m][1] * rs, b0 = acc[ai][1][m][0] * rs, b1 = acc[ai][1][m][1] * rs;
                const f32x4 o0 = a0 * c0[mm] - b0 * s0[mm], o1 = a1 * c1[mm] - b1 * s1[mm], p0 = b0 * c0[mm] + a0 * s0[mm], p1 = b1 * c1[mm] + a1 * s1[mm];
                u32x4 w; w.x = pk2(o0[0], o0[1]); w.y = pk2(o0[2], o0[3]); w.z = pk2(o1[0], o1[1]); w.w = pk2(o1[2], o1[3]);
                *(u32x4*)(ws + (dbase + r * pitchb)) = w;
                w.x = pk2(p0[0], p0[1]); w.y = pk2(p0[2], p0[3]); w.z = pk2(p1[0], p1[1]); w.w = pk2(p1[2], p1[3]);
                *(u32x4*)(ws + (dbase + r * pitchb + 128u)) = w; }
        }
        return false;
    }
};

struct EpiMerged {
    unsigned char* ws;
    __device__ __forceinline__ bool operator()(Acc& acc, const pg8::Unit& u, int wr, int wc, int fr, int fq) const {
        const int row0 = u.pm * 256 + wr * 64 + fr; const int colp = wc * 32 + 8 * fq;
        const bf16_t* G = (const bf16_t*)(ws + (u.aux == 0 ? WS_RG : WS_SB)); bf16_t* mg = (bf16_t*)(ws + WS_MERGED);
#pragma unroll
        for (int ai = 0; ai < 2; ++ai)
#pragma unroll
        for (int mp = 0; mp < 2; ++mp) {
            u32x4 gw[2][2];
#pragma unroll
            for (int mm = 0; mm < 2; ++mm)
#pragma unroll
                for (int bj = 0; bj < 2; ++bj) gw[mm][bj] = *(const u32x4*)(G + (size_t)(row0 + ai * 128 + (2 * mp + mm) * 16) * DM + u.pn * 256 + bj * 128 + colp);
#pragma unroll
            for (int mm = 0; mm < 2; ++mm)
#pragma unroll
                for (int bj = 0; bj < 2; ++bj) { const u32x4 w = gw[mm][bj]; const int m = 2 * mp + mm;
                    const f32x4 g0 = (f32x4){bf2f(w.x & 0xffffu), bf2f(w.x >> 16), bf2f(w.y & 0xffffu), bf2f(w.y >> 16)}, g1 = (f32x4){bf2f(w.z & 0xffffu), bf2f(w.z >> 16), bf2f(w.w & 0xffffu), bf2f(w.w >> 16)};
                    if (u.aux == 0) { acc[ai][bj][m][0] *= g0; acc[ai][bj][m][1] *= g1; }
                    else { const f32x4 v0 = acc[ai][bj][m][0] * g0, v1 = acc[ai][bj][m][1] * g1;
                        u32x4 q; q.x = pk2(v0[0], v0[1]); q.y = pk2(v0[2], v0[3]); q.z = pk2(v1[0], v1[1]); q.w = pk2(v1[2], v1[3]);
                        *(u32x4*)(mg + (size_t)(row0 + ai * 128 + m * 16) * DM + u.pn * 256 + bj * 128 + colp) = q; } }
        }
        return u.aux == 0;
    }
};

struct EpiX1 {
    unsigned char* ws; const float* x; float* x1;
    __device__ __forceinline__ bool operator()(Acc& acc, const pg8::Unit& u, int wr, int wc, int fr, int fq) const {
        const int row0 = u.pm * 256 + wr * 64 + fr; const int colp = wc * 32 + 8 * fq;
        bf16_t* x1b = (bf16_t*)(ws + WS_X1B); float* part = (float*)(ws + WS_SSQ2);
#pragma unroll
        for (int ai = 0; ai < 2; ++ai)
#pragma unroll
            for (int mp = 0; mp < 2; ++mp) {
                f32x4 xv[2][2][2];
#pragma unroll
                for (int mm = 0; mm < 2; ++mm)
#pragma unroll
                    for (int bj = 0; bj < 2; ++bj) { const size_t o = (size_t)(row0 + ai * 128 + (2 * mp + mm) * 16) * DM + u.pn * 256 + bj * 128 + colp; xv[mm][bj][0] = *(const f32x4*)(x + o); xv[mm][bj][1] = *(const f32x4*)(x + o + 4); }
#pragma unroll
                for (int mm = 0; mm < 2; ++mm) { const int m = 2 * mp + mm; const int r = row0 + ai * 128 + m * 16; float s = 0.f;
#pragma unroll
                    for (int bj = 0; bj < 2; ++bj) { const size_t o = (size_t)r * DM + u.pn * 256 + bj * 128 + colp;
                        const f32x4 v0 = acc[ai][bj][m][0] + xv[mm][bj][0], v1 = acc[ai][bj][m][1] + xv[mm][bj][1];
                        s += (v0[0] * v0[0] + v0[1] * v0[1]) + (v0[2] * v0[2] + v0[3] * v0[3]) + (v1[0] * v1[0] + v1[1] * v1[1]) + (v1[2] * v1[2] + v1[3] * v1[3]);
                        u32x4 w; w.x = pk2(v0[0], v0[1]); w.y = pk2(v0[2], v0[3]); w.z = pk2(v1[0], v1[1]); w.w = pk2(v1[2], v1[3]);
                        *(u32x4*)(x1b + o) = w; }
                    s += shx(s, 16, fq * 16 + fr); s += shx(s, 32, fq * 16 + fr);
                    if (fq == 0) part[(size_t)r * 32 + u.pn * 4 + wc] = s; }
            }
        return false;
    }
};

struct EpiGateUp {
    unsigned char* ws;
    __device__ __forceinline__ bool operator()(Acc& acc, const pg8::Unit& u, int wr, int wc, int fr, int fq) const {
        const int row0 = u.pm * 256 + wr * 64 + fr; const int colp = wc * 32 + 8 * fq;
        const float* rss = (const float*)(ws + WS_RSS); bf16_t* act = (bf16_t*)(ws + WS_ACT);
        float rs8[2][4];
#pragma unroll
        for (int ai = 0; ai < 2; ++ai)
#pragma unroll
            for (int m = 0; m < 4; ++m) rs8[ai][m] = rss[row0 + ai * 128 + m * 16];
        EPI_ROWS_BEGIN { const float rs = rs8[ai][m];
            f32x4 a0 = acc[ai][0][m][0] * rs, a1 = acc[ai][0][m][1] * rs; const f32x4 u0 = acc[ai][1][m][0] * rs, u1 = acc[ai][1][m][1] * rs;
#pragma unroll
            for (int e = 0; e < 4; ++e) { a0[e] = siluf_(a0[e]) * u0[e]; a1[e] = siluf_(a1[e]) * u1[e]; }
            u32x4 w; w.x = pk2(a0[0], a0[1]); w.y = pk2(a0[2], a0[3]); w.z = pk2(a1[0], a1[1]); w.w = pk2(a1[2], a1[3]);
            *(u32x4*)(act + (size_t)r * DEXP + u.pn * 128 + colp) = w; } EPI_ROWS_END
        return false;
    }
};

struct EpiDown {
    unsigned char* ws;
    __device__ __forceinline__ bool operator()(Acc& acc, const pg8::Unit& u, int wr, int wc, int fr, int fq) const {
        const int row0 = u.pm * 256 + wr * 64 + fr; const int colp = wc * 32 + 8 * fq;
        const float* gs = (const float*)(ws + WS_GS); bf16_t* ys = (bf16_t*)(ws + WS_YS);
        float g8[2][4];
#pragma unroll
        for (int ai = 0; ai < 2; ++ai)
#pragma unroll
            for (int m = 0; m < 4; ++m) g8[ai][m] = gs[row0 + ai * 128 + m * 16];
        EPI_ROWS_BEGIN { const float g = g8[ai][m];
#pragma unroll
            for (int bj = 0; bj < 2; ++bj) { const f32x4 v0 = acc[ai][bj][m][0] * g, v1 = acc[ai][bj][m][1] * g;
                u32x4 w; w.x = pk2(v0[0], v0[1]); w.y = pk2(v0[2], v0[3]); w.z = pk2(v1[0], v1[1]); w.w = pk2(v1[2], v1[3]);
                *(u32x4*)(ys + (size_t)r * DM + u.pn * 256 + bj * 128 + colp) = w; } } EPI_ROWS_END
        return false;
    }
};

struct EpiNull {
    __device__ __forceinline__ bool operator()(Acc& acc, const pg8::Unit& u, int wr, int wc, int fr, int fq) const {
#pragma unroll
        for (int ai = 0; ai < 2; ++ai)
#pragma unroll
            for (int bj = 0; bj < 2; ++bj)
#pragma unroll
                for (int m = 0; m < 4; ++m)
#pragma unroll
                    for (int n = 0; n < 2; ++n) asm volatile("" :: "v"(acc[ai][bj][m][n]));
        return false;
    }
};

template <int MODE> struct EpiProbeStore {
    unsigned char* ws;
    __device__ __forceinline__ bool operator()(Acc& acc, const pg8::Unit& u, int wr, int wc, int fr, int fq) const {
        const int row0 = u.pm * 256 + wr * 64 + fr; const int colp = wc * 32 + 8 * fq; unsigned char* base = ws + WS_KV;
#pragma unroll
        for (int ai = 0; ai < 2; ++ai)
#pragma unroll
            for (int m = 0; m < 4; ++m)
#pragma unroll
                for (int bj = 0; bj < 2; ++bj) { const int r = row0 + ai * 128 + m * 16;
                    u32x4 w; w.x = pk2(acc[ai][bj][m][0][0], acc[ai][bj][m][0][1]); w.y = pk2(acc[ai][bj][m][0][2], acc[ai][bj][m][0][3]); w.z = pk2(acc[ai][bj][m][1][0], acc[ai][bj][m][1][1]); w.w = pk2(acc[ai][bj][m][1][2], acc[ai][bj][m][1][3]);
                    size_t off;
                    if (MODE == 0) off = ((size_t)r * 2048 + (u.pn & 7) * 256 + bj * 128 + colp) * 2;
                    else off = ((((size_t)(u.pm * 8 + (u.pn & 7)) * 8 + (wr * 4 + wc)) * 16 + (ai * 8 + m * 2 + bj)) * 1024 + (size_t)(fq * 16 + fr) * 16) & (size_t)(64 * 1024 * 1024 - 1);
                    *(u32x4*)(base + off) = w; }
        return false;
    }
};

struct Frame { LAS unsigned char* lds; int tid, lane, wave, G, gw, NGW; };
__device__ __forceinline__ Frame make_frame(LAS unsigned char* lds, int wave) { Frame F; F.lds = lds; F.lane = opaque_i(lane_id()); F.wave = wave; F.tid = wave * 64 + F.lane; F.G = gridDim.x; F.gw = blockIdx.x * 8 + F.wave; F.NGW = F.G * 8; return F; }
constexpr int LDS_PHASE_BYTES = 148480;
constexpr int LDS_BYTES = LDS_PHASE_BYTES + 256;

#define XB_TMO      128
#define XB_XCNT(j)  (256  + 64 * (j))
#define XB_XSUB(j)  (1280 + 64 * (j))
#define XB_XGEN(j)  (2304 + 64 * (j))
#define XB_TOP      3328
#define XB_TOPGEN   3392
#define XCD_BAR_WORDS 3456
#define XB_SPIN_CAP (1u << 22)
__device__ __forceinline__ unsigned xb_ld(unsigned* p)              { return __hip_atomic_load(p, __ATOMIC_RELAXED, __HIP_MEMORY_SCOPE_AGENT); }
__device__ __forceinline__ unsigned xb_add(unsigned* p, unsigned v) { return __hip_atomic_fetch_add(p, v, __ATOMIC_RELAXED, __HIP_MEMORY_SCOPE_AGENT); }
__device__ __forceinline__ unsigned xb_xcc_id() { return (unsigned)__builtin_amdgcn_s_getreg((3 << 11) | 20) & 0xFu; }
#define XB_SPIN(cond, bar) do { unsigned _sp = 0; while (cond) { __builtin_amdgcn_s_sleep(1); \
    if ((++_sp & 255u) == 0u) { if (xb_ld(&(bar)[XB_TMO])) break; if (_sp > XB_SPIN_CAP) { atomicAdd(&(bar)[XB_TMO], 1u); break; } } } } while (0)
struct XcdBarrier { unsigned* bar; unsigned x; volatile LAS unsigned* st; int wave; };
__device__ __forceinline__ XcdBarrier xcd_barrier_post(unsigned* bar, volatile LAS unsigned* st, int wave) {
    XcdBarrier b; b.bar = bar; b.x = xb_xcc_id(); b.st = st; b.wave = wave;
    if (wave == 0 && lane_id() == 0) (void)xb_add(&bar[XB_XCNT(b.x)], 1u);
    return b;
}
__device__ __forceinline__ void xcd_barrier_complete(unsigned* bar, unsigned x, unsigned& nloc, unsigned& nx) {
    const unsigned G = gridDim.x * gridDim.y * gridDim.z;
    unsigned sum, cnt, mine, sp = 0u;
    for (;;) {
        sum = 0u; cnt = 0u; mine = 0u;
#pragma unroll
        for (unsigned j = 0; j < 16; ++j) { const unsigned c = xb_ld(&bar[XB_XCNT(j)]); sum += c; cnt += (c > 0u) ? 1u : 0u; mine = (j == x) ? c : mine; }
        if (sum == G) break;
        __builtin_amdgcn_s_sleep(1);
        if ((++sp & 255u) == 0u) { if (xb_ld(&bar[XB_TMO])) break; if (sp > XB_SPIN_CAP) { atomicAdd(&bar[XB_TMO], 1u); break; } }
    }
    nloc = mine > 0u ? mine : 1u; nx = cnt > 0u ? cnt : 1u;
}
__device__ __forceinline__ void xcd_barrier(const XcdBarrier& b) {
    asm volatile("s_waitcnt vmcnt(0)" ::: "memory");
    __syncthreads();
    if (b.wave == 0 && lane_id() == 0) {
        unsigned* bar = b.bar;
        __builtin_amdgcn_s_waitcnt(0);
        unsigned nloc = b.st[0], nx = b.st[1];
        if (nloc == 0u) { xcd_barrier_complete(bar, b.x, nloc, nx); b.st[0] = nloc; b.st[1] = nx; }
        const unsigned old = xb_add(&bar[XB_XSUB(b.x)], 1u);
        const unsigned gen = old / nloc;
        if (old + 1u == (gen + 1u) * nloc) {
            __builtin_amdgcn_fence(__ATOMIC_RELEASE, "agent");
            asm volatile("s_waitcnt vmcnt(0)" ::: "memory");
            const unsigned og = xb_add(&bar[XB_TOP], 1u);
            const unsigned tg = og / nx;
            if (og + 1u == (tg + 1u) * nx) xb_add(&bar[XB_TOPGEN], 1u);
            else XB_SPIN(xb_ld(&bar[XB_TOPGEN]) == tg, bar);
            __builtin_amdgcn_fence(__ATOMIC_ACQUIRE, "agent");
            xb_add(&bar[XB_XGEN(b.x)], 1u);
            asm volatile("s_waitcnt vmcnt(0)" ::: "memory");
        } else {
            XB_SPIN(xb_ld(&bar[XB_XGEN(b.x)]) == gen, bar);
            __builtin_amdgcn_fence(__ATOMIC_ACQUIRE, "agent");
            asm volatile("s_waitcnt vmcnt(0)" ::: "memory");
        }
    }
    __syncthreads();
}

typedef short s16x4 __attribute__((ext_vector_type(4)));
struct TrDesc { const float* src; int ld, c0, nvalid; const float* gain; bf16_t* dst; int Kd, r0, k0; };
__device__ __forceinline__ void tr_load(const TrDesc& d, f32x4 (&v)[16], float (&gv)[16], int lane) {
    const int lg = lane >> 4, li = lane & 15; const bool ok = (4 * li) < d.nvalid;
#pragma unroll
    for (int i = 0; i < 16; ++i) { const int k = 4 * i + lg; v[i] = ok ? *(const f32x4*)(d.src + (size_t)(d.k0 + k) * d.ld + d.c0 + 4 * li) : (f32x4){0.f, 0.f, 0.f, 0.f}; }
    if (d.gain) {
#pragma unroll
        for (int i = 0; i < 16; ++i) gv[i] = d.gain[d.k0 + 4 * i + lg]; }
}
__device__ __forceinline__ void tr_to_lds(const TrDesc& d, f32x4 (&v)[16], const float (&gv)[16], LAS unsigned char* scr, int lane) {
    const int lg = lane >> 4, li = lane & 15;
    if (d.gain) {
#pragma unroll
        for (int i = 0; i < 16; ++i) v[i] *= gv[i]; }
#pragma unroll
    for (int i = 0; i < 16; ++i) { const int k = 4 * i + lg; u32x2 w; w.x = pk2(v[i][0], v[i][1]); w.y = pk2(v[i][2], v[i][3]);
        *(LAS u32x2*)(scr + k * 128 + ((((li >> 2) ^ (k & 3) ^ ((k >> 3) & 1)) << 5) | ((li & 3) * 8))) = w; }
}
__device__ __forceinline__ void tr_from_lds(const TrDesc& d, LAS unsigned char* scr, int lane) {
    const int lg = lane >> 4, li = lane & 15;
    LDS_WAIT(); asm volatile("" ::: "memory");
    const int q = li >> 2, p = li & 3;
#pragma unroll
    for (int nb = 0; nb < 4; ++nb)
#pragma unroll
        for (int ch = 0; ch < 2; ++ch) { const int c = 4 * ch + lg; const int ka = 8 * c + q, kb = ka + 4;
            const s16x4 lo = __builtin_amdgcn_ds_read_tr16_b64_v4i16((LAS s16x4*)(scr + ka * 128 + ((nb ^ (ka & 3) ^ ((ka >> 3) & 1)) << 5) + 8 * p));
            const s16x4 hi = __builtin_amdgcn_ds_read_tr16_b64_v4i16((LAS s16x4*)(scr + kb * 128 + ((nb ^ (kb & 3) ^ ((kb >> 3) & 1)) << 5) + 8 * p));
            const u32x2 l2 = __builtin_bit_cast(u32x2, lo), h2 = __builtin_bit_cast(u32x2, hi); u32x4 o; o.x = l2.x; o.y = l2.y; o.z = h2.x; o.w = h2.y;
            *(u32x4*)(d.dst + (size_t)(d.r0 + 16 * nb + li) * d.Kd + d.k0 + 8 * c) = o; }
    LDS_WAIT(); asm volatile("" ::: "memory");
}
template <class DescFn>
__device__ __forceinline__ void tr_loop(int first, int hi, int stride, LAS unsigned char* scr, int lane, const DescFn& D) {
    if (first >= hi) return;
    f32x4 v[16]; float gv[16];
    TrDesc cur = D(first); tr_load(cur, v, gv, lane);
#pragma unroll 1
    for (int it = first;;) {
        tr_to_lds(cur, v, gv, scr, lane);
        const int nx = it + stride; const bool has = nx < hi; TrDesc nd = cur;
        if (has) { nd = D(nx); tr_load(nd, v, gv, lane); }
        tr_from_lds(cur, scr, lane);
        if (!has) break;
        cur = nd; it = nx;
    }
}
__device__ __forceinline__ void map_in(int G64, int& src0, int& nv) {
    nv = 64;
    if (G64 < 8) { src0 = 64 * G64; }
    else if (G64 < 12) { src0 = (G64 == 8) ? 512 : (G64 == 9) ? 768 : (G64 == 10) ? 576 : 832; }
    else if (G64 < 14) { src0 = 640 + 64 * (G64 - 12); }
    else if (G64 == 14) { src0 = 896; nv = 16; }
    else if (G64 == 15) { src0 = 0; nv = 0; }
    else if (G64 < 80) { src0 = 912 + 64 * (G64 - 16); }
    else { const int q = 64 * (G64 - 80); const int j = q >> 8, bj = (q >> 7) & 1, pos0 = q & 127; src0 = (bj ? 7056 : 5008) + 128 * j + pos0; }
}
__device__ __forceinline__ void sincos_d(float angf, float& c, float& s) {
    const double x = (double)angf; const double n = rint(x * 0.63661977236758134308);
    double r = fma(-n, 1.57079632679489655800e+00, x); r = fma(-n, 6.12323399573676603587e-17, r);
    const double r2 = r * r;
    double sp = 1.0 / 6227020800.0; sp = fma(sp, r2, -1.0 / 39916800.0); sp = fma(sp, r2, 1.0 / 362880.0); sp = fma(sp, r2, -1.0 / 5040.0); sp = fma(sp, r2, 1.0 / 120.0); sp = fma(sp, r2, -1.0 / 6.0);
    const double sn = fma(r * r2, sp, r);
    double cp = -1.0 / 87178291200.0; cp = fma(cp, r2, 1.0 / 479001600.0); cp = fma(cp, r2, -1.0 / 3628800.0); cp = fma(cp, r2, 1.0 / 40320.0); cp = fma(cp, r2, -1.0 / 720.0); cp = fma(cp, r2, 1.0 / 24.0); cp = fma(cp, r2, -0.5);
    const double cs = fma(r2, cp, 1.0);
    const int q = ((int)n) & 3;
    const double cc = (q == 0) ? cs : (q == 1) ? -sn : (q == 2) ? -cs : sn;
    const double ss = (q == 0) ? sn : (q == 1) ? cs : (q == 2) ? -sn : -cs;
    c = (float)cc; s = (float)ss;
}
__device__ __forceinline__ void p0_prep(const Frame& F, const Params& P) {
    unsigned char* ws = P.ws;
    LAS unsigned char* scr = F.lds + F.wave * 16384;
    const int gtid = blockIdx.x * 512 + F.tid, GT = F.G * 512;
    if (gtid < 1024) ((int*)(ws + WS_CTL))[gtid] = 0;
    if (gtid < 1024) ((float*)(ws + WS_LB))[gtid] = 1.0f / (1.0f + expf(P.lb_logits[1024 + gtid] - P.lb_logits[gtid]));
    for (int i = gtid; i < SEQ * 64; i += GT) { const int pos = i >> 6, j = i & 63;
        const float inv = (float)(1.0 / pow(10000.0, (double)(2 * j) / 128.0)); const float ang = (float)pos * inv; float c, s; sincos_d(ang, c, s);
        ((float*)(ws + WS_COS))[i] = c; ((float*)(ws + WS_SIN))[i] = s; }
    for (int i = gtid; i < 48 * DM; i += GT) { const int j = i / DM, k = i % DM;
        const float v = (j < 4) ? P.w_grp[k * 4 + j] : (j < 36) ? P.w_exp[k * 32 + (j - 4)] : 0.f;
        ((bf16_t*)(ws + WS_WRT))[i] = (bf16_t)f2bf(v * P.g_norm2[k]); }
    constexpr int I_IN = 32 * 144;
    tr_loop(F.gw, I_IN, F.NGW, scr, F.lane, [&](int it) { const int kb = it / 144, nb = it % 144; int src0, nv; map_in(nb, src0, nv);
        TrDesc d; d.src = P.w_in; d.ld = DIN; d.c0 = src0; d.nvalid = nv; d.gain = P.g_norm1; d.dst = (bf16_t*)(ws + WS_WTIN); d.Kd = DM; d.r0 = 64 * nb; d.k0 = 64 * kb; return d; });
    for (int m = F.gw; m < NTOK; m += F.NGW) {
        const f32x4* xr = (const f32x4*)(P.x + (size_t)m * DM) + F.lane; f32x4 v[8]; float s = 0.f;
#pragma unroll
        for (int j = 0; j < 8; ++j) { v[j] = xr[64 * j]; s += (v[j][0] * v[j][0] + v[j][1] * v[j][1]) + (v[j][2] * v[j][2] + v[j][3] * v[j][3]); }
        s = wave_sum(s, F.lane);
        if (F.lane == 0) ((float*)(ws + WS_RSTD1))[m] = 1.0f / sqrtf(s * (1.0f / DM) + EPS);
        u32x2* o = (u32x2*)((bf16_t*)(ws + WS_XB) + (size_t)m * DM) + F.lane;
#pragma unroll
        for (int j = 0; j < 8; ++j) { u32x2 w; w.x = pk2(v[j][0], v[j][1]); w.y = pk2(v[j][2], v[j][3]); o[64 * j] = w; }
    }
}
__device__ __forceinline__ void conv_gateup(const Frame& F, const Params& P, int lo, int hi) {
    LAS unsigned char* scr = F.lds + F.wave * 16384;
    tr_loop(lo + F.gw, hi, F.NGW, scr, F.lane, [&](int it) { const int e = it >> 9, r = it & 511, kb = r >> 4, nb = r & 15;
        const int p0 = 64 * nb, T = p0 >> 8, bj = (p0 >> 7) & 1, pos = p0 & 127, col = 128 * T + pos;
        TrDesc d; d.src = (bj ? P.w_up : P.w_gate) + (size_t)e * DM * DEXP; d.ld = DEXP; d.c0 = col; d.nvalid = 64; d.gain = P.g_norm2; d.dst = (bf16_t*)(P.ws + WS_WGUT) + (size_t)e * 1024 * DM; d.Kd = DM; d.r0 = p0; d.k0 = 64 * kb; return d; });
}
__device__ __forceinline__ void conv_down_sub(const Frame& F, const Params& P, int lo, int hi, int first, int stride) {
    LAS unsigned char* scr = F.lds + F.wave * 16384;
    tr_loop(lo + first, hi, stride, scr, F.lane, [&](int it) { const int e = it >> 8, r = it & 255, kb = r >> 5, nb = r & 31;
        TrDesc d; d.src = P.w_down + (size_t)e * DEXP * DM; d.ld = DM; d.c0 = 64 * nb; d.nvalid = 64; d.gain = nullptr; d.dst = (bf16_t*)(P.ws + WS_WDT) + (size_t)e * DM * DEXP; d.Kd = DEXP; d.r0 = 64 * nb; d.k0 = 64 * kb; return d; });
}
__device__ __forceinline__ void conv_down(const Frame& F, const Params& P, int lo, int hi) {
    LAS unsigned char* scr = F.lds + F.wave * 16384;
    tr_loop(lo + F.gw, hi, F.NGW, scr, F.lane, [&](int it) { const int e = it >> 8, r = it & 255, kb = r >> 5, nb = r & 31;
        TrDesc d; d.src = P.w_down + (size_t)e * DEXP * DM; d.ld = DM; d.c0 = 64 * nb; d.nvalid = 64; d.gain = nullptr; d.dst = (bf16_t*)(P.ws + WS_WDT) + (size_t)e * DM * DEXP; d.Kd = DEXP; d.r0 = 64 * nb; d.k0 = 64 * kb; return d; });
}

__device__ __forceinline__ void conv_small(const Frame& F, const Params& P, int lo, int hi) {
    unsigned char* ws = P.ws; LAS unsigned char* scr = F.lds + F.wave * 16384;
    constexpr int I_QQ = 8 * 48, I_PA = 16 * 32, I_O = 32 * 32, NIT = I_QQ + 2 * I_PA + I_O;
    tr_loop(lo + F.gw, hi < NIT ? hi : NIT, F.NGW, scr, F.lane, [&](int it) { TrDesc d; d.nvalid = 64;
        int r = it;
        if (r < I_QQ) { const int kb = r / 48, nb = r % 48; const int p0 = 64 * nb, T = p0 >> 8, bj = (p0 >> 7) & 1, pos = p0 & 127, head = 2 * T + (pos >> 6), col = (pos & 63) + 64 * bj;
            d.gain = P.g_cq; d.dst = (bf16_t*)(ws + WS_WTQQ); d.Kd = QR; d.r0 = p0; d.k0 = 64 * kb;
            if (head < 8) { d.src = P.w_uq; d.ld = 1024; d.c0 = head * 128 + col; } else { d.src = P.w_qidx; d.ld = 2048; d.c0 = (head - 8) * 128 + col; }
            return d; }
        r -= I_QQ; d.gain = nullptr;
        if (r < I_PA) { const int kb = r / 32, nb = r % 32; d.src = P.w_pa; d.ld = DM; d.c0 = 64 * nb; d.dst = (bf16_t*)(ws + WS_WTPA); d.Kd = 1024; d.r0 = 64 * nb; d.k0 = 64 * kb; return d; }
        r -= I_PA;
        if (r < I_PA) { const int kb = r / 32, nb = r % 32; d.src = P.w_pb; d.ld = DM; d.c0 = 64 * nb; d.dst = (bf16_t*)(ws + WS_WTPB); d.Kd = 1024; d.r0 = 64 * nb; d.k0 = 64 * kb; return d; }
        r -= I_PA;
        { const int kb = r / 32, nb = r % 32; d.src = P.w_o; d.ld = DM; d.c0 = 64 * nb; d.dst = (bf16_t*)(ws + WS_WTO); d.Kd = DM; d.r0 = 64 * nb; d.k0 = 64 * kb; return d; } });
}

#ifndef P3_NOBAR_PROBE
#define P3_NOBAR_PROBE 0
#endif
__device__ __forceinline__ unsigned key16(unsigned u) { return (u & 0x8000u) ? (~u & 0xffffu) : (u | 0x8000u); }
__device__ __forceinline__ void p3_task(const Frame& F, const Params& P, int b, int blk, bool do_sel) {
    unsigned char* ws = P.ws; LAS unsigned char* lds = F.lds;
    const bf16_t* qi = (const bf16_t*)(ws + WS_QI); const bf16_t* kir = (const bf16_t*)(ws + WS_KIR); const float* wi = (const float*)(ws + WS_WI);
    unsigned short* sel = (unsigned short*)(ws + WS_SEL); int* nsel = (int*)(ws + WS_NSEL);
    const int lane = F.lane, w = F.wave, tid = F.tid; const int t0 = 16 * blk; const int hb = lane >> 5, r = lane & 31;
    constexpr int P3_PITCH = 4096 + 32;
    LAS _Float16* sc = (LAS _Float16*)lds;
    LAS unsigned char* kb = lds + 16 * P3_PITCH * 2;
    bf16x8 af[8];
    { const size_t tokA = (size_t)b * SEQ + t0 + 2 * w + ((r >> 2) & 1); const int head = (r & 3) + 4 * (r >> 3); const bf16_t* p = qi + (tokA * 16 + head) * 128 + 8 * hb;
#pragma unroll
      for (int s = 0; s < 8; ++s) af[s] = *(const bf16x8*)(p + 16 * s); }
    float wreg[16];
    { const float* p = wi + ((size_t)b * SEQ + t0 + 2 * w + hb) * 16;
#pragma unroll
      for (int q = 0; q < 4; ++q) { const f32x4 v = *(const f32x4*)(p + 4 * q); wreg[4 * q] = v[0]; wreg[4 * q + 1] = v[1]; wreg[4 * q + 2] = v[2]; wreg[4 * q + 3] = v[3]; } }
    const int ntiles = (t0 + 16 + 31) >> 5;
    const int skey = tid >> 4, schunk = tid & 15; const unsigned soff = (unsigned)(skey * 256 + ((schunk ^ (skey & 15)) * 16));
    const unsigned kgo = (unsigned)WS_KIR + (((unsigned)b * SEQ + skey) * 128u + 8u * schunk) * 2u;
    __syncthreads();
    u32x4 st0 = *(const u32x4*)(ws + kgo), st1 = st0, st2 = st0;
    if (1 < ntiles) st1 = *(const u32x4*)(ws + kgo + 8192u);
    if (2 < ntiles) st2 = *(const u32x4*)(ws + kgo + 16384u);
    *(LAS u32x4*)(kb + soff) = st0;
    if (3 < ntiles) st0 = *(const u32x4*)(ws + kgo + 3u * 8192u);
    bf16x8 bqA[8], bqB[8]; f32x16 accA, accB;
#pragma unroll
    for (int e = 0; e < 16; ++e) { accA[e] = 0.f; accB[e] = 0.f; }
#pragma unroll
    for (int s = 0; s < 8; ++s) { bqA[s] = (bf16x8){0, 0, 0, 0, 0, 0, 0, 0}; bqB[s] = (bf16x8){0, 0, 0, 0, 0, 0, 0, 0}; }
#define P3_EPI2(ACC, S0, SUM) { const f32x2 rl_ = (f32x2){__int_as_float(max(__float_as_int(ACC[2 * (S0)]), 0)), __int_as_float(max(__float_as_int(ACC[2 * (S0) + 1]), 0))};     \
        SUM = __builtin_elementwise_fma(rl_, (f32x2){wreg[2 * (S0)], wreg[2 * (S0) + 1]}, SUM); }
#define P3_ITER(IEXPR, PAR, BQR, BQU, ACCW, ACCE, ST) { const int i_ = (IEXPR);     \
        if (P3_NOBAR_PROBE && !do_sel) { } else __syncthreads(); \
        __builtin_amdgcn_sched_barrier(0);     \
        *(LAS u32x4*)(kb + (1 - (PAR)) * 8192 + soff) = ST;     \
        { const int tl_ = (i_ + 4 < ntiles) ? (i_ + 4) : (ntiles - 1); ST = *(const u32x4*)((ws + (size_t)tl_ * 8192u) + kgo); } \
        _Pragma("unroll") for (int s = 0; s < 8; ++s) BQR[s] = *(const LAS bf16x8*)(kfrag[s] + (PAR) * 8192); \
        { f32x2 s2_ = (f32x2){0.f, 0.f}; \
            _Pragma("unroll") for (int s = 0; s < 8; ++s) { \
                if (s == 0) ACCW = __builtin_amdgcn_mfma_f32_32x32x16_bf16(af[0], BQU[0], zero16, 0, 0, 0); \
                else ACCW = __builtin_amdgcn_mfma_f32_32x32x16_bf16(af[s], BQU[s], ACCW, 0, 0, 0); \
                P3_EPI2(ACCE, s, s2_) \
                __builtin_amdgcn_sched_group_barrier(0x008, 1, 0); __builtin_amdgcn_sched_group_barrier(0x100, 1, 0); __builtin_amdgcn_sched_group_barrier(0x002, 3, 0); } \
            { const int ts_ = ((i_ >= 2) && (i_ - 2 < ntiles)) ? (i_ - 2) : 128;     \
              scrow[32 * ts_] = (_Float16)(s2_[0] + s2_[1]); } } \
        __builtin_amdgcn_sched_barrier(0); LDS_WAIT(); }
    f32x16 zero16;
#pragma unroll
    for (int e = 0; e < 16; ++e) zero16[e] = 0.f;
    const LAS unsigned char* kfrag[8];
#pragma unroll
    for (int s = 0; s < 8; ++s) kfrag[s] = kb + r * 256 + (((2 * s + hb) ^ (r & 15)) * 16);
    LAS _Float16* scrow = sc + (2 * w + hb) * P3_PITCH + r;
    for (int i = 0; i <= ntiles + 1; i += 6) {
        P3_ITER(i, 0, bqA, bqB, accB, accA, st1)
        P3_ITER(i + 1, 1, bqB, bqA, accA, accB, st2)
        P3_ITER(i + 2, 0, bqA, bqB, accB, accA, st0)
        P3_ITER(i + 3, 1, bqB, bqA, accA, accB, st1)
        P3_ITER(i + 4, 0, bqA, bqB, accB, accA, st2)
        P3_ITER(i + 5, 1, bqB, bqA, accA, accB, st0)
    }
#undef P3_ITER
#undef P3_EPI2
    if (!do_sel) return;
    typedef short s16x2 __attribute__((ext_vector_type(2)));
    for (int i = 0; i < 2; ++i) {
        const int t = t0 + 2 * w + i; const size_t tok = (size_t)b * SEQ + t; const int n = t + 1;
        unsigned short* so = sel + tok * 256;
        if (n <= 256) {
#pragma unroll
            for (int j = 0; j < 4; ++j) { const int s = 64 * j + lane; if (s < n) so[s] = (unsigned short)s; }
            if (lane == 0) nsel[tok] = n;
            continue;
        }
        LAS unsigned short* row = (LAS unsigned short*)(sc + (2 * w + i) * P3_PITCH);
        const int nceil = (n + 127) & ~127;
        for (int s = n + lane; s < nceil; s += 64) row[s] = 0xFC00u;
        LDS_WAIT(); __builtin_amdgcn_wave_barrier();
        s16x2 e[32];
#pragma unroll
        for (int j2 = 0; j2 < 32; ++j2) {
            if (128 * j2 < n) { const s16x2 u = *(const LAS s16x2*)(row + 128 * j2 + 2 * lane);
                const s16x2 m = u >> 15; const s16x2 k16 = u ^ (m | (s16x2){(short)0x8000, (short)0x8000});
                e[j2] = __builtin_bit_cast(s16x2, (__builtin_bit_cast(unsigned, k16) >> 1) & 0x7fff7fffu); }
            else e[j2] = (s16x2){0, 0};
        }
#define P3_COUNT_LT(C, OUT) { const s16x2 c2_ = (s16x2){(short)(C), (short)(C)}; s16x2 a_ = (s16x2){0, 0}; \
            _Pragma("unroll") for (int j2 = 0; j2 < 32; ++j2) { if (128 * j2 < n) a_ += (e[j2] - c2_) >> 15; } \
            OUT = -((int)a_[0] + (int)a_[1]); }
        const int nel = nceil;
        int thr = 0;
#pragma unroll 1
        for (int bit = 14; bit >= 0; --bit) { const int cand = thr | (1 << bit); int lt; P3_COUNT_LT(cand, lt);
            lt = wave_sum_i(lt, lane); if (nel - lt >= 256) thr = cand; }
        int lt0, lt1; P3_COUNT_LT(thr, lt0); P3_COUNT_LT(thr + 1, lt1);
#undef P3_COUNT_LT
        const int held = 2 * ((nceil + 127) >> 7);
        const int cgt = held - lt1, ceq = lt1 - lt0;
        int pg = cgt, pe = ceq;
#pragma unroll
        for (int o = 1; o < 64; o <<= 1) { const int a = shl_i(pg, lane - o, lane), c = shl_i(pe, lane - o, lane); if (lane >= o) { pg += a; pe += c; } }
        const int ngt = shl_i(pg, 63, lane); const int need = 256 - ngt;
        const int eqb = pe - ceq;
        const int take_eq = max(0, min(ceq, need - eqb));
        int pos = (pg - cgt) + min(eqb, need); int eqt = 0;
#pragma unroll
        for (int j2 = 0; j2 < 32; ++j2) {
            if (128 * j2 < n) {
#pragma unroll
                for (int h2 = 0; h2 < 2; ++h2) { const int k = (int)e[j2][h2];
                    const bool iseq = (k == thr); const bool take = (k > thr) || (iseq && eqt < take_eq);
                    if (take) { so[pos] = (unsigned short)(128 * j2 + 2 * lane + h2); ++pos; if (iseq) ++eqt; } }
            }
        }
        if (lane == 0) nsel[tok] = 256;
    }
}

#ifndef P4_PROBE
#define P4_PROBE 0
#endif
__device__ __forceinline__ void p4_token(const Frame& F, const Params& P, int tok, const int n, const u32x2 selrow, const bool rep) {
    const unsigned char* ws = P.ws;
    const int lane = F.lane; const int fr = lane & 15, g = lane >> 4;
    LAS unsigned char* vb0 = F.lds + F.wave * 16384;
    LAS unsigned short* selL = (LAS unsigned short*)(F.lds + 131072 + F.wave * 512);
    const unsigned bbase = (unsigned)(tok >> 12) * SEQ;
    *(LAS u32x2*)(selL + 4 * lane) = selrow;
    LDS_WAIT(); __builtin_amdgcn_wave_barrier();
    const int nch = (n + 31) >> 5;
#define P4_DMA(CH) do { LAS unsigned char* vb_ = vb0 + ((CH) & 1) * 8192; \
        _Pragma("unroll") for (int i_ = 0; i_ < 8; ++i_) { const int rho_ = 4 * i_ + g; const int slot_ = 32 * (CH) + rho_; const unsigned key_ = (slot_ < n) ? (unsigned)selL[slot_] : 0u; \
            __builtin_amdgcn_global_load_lds((const unsigned*)(ws + (unsigned)WS_VV + (bbase + key_) * 256u + 16u * (unsigned)(fr ^ (2 * (rho_ & 7)))), (LAS unsigned*)(vb_ + 1024 * i_), 16, 0, 0); } } while (0)
    const bool do_pv = !(P4_PROBE == 2 && rep);
#define P4_KDMA(CH) do { LAS unsigned char* kb_ = vb0 + ((CH) & 3) * 4096; \
        _Pragma("unroll") for (int i_ = 0; i_ < 4; ++i_) { const int rho_ = 4 * i_ + g; const int slot_ = 16 * (CH) + rho_; const unsigned key_ = (slot_ < n) ? (unsigned)selL[slot_] : 0u; \
            __builtin_amdgcn_global_load_lds((const unsigned*)(ws + (unsigned)WS_KR + (bbase + key_) * 256u + 16u * (unsigned)(fr ^ rho_)), (LAS unsigned*)(kb_ + 1024 * i_), 16, 0, 0); } } while (0)
    bf16x8 qf[4];
#pragma unroll
    for (int s = 0; s < 4; ++s) { if (fr < 8) qf[s] = *(const bf16x8*)(ws + (unsigned)WS_Q + ((unsigned)tok * 1024u + fr * 128u + 32u * s + 8u * g) * 2u); else qf[s] = (bf16x8){0, 0, 0, 0, 0, 0, 0, 0}; }
    f32x4 acc[16];
    P4_KDMA(0); P4_KDMA(1); P4_KDMA(2);
#pragma unroll
    for (int T = 0; T < 16; ++T) {
        if (T + 3 < 16) P4_KDMA(T + 3);
        if (T <= 12) asm volatile("s_waitcnt vmcnt(12)" ::: "memory"); else if (T == 13) asm volatile("s_waitcnt vmcnt(8)" ::: "memory"); else if (T == 14) asm volatile("s_waitcnt vmcnt(4)" ::: "memory"); else asm volatile("s_waitcnt vmcnt(0)" ::: "memory");
        const LAS unsigned char* kc = vb0 + (T & 3) * 4096 + fr * 256; f32x4 a = (f32x4){0.f, 0.f, 0.f, 0.f};
#pragma unroll
        for (int s = 0; s < 4; ++s) a = __builtin_amdgcn_mfma_f32_16x16x32_bf16(*(const LAS bf16x8*)(kc + (((4 * s + g) ^ fr) * 16)), qf[s], a, 0, 0, 0);
        acc[T] = a;
        LDS_WAIT();
    }
#undef P4_KDMA
    if (do_pv) { P4_DMA(0); P4_DMA(1); }
    float mx = -3.0e38f;
#pragma unroll
    for (int T = 0; T < 16; ++T)
#pragma unroll
        for (int e = 0; e < 4; ++e) { const int slot = 16 * T + 4 * g + e; const float v = (slot < n) ? acc[T][e] : -3.0e38f; acc[T][e] = v; mx = fmaxf(mx, v); }
    mx = fmaxf(mx, shx(mx, 16, lane)); mx = fmaxf(mx, shx(mx, 32, lane));
    float sum = 0.f; unsigned pb[8][4];
#pragma unroll
    for (int T = 0; T < 16; ++T) { float p[4];
#pragma unroll
        for (int e = 0; e < 4; ++e) { p[e] = __expf(acc[T][e] - mx); sum += p[e]; }
        pb[T >> 1][(T & 1) * 2] = pk2(p[0], p[1]); pb[T >> 1][(T & 1) * 2 + 1] = pk2(p[2], p[3]); }
    sum += shx(sum, 16, lane); sum += shx(sum, 32, lane);
    const float inv = 1.0f / sum;
    f32x4 o[8];
#pragma unroll
    for (int dt = 0; dt < 8; ++dt) o[dt] = (f32x4){0.f, 0.f, 0.f, 0.f};
    const int q4 = fr >> 2, p4 = fr & 3;
#pragma unroll
    for (int c = 0; c < 8; ++c) {
        if (c < nch && do_pv) {
            if (c + 1 < 8) asm volatile("s_waitcnt vmcnt(8)" ::: "memory"); else asm volatile("s_waitcnt vmcnt(0)" ::: "memory");
            const LAS unsigned char* vb = vb0 + (c & 1) * 8192;
            u32x4 bw; bw.x = pb[c][0]; bw.y = pb[c][1]; bw.z = pb[c][2]; bw.w = pb[c][3]; const bf16x8 bfrag = __builtin_bit_cast(bf16x8, bw);
            const int r0 = 4 * g + q4, r1 = 16 + 4 * g + q4;
#pragma unroll
            for (int dt = 0; dt < 8; ++dt) {
                const int ch = 2 * dt + (p4 >> 1);
                const s16x4 lo = __builtin_amdgcn_ds_read_tr16_b64_v4i16((LAS s16x4*)(vb + r0 * 256 + ((ch ^ (2 * (r0 & 7))) * 16) + 8 * (p4 & 1)));
                const s16x4 hi = __builtin_amdgcn_ds_read_tr16_b64_v4i16((LAS s16x4*)(vb + r1 * 256 + ((ch ^ (2 * (r1 & 7))) * 16) + 8 * (p4 & 1)));
                const u32x2 l2 = __builtin_bit_cast(u32x2, lo), h2 = __builtin_bit_cast(u32x2, hi); u32x4 aw; aw.x = l2.x; aw.y = l2.y; aw.z = h2.x; aw.w = h2.y;
                o[dt] = __builtin_amdgcn_mfma_f32_16x16x32_bf16(__builtin_bit_cast(bf16x8, aw), bfrag, o[dt], 0, 0, 0); }
            LDS_WAIT();
            if (c + 2 < 8) { if (c + 2 < nch) P4_DMA(c + 2); else { P4_DMA(c + 2); } }
        }
    }
    asm volatile("s_waitcnt vmcnt(0)" ::: "memory");
#undef P4_DMA
    if (fr < 8 && !(P4_PROBE != 0 && rep)) {
#pragma unroll
        for (int dt = 0; dt < 8; ++dt) { u32x2 w; w.x = pk2(o[dt][0] * inv, o[dt][1] * inv); w.y = pk2(o[dt][2] * inv, o[dt][3] * inv);
            *(u32x2*)(P.ws + (unsigned)WS_YATT + ((unsigned)tok * 1024u + fr * 128u + 16u * dt + 4u * g) * 2u) = w; }
    }
    __builtin_amdgcn_wave_barrier();
}

__device__ __forceinline__ void p4_tokens(const Frame& F, const Params& P, const bool rep) {
    const unsigned char* ws = P.ws; int tok = F.gw; if (tok >= NTOK) return;
    int n = ((const int*)(ws + WS_NSEL))[tok]; u32x2 row = *(const u32x2*)(ws + (unsigned)WS_SEL + (unsigned)tok * 512u + 8u * F.lane);
    for (;;) {
        const int nxt = tok + F.NGW; const int tl = nxt < NTOK ? nxt : tok;
        const int n2 = ((const int*)(ws + WS_NSEL))[tl]; const u32x2 row2 = *(const u32x2*)(ws + (unsigned)WS_SEL + (unsigned)tl * 512u + 8u * F.lane);
        p4_token(F, P, tok, n, row, rep);
        if (nxt >= NTOK) break;
        tok = nxt; n = n2; row = row2;
    }
}

__device__ __forceinline__ void h1_pass(const Frame& F, const Params& P, int ubase, bool rep) {
    unsigned char* ws = P.ws; LAS unsigned char* lds = F.lds;
    const int us = F.tid >> 7, d = F.tid & 127; const int uidx = ubase + us;
    const int b = uidx >> 9, c = (uidx >> 3) & 63, h = uidx & 7; const unsigned tok0 = (unsigned)(b * SEQ + 64 * c); const unsigned col0 = 128u * h;
    LAS bf16_t* KtL = (LAS bf16_t*)(lds + us * 36864); LAS bf16_t* VtL = KtL + 128 * 72;
    const unsigned e0 = (tok0 * 1024u + col0 + d);
    __syncthreads();
    float cum[64];
#pragma unroll
    for (int t = 0; t < 64; ++t) cum[t] = *(const float*)(ws + (unsigned)WS_LOGF + (e0 + 1024u * t) * 4u);
#pragma unroll
    for (int t = 1; t < 64; ++t) cum[t] += cum[t - 1];
    const float cmid = cum[31], clast = cum[63];
#pragma unroll
    for (int tg = 0; tg < 64; tg += 8) {
        unsigned short qraw[8], vraw[8];
#pragma unroll
        for (int i = 0; i < 8; ++i) { const unsigned a = (e0 + 1024u * (tg + i)) * 2u; qraw[i] = *(const bf16_t*)(ws + (unsigned)WS_QT + a); vraw[i] = *(const bf16_t*)(ws + (unsigned)WS_VH + a); }
#pragma unroll
        for (int i = 0; i < 8; ++i) { const int t = tg + i; const float g = (t == 0) ? cum[0] : (cum[t] - cum[t - 1]);
            const float e = __expf(cum[t] - cmid), ei = __expf(cmid - cum[t]), el = __expf(clast - cum[t]); const float k1 = 1.0f - __expf(g);
            const unsigned a = (e0 + 1024u * t) * 2u;
            const bf16_t qb = (bf16_t)f2bf(bf2f(qraw[i]) * e);
            if (!rep) *(bf16_t*)(ws + (unsigned)WS_QT + a) = qb; else *(bf16_t*)(ws + (unsigned)WS_KT + a) = qb;
            *(bf16_t*)(ws + (unsigned)WS_KT + a) = (bf16_t)f2bf(k1 * ei);
            KtL[d * 72 + t] = (bf16_t)f2bf(k1 * el); VtL[d * 72 + t] = vraw[i]; }
        asm volatile("" ::: "memory"); __builtin_amdgcn_sched_barrier(0);
    }
    ((float*)(ws + WS_AVEC))[(size_t)uidx * 128 + d] = __expf(cmid); ((float*)(ws + WS_DECAY))[(size_t)uidx * 128 + d] = __expf(clast);
    __syncthreads();
    const int lane2 = opaque_i(F.lane); const int fr = lane2 & 15, g = lane2 >> 4, wu = F.wave & 1;
    bf16x8 kf[8][2];
#pragma unroll
    for (int dt = 0; dt < 8; ++dt) { kf[dt][0] = *(const LAS bf16x8*)(KtL + (16 * dt + fr) * 72 + 8 * g); kf[dt][1] = *(const LAS bf16x8*)(KtL + (16 * dt + fr) * 72 + 32 + 8 * g); }
    bf16_t* KVb = (bf16_t*)(ws + WS_KV) + (size_t)uidx * 16384;
#pragma unroll
    for (int vi = 0; vi < 4; ++vi) { const int vt = 4 * wu + vi;
        const bf16x8 a0 = *(const LAS bf16x8*)(VtL + (16 * vt + fr) * 72 + 8 * g), a1 = *(const LAS bf16x8*)(VtL + (16 * vt + fr) * 72 + 32 + 8 * g);
#pragma unroll
        for (int dt = 0; dt < 8; ++dt) { f32x4 acc = (f32x4){0.f, 0.f, 0.f, 0.f};
            acc = __builtin_amdgcn_mfma_f32_16x16x32_bf16(a0, kf[dt][0], acc, 0, 0, 0); acc = __builtin_amdgcn_mfma_f32_16x16x32_bf16(a1, kf[dt][1], acc, 0, 0, 0);
#pragma unroll
            for (int e = 0; e < 4; ++e) KVb[(16 * vt + 4 * g + e) * 128 + 16 * dt + fr] = (bf16_t)f2bf(acc[e]); }
        __builtin_amdgcn_sched_barrier(0); }
}
__device__ __forceinline__ void h2_scan(const Frame& F, const Params& P) {
    unsigned char* ws = P.ws; bf16_t* KV = (bf16_t*)(ws + WS_KV); const float* decay = (const float*)(ws + WS_DECAY);
    for (int idx = blockIdx.x * 512 + F.tid; idx < 32 * 4096; idx += F.G * 512) {
    const int bh = idx >> 12, rem = idx & 4095, v = rem >> 5, d4 = rem & 31; const int b = bh >> 3, h = bh & 7;
    f32x4 S = (f32x4){0.f, 0.f, 0.f, 0.f};
    for (int c0 = 0; c0 < 64; c0 += 16) {
        u32x2 kv[16]; f32x4 dc[16];
#pragma unroll
        for (int j = 0; j < 16; ++j) { const size_t u = (size_t)((b * 64 + c0 + j) * 8 + h); kv[j] = *(const u32x2*)(KV + u * 16384 + v * 128 + 4 * d4); dc[j] = *(const f32x4*)(decay + u * 128 + 4 * d4); }
#pragma unroll
        for (int j = 0; j < 16; ++j) { const size_t u = (size_t)((b * 64 + c0 + j) * 8 + h);
            u32x2 o; o.x = pk2(S[0], S[1]); o.y = pk2(S[2], S[3]);
            *(u32x2*)(KV + u * 16384 + v * 128 + 4 * d4) = o;
            S[0] = dc[j][0] * S[0] + bf2f(kv[j].x & 0xffffu); S[1] = dc[j][1] * S[1] + bf2f(kv[j].x >> 16); S[2] = dc[j][2] * S[2] + bf2f(kv[j].y & 0xffffu); S[3] = dc[j][3] * S[3] + bf2f(kv[j].y >> 16); }
    }
    }
}
__device__ __forceinline__ void h3_unit(const Frame& F, const Params& P, int bc) {
    const unsigned char* ws = P.ws; LAS unsigned char* lds = F.lds;
    const int lane = F.lane, fr = lane & 15, g = lane >> 4, h = F.wave; const int b = bc >> 6, c = bc & 63; const int uidx = bc * 8 + h;
    const unsigned tok0 = (unsigned)(b * SEQ + 64 * c); const unsigned col0 = 128u * h;
    const unsigned rowoff = ((tok0 + fr) * 1024u + col0 + 8u * g) * 2u;
    LAS unsigned char* Vt = lds + h * 16384; LAS float* ex = (LAS float*)(lds + 131072);
    __syncthreads();
    { const unsigned vo = (unsigned)WS_VH + ((tok0 + (lane >> 4)) * 1024u + col0 + 8u * (lane & 15)) * 2u;
#pragma unroll 4
      for (int it = 0; it < 16; ++it) { const int t = 4 * it + (lane >> 4), chunk = lane & 15;
        const u32x4 wv = *(const u32x4*)(ws + vo + (unsigned)it * 4u * 2048u);
#pragma unroll
        for (int e = 0; e < 8; ++e) { const int v = 8 * chunk + e; const unsigned wd = ((const unsigned*)&wv)[e >> 1]; const unsigned short val = (e & 1) ? (unsigned short)(wd >> 16) : (unsigned short)(wd & 0xffffu);
            *(LAS unsigned short*)(Vt + v * 128 + (((t >> 2) ^ (v & 15)) * 8) + (t & 3) * 2) = val; } } }
    LDS_WAIT(); __builtin_amdgcn_wave_barrier();
    const unsigned soff = (unsigned)WS_KV + ((unsigned)uidx * 16384u + (unsigned)fr * 128u + 8u * g) * 2u;
    const unsigned aoff = (unsigned)WS_AVEC + ((unsigned)uidx * 128u + 8u * g) * 4u;
#pragma unroll 1
    for (int jh = 0; jh < 2; ++jh) {
        bf16x8 qf[2][4];
#pragma unroll
        for (int jj = 0; jj < 2; ++jj)
#pragma unroll
            for (int ks = 0; ks < 4; ++ks) qf[jj][ks] = *(const bf16x8*)(ws + (unsigned)WS_QT + rowoff + (unsigned)(16 * (2 * jh + jj)) * 2048u + 64u * ks);
        unsigned bfr[2][2][4];
#pragma unroll
        for (int jj = 0; jj < 2; ++jj)
#pragma unroll
            for (int p = 0; p < 2; ++p)
#pragma unroll
                for (int e = 0; e < 4; ++e) bfr[jj][p][e] = 0u;
#pragma unroll
        for (int i = 0; i < 4; ++i) {
            if (i <= 2 * jh + 1) {
                bf16x8 kf[4];
#pragma unroll
                for (int ks = 0; ks < 4; ++ks) kf[ks] = *(const bf16x8*)(ws + (unsigned)WS_KT + rowoff + (unsigned)(16 * i) * 2048u + 64u * ks);
#pragma unroll
                for (int jj = 0; jj < 2; ++jj) { const int j = 2 * jh + jj;
                    if (i <= j) { f32x4 st = (f32x4){0.f, 0.f, 0.f, 0.f};
#pragma unroll
                        for (int ks = 0; ks < 4; ++ks) st = __builtin_amdgcn_mfma_f32_16x16x32_bf16(kf[ks], qf[jj][ks], st, 0, 0, 0);
                        if (i == j) {
#pragma unroll
                            for (int e = 0; e < 4; ++e) st[e] = (4 * g + e <= fr) ? st[e] : 0.f; }
                        bfr[jj][i >> 1][(i & 1) * 2] = pk2(st[0], st[1]); bfr[jj][i >> 1][(i & 1) * 2 + 1] = pk2(st[2], st[3]); } }
            }
        }
#pragma unroll
        for (int ks = 0; ks < 4; ++ks) { const f32x4 a0 = *(const f32x4*)(ws + aoff + 128u * ks), a1 = *(const f32x4*)(ws + aoff + 128u * ks + 16u);
#pragma unroll
            for (int jj = 0; jj < 2; ++jj) { const u32x4 qw = __builtin_bit_cast(u32x4, qf[jj][ks]); u32x4 o;
                o.x = pk2(bf2f(qw.x & 0xffffu) * a0[0], bf2f(qw.x >> 16) * a0[1]); o.y = pk2(bf2f(qw.y & 0xffffu) * a0[2], bf2f(qw.y >> 16) * a0[3]);
                o.z = pk2(bf2f(qw.z & 0xffffu) * a1[0], bf2f(qw.z >> 16) * a1[1]); o.w = pk2(bf2f(qw.w & 0xffffu) * a1[2], bf2f(qw.w >> 16) * a1[3]);
                qf[jj][ks] = __builtin_bit_cast(bf16x8, o); } }
        f32x4 acc[8][2];
#pragma unroll
        for (int vt = 0; vt < 8; ++vt) { acc[vt][0] = (f32x4){0.f, 0.f, 0.f, 0.f}; acc[vt][1] = (f32x4){0.f, 0.f, 0.f, 0.f}; }
#pragma unroll
        for (int vt = 0; vt < 8; ++vt) {
            const int v = 16 * vt + fr;
#pragma unroll
            for (int p = 0; p < 2; ++p) {
                if (p <= jh) {
                    const u32x2 lo = *(const LAS u32x2*)(Vt + v * 128 + (((8 * p + g) ^ (v & 15)) * 8)), hi = *(const LAS u32x2*)(Vt + v * 128 + (((8 * p + 4 + g) ^ (v & 15)) * 8));
                    u32x4 aw; aw.x = lo.x; aw.y = lo.y; aw.z = hi.x; aw.w = hi.y; const bf16x8 af = __builtin_bit_cast(bf16x8, aw);
#pragma unroll
                    for (int jj = 0; jj < 2; ++jj) { u32x4 bw; bw.x = bfr[jj][p][0]; bw.y = bfr[jj][p][1]; bw.z = bfr[jj][p][2]; bw.w = bfr[jj][p][3];
                        acc[vt][jj] = __builtin_amdgcn_mfma_f32_16x16x32_bf16(af, __builtin_bit_cast(bf16x8, bw), acc[vt][jj], 0, 0, 0); }
                }
            }
#pragma unroll
            for (int ks = 0; ks < 4; ++ks) {
                const bf16x8 af = *(const bf16x8*)(ws + soff + (unsigned)(16 * vt) * 256u + 64u * ks);
#pragma unroll
                for (int jj = 0; jj < 2; ++jj) acc[vt][jj] = __builtin_amdgcn_mfma_f32_16x16x32_bf16(af, qf[jj][ks], acc[vt][jj], 0, 0, 0);
            }
            if ((vt & 3) == 3) asm volatile("" ::: "memory");
        }
#pragma unroll
        for (int jj = 0; jj < 2; ++jj) { float s = 0.f;
#pragma unroll
            for (int vt = 0; vt < 8; ++vt) s += (acc[vt][jj][0] * acc[vt][jj][0] + acc[vt][jj][1] * acc[vt][jj][1]) + (acc[vt][jj][2] * acc[vt][jj][2] + acc[vt][jj][3] * acc[vt][jj][3]);
            s += shx(s, 16, lane); s += shx(s, 32, lane);
            if (g == 0) ex[(16 * (2 * jh + jj) + fr) * 8 + h] = s; }
        __syncthreads();
        const unsigned ooff = ((tok0 + fr) * 1024u + col0 + 4u * g) * 2u;
#pragma unroll
        for (int jj = 0; jj < 2; ++jj) { const int t = 16 * (2 * jh + jj) + fr;
            const f32x4 e0 = *(const LAS f32x4*)(ex + t * 8), e1 = *(const LAS f32x4*)(ex + t * 8 + 4);
            const float rs = __builtin_amdgcn_rsqf((((e0[0] + e0[1]) + (e0[2] + e0[3])) + ((e1[0] + e1[1]) + (e1[2] + e1[3]))) * (1.0f / 1024.0f) + EPS);
#pragma unroll
            for (int vt = 0; vt < 8; ++vt) { const unsigned o = ooff + (unsigned)(16 * (2 * jh + jj)) * 2048u + 32u * vt;
                const u32x2 sgw = *(const u32x2*)(ws + (unsigned)WS_SG + o); const f32x4 gh = *(const f32x4*)(P.g_hnorm + col0 + 16 * vt + 4 * g);
                const float y0 = acc[vt][jj][0] * rs * gh[0] * bf2f(sgw.x & 0xffffu), y1 = acc[vt][jj][1] * rs * gh[1] * bf2f(sgw.x >> 16);
                const float y2 = acc[vt][jj][2] * rs * gh[2] * bf2f(sgw.y & 0xffffu), y3 = acc[vt][jj][3] * rs * gh[3] * bf2f(sgw.y >> 16);
                u32x2 w; w.x = pk2(y0, y1); w.y = pk2(y2, y3); *(u32x2*)(P.ws + (unsigned)WS_YREC + o) = w; } }
        __syncthreads();
    }
}

__device__ __forceinline__ void p7_pass(const Frame& F, const Params& P, int task0, bool rep) {
    unsigned char* ws = P.ws; LAS unsigned char* lds = F.lds;
    const int lane = F.lane, fr = lane & 15, g = lane >> 4, w = F.wave; const int tt = w & 3, kh = w >> 2; const unsigned tok0 = (unsigned)task0 * 16u;
    constexpr int STG = 57344;
    LAS float* lgx = (LAS float*)(lds + 2 * STG);
    LAS int* hist = (LAS int*)(lds + 2 * STG + 2 * 64 * 48 * 4);
    if (F.tid < 32) hist[F.tid] = 0;
    const int l5 = lane & 31, lh = lane >> 5;
#define P7_DMA(KC) do { LAS unsigned char* st_ = lds + ((KC) & 1) * STG; \
        _Pragma("unroll") for (int i_ = 0; i_ < 4; ++i_) { const int row_ = 8 * w + 2 * i_ + lh; \
            __builtin_amdgcn_global_load_lds((const unsigned*)(ws + (unsigned)WS_X1B + (tok0 + row_) * 4096u + (unsigned)(KC) * 512u + 16u * (unsigned)(l5 ^ (row_ & 15))), (LAS unsigned*)(st_ + (8 * w + 2 * i_) * 512), 16, 0, 0); } \
        _Pragma("unroll") for (int i_ = 0; i_ < 3; ++i_) { const int row_ = 6 * w + 2 * i_ + lh; \
            __builtin_amdgcn_global_load_lds((const unsigned*)(ws + (unsigned)WS_WRT + (unsigned)row_ * 4096u + (unsigned)(KC) * 512u + 16u * (unsigned)(l5 ^ (row_ & 15))), (LAS unsigned*)(st_ + 32768 + (6 * w + 2 * i_) * 512), 16, 0, 0); } } while (0)
    if (!rep) { int* tokrow = (int*)(ws + WS_TOKROW); for (int i = (task0 >> 2) * 159 + F.tid; i < (task0 >> 2) * 159 + 159; i += 512) tokrow[i] = 0; }
    f32x4 acc[3];
#pragma unroll
    for (int nt = 0; nt < 3; ++nt) acc[nt] = (f32x4){0.f, 0.f, 0.f, 0.f};
    __syncthreads();
    P7_DMA(0);
#pragma unroll 1
    for (int kc = 0; kc < 8; ++kc) {
        if (kc + 1 < 8) { P7_DMA(kc + 1); asm volatile("s_waitcnt vmcnt(7)" ::: "memory"); } else asm volatile("s_waitcnt vmcnt(0)" ::: "memory");
        __syncthreads();
        const LAS unsigned char* st = lds + (kc & 1) * STG;
#pragma unroll
        for (int q = 0; q < 4; ++q) { const int c = 4 * (4 * kh + q) + g;
            const bf16x8 a = *(const LAS bf16x8*)(st + (16 * tt + fr) * 512 + ((c ^ fr) * 16));
#pragma unroll
            for (int nt = 0; nt < 3; ++nt) acc[nt] = __builtin_amdgcn_mfma_f32_16x16x32_bf16(a, *(const LAS bf16x8*)(st + 32768 + (16 * nt + fr) * 512 + ((c ^ fr) * 16)), acc[nt], 0, 0, 0); }
        LDS_WAIT();
        __syncthreads();
    }
#undef P7_DMA
#pragma unroll
    for (int nt = 0; nt < 3; ++nt)
#pragma unroll
        for (int e = 0; e < 4; ++e) lgx[(kh * 64 + 16 * tt + 4 * g + e) * 48 + 16 * nt + fr] = acc[nt][e];
    __syncthreads();
    if (kh == 0 && lane < 16) {
        const unsigned tok = tok0 + 16u * tt + lane; const float* part = (const float*)(ws + WS_SSQ2) + (size_t)tok * 32; float ssq = 0.f;
#pragma unroll
        for (int q = 0; q < 8; ++q) { const f32x4 v = *(const f32x4*)(part + 4 * q); ssq += (v[0] + v[1]) + (v[2] + v[3]); }
        const float rs = 1.0f / sqrtf(ssq * (1.0f / DM) + EPS);
        const LAS float* l = lgx + (16 * tt + lane) * 48; const LAS float* l2 = l + 64 * 48;
        float gl0 = (l[0] + l2[0]) * rs + P.b_grp[0]; int grp = 0; float gmax = gl0; float glv[4]; glv[0] = gl0;
#pragma unroll
        for (int j = 1; j < 4; ++j) { const float v = (l[j] + l2[j]) * rs + P.b_grp[j]; glv[j] = v; if (v > gmax) { gmax = v; grp = j; } }
        float gsum = 0.f;
#pragma unroll
        for (int j = 0; j < 4; ++j) gsum += expf(glv[j] - gmax);
        const float pg = 1.0f / gsum;
        float m1 = -3.0e38f, m2 = -3.0e38f; int i1 = 0, i2 = 0;
#pragma unroll
        for (int i = 0; i < 8; ++i) { const float v = (l[4 + 8 * grp + i] + l2[4 + 8 * grp + i]) * rs + P.b_exp[8 * grp + i];
            if (v > m1) { m2 = m1; i2 = i1; m1 = v; i1 = i; } else if (v > m2) { m2 = v; i2 = i; } }
        const float r2 = expf(m2 - m1); const float g0 = pg / (1.0f + r2), g1 = pg * r2 / (1.0f + r2);
        const int e0 = grp * 8 + i1, e1 = grp * 8 + i2;
        const int r0 = __hip_atomic_fetch_add(hist + e0, 1, __ATOMIC_RELAXED, __HIP_MEMORY_SCOPE_WORKGROUP), r1 = __hip_atomic_fetch_add(hist + e1, 1, __ATOMIC_RELAXED, __HIP_MEMORY_SCOPE_WORKGROUP);
        ((int*)(ws + WS_ROUTE_E))[tok * 2] = e0 | (r0 << 8); ((int*)(ws + WS_ROUTE_E))[tok * 2 + 1] = e1 | (r1 << 8);
        ((float*)(ws + WS_ROUTE_G))[tok * 2] = g0; ((float*)(ws + WS_ROUTE_G))[tok * 2 + 1] = g1;
        ((float*)(ws + WS_RSTD1))[tok] = rs;
    }
    __syncthreads();
    if (F.tid < 32) ((int*)(ws + WS_CNTB))[(task0 >> 2) * 32 + F.tid] = hist[F.tid];
}

__device__ __forceinline__ void p7b_gather(const Frame& F, const Params& P, bool rep) {
    unsigned char* ws = P.ws; int* ctl = (int*)(ws + WS_CTL); const int lane = F.lane;
    int* tokrow = (int*)(ws + WS_TOKROW); const int* cb = (const int*)(ws + WS_CNTB);
    for (int tok0 = (F.wave * F.G + (int)blockIdx.x) * 64; tok0 < NTOK; tok0 += F.NGW * 64) {
        const int gi = tok0 >> 6;
        const int e = lane & 31; int tot = 0, lt = 0;
#pragma unroll 8
        for (int p = lane >> 5; p < NTOK / 64; p += 2) { const int v = cb[p * 32 + e]; tot += v; lt += (p < gi) ? v : 0; }
        tot += shl_i(tot, lane ^ 32, lane); lt += shl_i(lt, lane ^ 32, lane);
        const int c = (lane < 32) ? tot : 0; const int pad = (c + 255) & ~255;
        int incl = pad;
#pragma unroll
        for (int o = 1; o < 64; o <<= 1) { const int t = shl_i(incl, lane - o, lane); if (lane >= o) incl += t; }
        const int basev = incl - pad;
        if (gi == 0 && !rep) {
            const int total = shl_i(incl, 31, lane); if (lane == 0) ctl[128] = total >> 8;
            if (lane < 32) { for (int r = basev >> 8; r < (incl >> 8); ++r) ctl[256 + r] = lane; }
        }
        const int rowbase = basev + lt;
        const int tok = tok0 + lane;
        const int pk0 = ((const int*)(ws + WS_ROUTE_E))[tok * 2], pk1 = ((const int*)(ws + WS_ROUTE_E))[tok * 2 + 1];
        const int d0 = shl_i(rowbase, pk0 & 255, lane) + (pk0 >> 8), d1 = shl_i(rowbase, pk1 & 255, lane) + (pk1 >> 8);
        const float rs = ((const float*)(ws + WS_RSTD1))[tok];
        tokrow[d0] = tok; tokrow[d1] = tok;
        ((float*)(ws + WS_RSS))[d0] = rs; ((float*)(ws + WS_RSS))[d1] = rs;
        ((float*)(ws + WS_GS))[d0] = ((const float*)(ws + WS_ROUTE_G))[tok * 2]; ((float*)(ws + WS_GS))[d1] = ((const float*)(ws + WS_ROUTE_G))[tok * 2 + 1];
        ((int*)(ws + WS_DEST))[tok * 2] = d0; ((int*)(ws + WS_DEST))[tok * 2 + 1] = d1;
    }
}

__device__ __forceinline__ void p9_final(const Frame& F, const Params& P) {
    unsigned char* ws = P.ws; const bf16_t* ys = (const bf16_t*)(ws + WS_YS); const bf16_t* x1b = (const bf16_t*)(ws + WS_X1B); const int lane = F.lane;
    for (int tok = F.gw; tok < NTOK; tok += F.NGW) {
        const int d0 = ((const int*)(ws + WS_DEST))[tok * 2], d1 = ((const int*)(ws + WS_DEST))[tok * 2 + 1];
        f32x4* xr = (f32x4*)(P.out + (size_t)tok * DM) + lane; const u32x2* x0 = (const u32x2*)(x1b + (size_t)tok * DM) + lane;
        const u32x2* y0 = (const u32x2*)(ys + (size_t)d0 * DM) + lane; const u32x2* y1 = (const u32x2*)(ys + (size_t)d1 * DM) + lane;
        f32x4 v[8]; float s = 0.f;
#pragma unroll
        for (int j = 0; j < 8; ++j) { const u32x2 x = x0[64 * j], a = y0[64 * j], b = y1[64 * j];
            v[j][0] = bf2f(x.x & 0xffffu) + (bf2f(a.x & 0xffffu) + bf2f(b.x & 0xffffu)); v[j][1] = bf2f(x.x >> 16) + (bf2f(a.x >> 16) + bf2f(b.x >> 16));
            v[j][2] = bf2f(x.y & 0xffffu) + (bf2f(a.y & 0xffffu) + bf2f(b.y & 0xffffu)); v[j][3] = bf2f(x.y >> 16) + (bf2f(a.y >> 16) + bf2f(b.y >> 16));
            s += (v[j][0] * v[j][0] + v[j][1] * v[j][1]) + (v[j][2] * v[j][2] + v[j][3] * v[j][3]); }
        s = wave_sum(s, lane); const float rs = 1.0f / sqrtf(s * (1.0f / DM) + EPS);
#pragma unroll
        for (int j = 0; j < 8; ++j) { const f32x4 gf = *((const f32x4*)P.g_final + 64 * j + lane); xr[64 * j] = v[j] * rs * gf; }
    }
}

#ifndef PHMASK
#define PHMASK 0xFFFFFF
#endif
#ifndef SELREP
#define SELREP 0
#endif
#ifndef REPMASK
#define REPMASK 0
#endif
#define TS_READ(v) asm volatile("s_memrealtime %0\n\ts_waitcnt lgkmcnt(0)" : "=s"(v) :: "memory")
#ifdef TS_A0
#define TS_MARK(k) { if (blockIdx.x == TS_BLOCK && threadIdx.x == 0) { unsigned long long t_; TS_READ(t_); __hip_atomic_store((unsigned long long*)(ws + WS_BAR + 15360) + (k), t_, __ATOMIC_RELAXED, __HIP_MEMORY_SCOPE_AGENT); } }
#else
#define TS_MARK(k)
#endif
#define PH(k) for (int _rep = 0; _rep < 1 + ((REPMASK >> (k)) & 1); ++_rep) if constexpr ((PHMASK >> (k)) & 1)
__global__ void __launch_bounds__(512, 2) mega_fwd(Params P) {
    extern __shared__ __attribute__((aligned(16))) unsigned char lds_raw[];
    cg::grid_group grid = cg::this_grid();
    LAS unsigned char* lds = (LAS unsigned char*)lds_raw; const int G = gridDim.x;
    const int wave_id = __builtin_amdgcn_readfirstlane((int)(threadIdx.x >> 6));
    unsigned char* ws = P.ws;
    const float* ctab = (const float*)(ws + WS_COS); const float* stab = (const float*)(ws + WS_SIN);
    volatile LAS unsigned* bst = (volatile LAS unsigned*)(lds + LDS_PHASE_BYTES);
    if (wave_id == 0 && lane_id() < 2) bst[lane_id()] = 0u;
    __syncthreads();
    const XcdBarrier xbar = xcd_barrier_post((unsigned*)(ws + WS_BAR), bst, wave_id);
#ifdef TS_A0
    TS_MARK(12)
#endif
    if (ws == nullptr) grid.sync();
    PH(0) { const Frame F = make_frame(lds, wave_id); p0_prep(F, P); }
    xcd_barrier(xbar);
    TS_MARK(0)
    const int skew = (blockIdx.x >> 3) & 3;
    const bool skew_first = skew != 0;
    if (skew_first) { const Frame F = make_frame(lds, wave_id); conv_small(F, P, 0, skew == 3 ? 2432 : 2048); conv_down(F, P, 0, 2048 * ((4 * skew) / 3)); __syncthreads(); }
#ifdef P1_DELAY_US
    { const unsigned long long t0 = __builtin_amdgcn_s_memrealtime(); const unsigned long long dt = (unsigned long long)(skew * P1_DELAY_US) * 100ull;
      while (__builtin_amdgcn_s_memrealtime() - t0 < dt) __builtin_amdgcn_s_sleep(8); }
#endif
    PH(1) { SchedDense S; S.A = (const char*)(ws + WS_XB); S.Bt = (const char*)(ws + WS_WTIN); S.nM = NTOK / 256; S.nN = NP1 / 256; S.G = G; S.c = blockIdx.x; S.tstep = (size_t)256 * DM * 2;
      EpiIn E; E.ws = ws; E.rstd1 = (const float*)(ws + WS_RSTD1); E.lb = (const float*)(ws + WS_LB); E.ctab = ctab; E.stab = stab;
      if (_rep == 0) pg8::gemm_phase(lds, DM, S, E, wave_id); else {
#if defined(EPI_PROBE_MODE)
        EpiProbeStore<EPI_PROBE_MODE> E0; E0.ws = ws; pg8::gemm_phase(lds, DM, S, E0, wave_id);
#else
        EpiNull E0; pg8::gemm_phase(lds, DM, S, E0, wave_id);
#endif
      } }
    { const Frame F = make_frame(lds, wave_id); if (skew != 3) { conv_small(F, P, skew == 0 ? 0 : 2048, 2432); conv_down(F, P, 2048 * ((4 * skew) / 3), 8192); } }
    xcd_barrier(xbar);
    TS_MARK(1)
    PH(2) { SchedDense S; S.A = (const char*)(ws + WS_CQ); S.Bt = (const char*)(ws + WS_WTQQ); S.nM = NTOK / 256; S.nN = 3072 / 256; S.G = G; S.c = blockIdx.x; S.tstep = (size_t)256 * QR * 2;
      EpiQ E; E.ws = ws;
      pg8::gemm_phase(lds, QR, S, E, wave_id); }
    PH(3) { const Frame F = make_frame(lds, wave_id); for (int u = 4 * blockIdx.x; u < 2048; u += 4 * G) h1_pass(F, P, u, _rep != 0); }
    xcd_barrier(xbar);
    TS_MARK(2)
    PH(4) { const Frame F = make_frame(lds, wave_id); for (int task = blockIdx.x; task < 1024; task += G) { const int bb = task >> 8, j = task & 255; p3_task(F, P, bb, (bb & 1) ? 255 - j : j, (_rep == 0) || SELREP); } }
    __syncthreads();
    PH(5) { const Frame F = make_frame(lds, wave_id); h2_scan(F, P); }
    xcd_barrier(xbar);
    TS_MARK(3)
#if defined(DUMP) && DUMP == 3
    { const Frame F = make_frame(lds, wave_id); const float* src = (const float*)(ws + WS_KV);
      for (size_t i = (size_t)blockIdx.x * 512 + F.tid; i < (size_t)NTOK * DM; i += (size_t)G * 512) P.out[i] = src[i];
      return; }
#endif
#if defined(DUMP) && DUMP == 2
    { const Frame F = make_frame(lds, wave_id); const bf16_t* s0 = (const bf16_t*)(ws + WS_QT); const bf16_t* s1 = (const bf16_t*)(ws + WS_KT);
      for (size_t i = (size_t)blockIdx.x * 512 + F.tid; i < (size_t)NTOK * DM; i += (size_t)G * 512) { const size_t r = i / DM, c = i % DM; P.out[i] = bf2f((c < 1024 ? s0 : s1)[r * 1024 + (c & 1023)]); }
      return; }
#endif
    PH(6) { const Frame F = make_frame(lds, wave_id); p4_tokens(F, P, _rep != 0); }
    PH(7) { const Frame F = make_frame(lds, wave_id); for (int bc = blockIdx.x; bc < 256; bc += G) h3_unit(F, P, bc); }
    xcd_barrier(xbar);
    TS_MARK(4)
#ifdef DUMP
    { const Frame F = make_frame(lds, wave_id); const bf16_t* src = (const bf16_t*)(ws + (DUMP == 0 ? WS_YATT : WS_YREC));
      for (size_t i = (size_t)blockIdx.x * 512 + F.tid; i < (size_t)NTOK * DM; i += (size_t)G * 512) { const size_t r = i / DM, c = i % DM; P.out[i] = bf2f(src[r * 1024 + (c & 1023)]); }
      return; }
#endif
    PH(8) { SchedMerged S; S.A0 = (const char*)(ws + WS_YATT); S.A1 = (const char*)(ws + WS_YREC); S.B0 = (const char*)(ws + WS_WTPA); S.B1 = (const char*)(ws + WS_WTPB);
      S.nM = NTOK / 256; S.nN = DM / 256; S.G = G; S.c = blockIdx.x; S.tstep = (size_t)256 * 1024 * 2;
      EpiMerged E; E.ws = ws;
      pg8::gemm_phase(lds, 1024, S, E, wave_id); }
    xcd_barrier(xbar);
    TS_MARK(5)
    if (skew_first) { PH(9) { const Frame F = make_frame(lds, wave_id); conv_gateup(F, P, 0, 2048 * ((8 * skew) / 3)); } __syncthreads(); }
    PH(10) { SchedDense S; S.A = (const char*)(ws + WS_MERGED); S.Bt = (const char*)(ws + WS_WTO); S.nM = NTOK / 256; S.nN = DM / 256; S.G = G; S.c = blockIdx.x; S.tstep = (size_t)256 * DM * 2;
      EpiX1 E; E.ws = ws; E.x = P.x; E.x1 = P.out;
      pg8::gemm_phase(lds, DM, S, E, wave_id); }
    if (skew != 3) { PH(9) { const Frame F = make_frame(lds, wave_id); conv_gateup(F, P, 2048 * ((8 * skew) / 3), 16384); } }
    xcd_barrier(xbar);
    TS_MARK(6)
    PH(12) { const Frame F = make_frame(lds, wave_id); for (int t = 4 * blockIdx.x; t < NTOK / 16; t += 4 * G) p7_pass(F, P, t, _rep != 0); }
    xcd_barrier(xbar);
    TS_MARK(7)
    PH(13) { const Frame F = make_frame(lds, wave_id); p7b_gather(F, P, _rep != 0); }
    xcd_barrier(xbar);
    TS_MARK(8)
    const int* ctl = (const int*)(ws + WS_CTL);
    PH(14) { SchedMoeG S; S.gA = (const char*)(ws + WS_X1B); S.tokrow = (const int*)(ws + WS_TOKROW); S.Bt = (const char*)(ws + WS_WGUT); S.tile_e = ctl + 256; S.ntiles = __builtin_amdgcn_readfirstlane(ctl[128]); S.NCT = 4; S.G = G; S.c = blockIdx.x; S.tstep = (size_t)256 * DM * 2;
      EpiGateUp E; E.ws = ws;
      pg8::gemm_phase<EpiGateUp, SchedMoeG, true>(lds, DM, S, E, wave_id); }
    xcd_barrier(xbar);
    TS_MARK(9)
    PH(15) { SchedMoe S; S.A = (const char*)(ws + WS_ACT); S.Bt = (const char*)(ws + WS_WDT); S.tile_e = ctl + 256; S.ntiles = __builtin_amdgcn_readfirstlane(ctl[128]); S.NCT = 8; S.G = G; S.c = blockIdx.x; S.tstep = (size_t)256 * DEXP * 2;
      EpiDown E; E.ws = ws;
      pg8::gemm_phase(lds, DEXP, S, E, wave_id); }
    xcd_barrier(xbar);
    TS_MARK(10)
    PH(16) { const Frame F = make_frame(lds, wave_id); p9_final(F, P); }
#ifdef TS_A0
    TS_MARK(11)
    if (blockIdx.x == TS_BLOCK && threadIdx.x == 0) { unsigned long long t0; TS_READ(t0);
      unsigned long long* tsb = (unsigned long long*)(ws + WS_BAR + 15360);
#define TS_LD(k) __hip_atomic_load(tsb + (k), __ATOMIC_RELAXED, __HIP_MEMORY_SCOPE_AGENT)
      const unsigned long long dt = 10ull * (TS_LD(TS_A1) - TS_LD(TS_A0)) + 1024000ull * ((TS_LD(TS_B1) - TS_LD(TS_B0)) / 800ull);
      for (;;) { unsigned long long t1; TS_READ(t1); if (t1 - t0 >= dt) break; __builtin_amdgcn_s_sleep(8); } }
#endif
}

extern "C" void kernel_launch(void* const* d_in, const int* in_sizes, int n_in, void* d_out, int out_size, void* d_ws, size_t ws_size, hipStream_t stream) {
    static int grid = 0;
    if (grid == 0) {
        if (n_in != 20 || out_size != NTOK * DM || ws_size < WS_END) { fprintf(stderr, "kernel_launch: unexpected shapes (n_in %d out %d ws %zu, need %zu)\n", n_in, out_size, ws_size, (size_t)WS_END); grid = -1; return; }
        int dev = 0, cus = 0, per_cu = 0;
        if (hipGetDevice(&dev) != hipSuccess || hipDeviceGetAttribute(&cus, hipDeviceAttributeMultiprocessorCount, dev) != hipSuccess) { grid = -1; return; }
        if (hipFuncSetAttribute((const void*)mega_fwd, hipFuncAttributeMaxDynamicSharedMemorySize, LDS_BYTES) != hipSuccess) { fprintf(stderr, "kernel_launch: hipFuncSetAttribute failed\n"); grid = -1; return; }
        if (hipOccupancyMaxActiveBlocksPerMultiprocessor(&per_cu, (const void*)mega_fwd, 512, LDS_BYTES) != hipSuccess || per_cu < 1) { fprintf(stderr, "kernel_launch: occupancy query says %d\n", per_cu); (void)hipGetLastError(); grid = -1; return; }
        grid = cus;
        if (grid > 256) grid = 256;
    }
    if (grid < 0) return;
    if (hipMemsetAsync((unsigned char*)d_ws + WS_BAR, 0, 16384, stream) != hipSuccess) { fprintf(stderr, "kernel_launch: memset of the barrier words failed\n"); return; }
    Params p{};
    const float** pp = (const float**)&p;
    for (int i = 0; i < 20; ++i) pp[i] = (const float*)d_in[i];
    p.out = (float*)d_out; p.ws = (unsigned char*)d_ws;
    void* args[] = {&p};
    hipError_t e = hipLaunchCooperativeKernel((const void*)mega_fwd, dim3(grid), dim3(512), args, LDS_BYTES, stream);
    if (e != hipSuccess) fprintf(stderr, "cooperative launch failed: %s (grid %d)\n", hipGetErrorString(e), grid);
}
```

```cpp
#include <hip/hip_runtime.h>
#include <hip/hip_cooperative_groups.h>
#include <cstdio>
#include <cstdint>
namespace cg = cooperative_groups;

#define LAS __attribute__((address_space(3)))
typedef unsigned short bf16_t;
typedef short bf16x8 __attribute__((ext_vector_type(8)));
typedef float f32x4 __attribute__((ext_vector_type(4)));
typedef float f32x2 __attribute__((ext_vector_type(2)));
typedef float f32x16 __attribute__((ext_vector_type(16)));
typedef unsigned u32x4 __attribute__((ext_vector_type(4)));
typedef unsigned u32x2 __attribute__((ext_vector_type(2)));

constexpr int NTOK = 16384, DM = 2048, SEQ = 4096, NBATCH = 4;
constexpr int DIN = 9104, NP1 = 9216;
constexpr int QR = 512;
constexpr int NEXP = 32, DEXP = 512;
constexpr int XS_ROWS = 40704;
constexpr float EPS = 1e-6f;

constexpr size_t MiB = 1u << 20;
constexpr size_t WS_R0 = 0;
constexpr size_t WS_R1 = 64 * MiB;
constexpr size_t WS_R2 = 100 * MiB;
constexpr size_t WS_R3 = 228 * MiB;
constexpr size_t WS_R4 = 292 * MiB;
constexpr size_t WS_R5 = 420 * MiB;
constexpr size_t WS_R6 = 452 * MiB;
constexpr size_t WS_R7 = 484 * MiB;
constexpr size_t WS_R8 = 516 * MiB;
constexpr size_t WS_R9 = 548 * MiB;
constexpr size_t WS_R10 = 564 * MiB;
constexpr size_t WS_R11 = 580 * MiB;
constexpr size_t WS_MISC = 599 * MiB;
constexpr size_t WS_END = 607 * MiB;

constexpr size_t WS_XB = WS_R0, WS_QI = WS_R0, WS_YATT = WS_R0, WS_YREC = WS_R0 + 32 * MiB, WS_X1B = WS_R0, WS_ACT = WS_R3;
constexpr size_t WS_WTIN = WS_R1, WS_Q = WS_R1;
constexpr size_t WS_RG = WS_R2, WS_SB = WS_R2 + 64 * MiB, WS_WGUT = WS_R5;
constexpr size_t WS_LOGF = WS_R3, WS_SEL = WS_R3, WS_MERGED = WS_R3;
constexpr size_t WS_KV = WS_R4, WS_WDT = WS_R4 + 64 * MiB;
constexpr size_t WS_QT = WS_R5, WS_XS = WS_R5, WS_YS = WS_R5;
constexpr size_t WS_VH = WS_R6, WS_SG = WS_R7, WS_KT = WS_R8, WS_CQ = WS_R9;
constexpr size_t WS_KR = WS_R10, WS_KIR = WS_R10 + 4 * MiB, WS_VV = WS_R10 + 8 * MiB, WS_WI = WS_R10 + 12 * MiB, WS_COS = WS_R10 + 13 * MiB, WS_SIN = WS_R10 + 14 * MiB;
constexpr size_t WS_WTQQ = WS_R11, WS_WTPA = WS_R11 + 3 * MiB, WS_WTPB = WS_R11 + 7 * MiB, WS_WTO = WS_R11 + 11 * MiB;
constexpr size_t WS_RSTD1 = WS_MISC;
constexpr size_t WS_SSQCQ = WS_MISC + 64 * 1024;
constexpr size_t WS_SSQ2 = WS_MISC + 576 * 1024;
constexpr size_t WS_NSEL = WS_MISC + 2624 * 1024;
constexpr size_t WS_LB = WS_MISC + 2688 * 1024;
constexpr size_t WS_AVEC = WS_MISC + 2692 * 1024;
constexpr size_t WS_DECAY = WS_MISC + 3716 * 1024;
constexpr size_t WS_ROUTE_E = WS_MISC + 4740 * 1024;
constexpr size_t WS_ROUTE_G = WS_MISC + 4868 * 1024;
constexpr size_t WS_DEST = WS_MISC + 4996 * 1024;
constexpr size_t WS_RSS = WS_MISC + 5124 * 1024;
constexpr size_t WS_GS = WS_MISC + 5284 * 1024;
constexpr size_t WS_WRT = WS_MISC + 5444 * 1024;
constexpr size_t WS_CTL = WS_MISC + 5636 * 1024;
constexpr size_t WS_BAR = WS_MISC + 5640 * 1024;
constexpr size_t WS_TOKROW = WS_MISC + 5656 * 1024;
constexpr size_t WS_CNTB = WS_MISC + 5824 * 1024;
static_assert(WS_TOKROW + 163840 <= WS_CNTB && WS_CNTB + 32768 <= WS_END, "ws map");

__device__ __forceinline__ float bf2f(unsigned b) { return __uint_as_float(b << 16); }
__device__ __forceinline__ unsigned f2bf(float f) { unsigned u = __float_as_uint(f); return (u + 0x7fffu + ((u >> 16) & 1u)) >> 16; }
typedef __bf16 bf16v2 __attribute__((ext_vector_type(2)));
__device__ __forceinline__ unsigned pk2(float lo, float hi) { f32x2 v = {lo, hi}; bf16v2 b = __builtin_convertvector(v, bf16v2); return __builtin_bit_cast(unsigned, b); }
__device__ __forceinline__ float shx(float v, int m, int lane) { return __int_as_float(__builtin_amdgcn_ds_bpermute((lane ^ m) << 2, __float_as_int(v))); }
__device__ __forceinline__ int shx_i(int v, int m, int lane) { return __builtin_amdgcn_ds_bpermute((lane ^ m) << 2, v); }
__device__ __forceinline__ int shl_i(int v, int src, int) { return __builtin_amdgcn_ds_bpermute(src << 2, v); }
__device__ __forceinline__ float wave_sum(float v, int lane) {
#pragma unroll
    for (int o = 1; o < 64; o <<= 1) v += shx(v, o, lane);
    return v;
}
__device__ __forceinline__ int wave_sum_i(int v, int lane) {
#pragma unroll
    for (int o = 1; o < 64; o <<= 1) v += shx_i(v, o, lane);
    return v;
}
__device__ __forceinline__ float sigmoidf_(float x) { return __builtin_amdgcn_rcpf(1.0f + __expf(-x)); }
__device__ __forceinline__ float siluf_(float x) { return x * sigmoidf_(x); }
__device__ __forceinline__ int opaque_i(int x) { asm volatile("" : "+v"(x)); return x; }
__device__ __forceinline__ int lane_id() { int x; asm volatile("v_mbcnt_lo_u32_b32 %0, -1, 0\n\tv_mbcnt_hi_u32_b32 %0, -1, %0" : "=v"(x)); return x; }
#define LDS_WAIT() asm volatile("s_waitcnt lgkmcnt(0)" ::: "memory")
#define VM_WAIT() asm volatile("s_waitcnt vmcnt(0)" ::: "memory")

namespace pg8 {
constexpr int BM = 256, BK = 64, HALF = 128, HTB = HALF * BK * 2, STAGE_BYTES = 8 * HTB, NXCD = 8, WGM = 8;
__host__ __device__ __forceinline__ int lds_byte(int r, int c) { const int st = (r >> 4) * 2 + (c >> 5), rr = r & 15, cc = c & 31, ob = rr * 64 + cc * 2; return st * 1024 + (ob ^ (((ob >> 9) & 1) << 5)); }
__host__ __device__ __forceinline__ void stage_rc(int b, int& R, int& C) { const int st = b / 1024, sb = b % 1024, swz = sb ^ (((sb >> 9) & 1) << 5); R = (st >> 1) * 16 + swz / 64; C = (st & 1) * 32 + (swz % 64) / 2; }
__host__ __device__ __forceinline__ int perm32(int rho) { const int n = rho >> 4, i = rho & 15; return 8 * (i >> 2) + 4 * n + (i & 3); }

struct Unit { const char* A; const char* B; int pm, pn, aux; };

__device__ __forceinline__ bool static_tile(long L, int nM, int nN, int& pm, int& pn) {
    const int nwg = nM * nN; if (L >= nwg) return false;
    int wgid = (int)L; { const int q = nwg / NXCD, r = nwg % NXCD, xcd = wgid % NXCD, off = wgid / NXCD; wgid = (xcd < r ? xcd * (q + 1) : r * (q + 1) + (xcd - r) * q) + off; }
    const int nig = WGM * nN, gid = wgid / nig, fm = gid * WGM, gsz = (nM - fm) < WGM ? (nM - fm) : WGM;
    pm = fm + ((wgid % nig) % gsz); pn = (wgid % nig) / gsz; return true;
}

template <class Epi, class Sched, bool GATHER = false>
__device__ __forceinline__ void gemm_phase(LAS unsigned char* lds, const int K, const Sched& S, const Epi& E, const int wid) {
    const int lane = opaque_i(lane_id()), tid = wid * 64 + lane, wr = wid >> 2, wc = wid & 3, fr = lane & 15, fq = lane >> 4;
    const int nt = K / BK;
    unsigned voffA[2], voffB[2]; int rowA[2]; unsigned colA2[2];
#pragma unroll
    for (int i = 0; i < 2; ++i) { int R, C; stage_rc(tid * 16 + i * 8192, R, C); const int Rb = (R & ~31) + perm32(R & 31);
        voffA[i] = (unsigned)(R * K + C) * 2u; voffB[i] = (unsigned)(Rb * K + C) * 2u; rowA[i] = R; colA2[i] = (unsigned)C * 2u; }
    unsigned gC[2][2], gN[2][2];
    const size_t kstep = (size_t)(BK * 2);
    const size_t hstep = (size_t)HALF * K * 2;
    const unsigned ldsw = (unsigned)wid * 1024u;
    const int aoff = lds_byte(wr * 64 + fr, fq * 8), boff = lds_byte(wc * 32 + fr, fq * 8);
#define PG8_SA(b, h) (((b) * 2 + (h)) * HTB)
#define PG8_SB(b, h) ((4 + (b) * 2 + (h)) * HTB)
#define PG8_STAGE(bufoff, gbase, voff) do { _Pragma("unroll") for (int _i = 0; _i < 2; ++_i) \
        __builtin_amdgcn_global_load_lds((const unsigned*)((const char*)(gbase) + (voff)[_i]), (LAS unsigned*)(lds + (bufoff) + ldsw + _i * 8192), 16, 0, 0); } while (0)
#define PG8_GLOAD(dst, U) do { _Pragma("unroll") for (int _h = 0; _h < 2; ++_h) _Pragma("unroll") for (int _i = 0; _i < 2; ++_i) \
        dst[_h][_i] = (unsigned)S.tokrow[(U).pm * 256 + 128 * _h + rowA[_i]] * (unsigned)(K * 2) + colA2[_i]; } while (0)
#define PG8_STAGE_A(bufoff, nx, h, kt) do { if constexpr (GATHER) { _Pragma("unroll") for (int _i = 0; _i < 2; ++_i) \
            __builtin_amdgcn_global_load_lds((const unsigned*)(S.gA + ((nx) ? gN[h][_i] : gC[h][_i]) + (size_t)(kt) * kstep), (LAS unsigned*)(lds + (bufoff) + ldsw + _i * 8192), 16, 0, 0); } \
        else { PG8_STAGE(bufoff, ((nx) ? nA : cA) + (size_t)(h) * hstep + (size_t)(kt) * kstep, voffA); } } while (0)
#define PG8_LDA(dst, b, h) do { _Pragma("unroll") for (int m = 0; m < 4; ++m) _Pragma("unroll") for (int k = 0; k < 2; ++k) dst[m][k] = *(const LAS bf16x8*)(lds + PG8_SA(b, h) + aoff + m * 2048 + k * 1024); } while (0)
#define PG8_LDB(dst, b, h) do { _Pragma("unroll") for (int n = 0; n < 2; ++n) _Pragma("unroll") for (int k = 0; k < 2; ++k) dst[n][k] = *(const LAS bf16x8*)(lds + PG8_SB(b, h) + boff + n * 2048 + k * 1024); } while (0)
#define PG8_MMA(ai, bj, At, Bt) do { __builtin_amdgcn_s_setprio(1); _Pragma("unroll") for (int m = 0; m < 4; ++m) _Pragma("unroll") for (int n = 0; n < 2; ++n) _Pragma("unroll") for (int k = 0; k < 2; ++k) \
        acc[ai][bj][m][n] = __builtin_amdgcn_mfma_f32_16x16x32_bf16(Bt[n][k], At[m][k], acc[ai][bj][m][n], 0, 0, 0); __builtin_amdgcn_s_setprio(0); } while (0)
#define PG8_WAIT_V(n) asm volatile("s_waitcnt vmcnt(" #n ")" ::: "memory")
#define PG8_WAIT_L(n) asm volatile("s_waitcnt lgkmcnt(" #n ")" ::: "memory")
#define PG8_BAR __builtin_amdgcn_s_barrier()
#define PG8_SCHED __builtin_amdgcn_sched_barrier(0)
    Unit cur, nxt; int ui = 0;
    if (!S.next(0, cur)) return;
    f32x4 acc[2][2][4][2];
#pragma unroll
    for (int a = 0; a < 2; ++a)
#pragma unroll
        for (int b = 0; b < 2; ++b)
#pragma unroll
            for (int m = 0; m < 4; ++m)
#pragma unroll
                for (int n = 0; n < 2; ++n) acc[a][b][m][n] = (f32x4){0.f, 0.f, 0.f, 0.f};
    bf16x8 At[4][2], B0[2][2], B1[2][2];
    const char* cA = cur.A; const char* cB = cur.B; const char* nA = cA;
    if constexpr (GATHER) { PG8_GLOAD(gC, cur); }
    PG8_STAGE(PG8_SB(0, 0), cB, voffB); PG8_STAGE(PG8_SB(0, 1), cB + hstep, voffB); PG8_STAGE_A(PG8_SA(0, 0), false, 0, 0); PG8_STAGE_A(PG8_SA(0, 1), false, 1, 0);
    if (wr == 1) PG8_BAR;
    PG8_WAIT_V(2); PG8_BAR;
    PG8_STAGE(PG8_SB(1, 0), cB + kstep, voffB); PG8_STAGE_A(PG8_SA(1, 0), false, 0, 1); PG8_STAGE(PG8_SB(1, 1), cB + hstep + kstep, voffB);
    PG8_WAIT_V(6); PG8_BAR;
    for (;;) {
        const bool has_next = S.next(ui + 1, nxt);
        nA = has_next ? nxt.A : cA; const char* nB = has_next ? nxt.B : cB;
        if constexpr (GATHER) { if (has_next) { PG8_GLOAD(gN, nxt); } else {
#pragma unroll
            for (int _h = 0; _h < 2; ++_h)
#pragma unroll
                for (int _i = 0; _i < 2; ++_i) gN[_h][_i] = gC[_h][_i]; } }
#pragma unroll 1
        for (int t = 0; t < nt; t += 2) {
            const bool last = (t == nt - 2);
            const char* b2 = last ? nB : cB + (size_t)(t + 2) * kstep; const char* b3 = b2 + kstep;
            const int t2 = last ? 0 : t + 2;
            PG8_LDB(B0, 0, 0); PG8_LDB(B1, 0, 1); PG8_SCHED; PG8_LDA(At, 0, 0); PG8_STAGE_A(PG8_SA(1, 1), false, 1, t + 1);
            PG8_WAIT_V(8); PG8_WAIT_L(0); PG8_BAR; PG8_MMA(0, 0, At, B0); PG8_MMA(0, 1, At, B1); PG8_BAR; PG8_SCHED;
            PG8_LDA(At, 0, 1); PG8_STAGE(PG8_SB(0, 0), b2, voffB); PG8_STAGE(PG8_SB(0, 1), b2 + hstep, voffB); PG8_STAGE_A(PG8_SA(0, 0), last, 0, t2);
            PG8_WAIT_V(8); PG8_WAIT_L(0); PG8_BAR; PG8_MMA(1, 0, At, B0); PG8_MMA(1, 1, At, B1); PG8_BAR; PG8_SCHED;
            PG8_LDB(B0, 1, 0); PG8_LDB(B1, 1, 1); PG8_SCHED; PG8_LDA(At, 1, 0); PG8_STAGE_A(PG8_SA(0, 1), last, 1, t2);
            PG8_WAIT_V(8); PG8_WAIT_L(0); PG8_BAR; PG8_MMA(0, 0, At, B0); PG8_MMA(0, 1, At, B1); PG8_BAR; PG8_SCHED;
            PG8_LDA(At, 1, 1); PG8_STAGE(PG8_SB(1, 0), b3, voffB); PG8_STAGE(PG8_SB(1, 1), b3 + hstep, voffB); PG8_STAGE_A(PG8_SA(1, 0), last, 0, t2 + 1);
            PG8_WAIT_V(8); PG8_WAIT_L(0); PG8_BAR; PG8_MMA(1, 0, At, B0); PG8_MMA(1, 1, At, B1); PG8_BAR; PG8_SCHED;
        }
        if (wr == 0) PG8_BAR;
        const bool keep = E(acc, cur, wr, wc, fr, fq);
        if (!has_next) break;
        if (!keep) {
#pragma unroll
            for (int a = 0; a < 2; ++a)
#pragma unroll
                for (int b = 0; b < 2; ++b)
#pragma unroll
                    for (int m = 0; m < 4; ++m)
#pragma unroll
                        for (int n = 0; n < 2; ++n) acc[a][b][m][n] = (f32x4){0.f, 0.f, 0.f, 0.f};
        }
        cur = nxt; cA = nA; cB = nB; ++ui;
        if constexpr (GATHER) {
#pragma unroll
            for (int _h = 0; _h < 2; ++_h)
#pragma unroll
                for (int _i = 0; _i < 2; ++_i) gC[_h][_i] = gN[_h][_i]; }
        if (wr == 1) PG8_BAR;
    }
    PG8_WAIT_V(0);
    PG8_BAR;
#undef PG8_SA
#undef PG8_SB
#undef PG8_STAGE
#undef PG8_STAGE_A
#undef PG8_GLOAD
#undef PG8_LDA
#undef PG8_LDB
#undef PG8_MMA
#undef PG8_WAIT_V
#undef PG8_WAIT_L
#undef PG8_BAR
#undef PG8_SCHED
}
}

struct Params {
    const float* x; const float* g_norm1; const float* w_in; const float* g_cq; const float* w_uq; const float* w_qidx; const float* lb_logits; const float* g_hnorm;
    const float* w_pa; const float* w_pb; const float* w_o; const float* g_norm2; const float* w_grp; const float* b_grp; const float* w_exp; const float* b_exp;
    const float* w_gate; const float* w_up; const float* w_down; const float* g_final;
    float* out; unsigned char* ws;
};

struct SchedDense {
    const char* A; const char* Bt; int nM, nN, G, c; size_t tstep;
    __device__ __forceinline__ bool next(int i, pg8::Unit& u) const {
        int pm, pn; if (!pg8::static_tile((long)i * G + c, nM, nN, pm, pn)) return false;
        u.pm = pm; u.pn = pn; u.aux = 0; u.A = A + (size_t)pm * tstep; u.B = Bt + (size_t)pn * tstep; return true;
    }
};
struct SchedMerged {
    const char* A0; const char* A1; const char* B0; const char* B1; int nM, nN, G, c; size_t tstep;
    __device__ __forceinline__ bool next(int i, pg8::Unit& u) const {
        int pm, pn; if (!pg8::static_tile((long)(i >> 1) * G + c, nM, nN, pm, pn)) return false;
        const int part = i & 1; u.pm = pm; u.pn = pn; u.aux = part;
        u.A = (part ? A1 : A0) + (size_t)pm * tstep; u.B = (part ? B1 : B0) + (size_t)pn * tstep; return true;
    }
};
struct SchedMoe {
    const char* A; const char* Bt; const int* tile_e; int ntiles, NCT, G, c; size_t tstep;
    __device__ __forceinline__ bool next(int i, pg8::Unit& u) const {
        const long L = (long)i * G + c; if (L >= (long)ntiles * NCT) return false;
        const int rt = (int)(L / NCT), ct = (int)(L % NCT); const int e = __builtin_amdgcn_readfirstlane(tile_e[rt]);
        u.pm = rt; u.pn = ct; u.aux = e; u.A = A + (size_t)rt * tstep; u.B = Bt + ((size_t)e * NCT + ct) * tstep; return true;
    }
};

struct SchedMoeG {
    const char* gA; const int* tokrow; const char* Bt; const int* tile_e; int ntiles, NCT, G, c; size_t tstep;
    __device__ __forceinline__ bool next(int i, pg8::Unit& u) const {
        const long L = (long)i * G + c; if (L >= (long)ntiles * NCT) return false;
        const int rt = (int)(L / NCT), ct = (int)(L % NCT); const int e = __builtin_amdgcn_readfirstlane(tile_e[rt]);
        u.pm = rt; u.pn = ct; u.aux = e; u.A = gA; u.B = Bt + ((size_t)e * NCT + ct) * tstep; return true;
    }
};

typedef f32x4 Acc[2][2][4][2];
#define EPI_ROWS_BEGIN _Pragma("unroll") for (int ai = 0; ai < 2; ++ai) _Pragma("unroll") for (int m = 0; m < 4; ++m) { const int r = row0 + ai * 128 + m * 16;
#define EPI_ROWS_END }

struct EpiIn {
    unsigned char* ws; const float* rstd1; const float* lb; const float* ctab; const float* stab;
    __device__ __forceinline__ bool operator()(Acc& acc, const pg8::Unit& u, int wr, int wc, int fr, int fq) const {
        const int row0 = u.pm * 256 + wr * 64 + fr; const int colp = wc * 32 + 8 * fq; const int T = u.pn;
        float rs8[2][4];
#pragma unroll
        for (int ai = 0; ai < 2; ++ai)
#pragma unroll
            for (int m = 0; m < 4; ++m) rs8[ai][m] = rstd1[row0 + ai * 128 + m * 16];
        if (T < 2) {
            bf16_t* cq = (bf16_t*)(ws + WS_CQ); float* part = (float*)(ws + WS_SSQCQ);
            EPI_ROWS_BEGIN { const float rs = rs8[ai][m]; float s = 0.f;
#pragma unroll
                for (int bj = 0; bj < 2; ++bj) { const f32x4 v0 = acc[ai][bj][m][0] * rs, v1 = acc[ai][bj][m][1] * rs;
                    s += (v0[0] * v0[0] + v0[1] * v0[1]) + (v0[2] * v0[2] + v0[3] * v0[3]) + (v1[0] * v1[0] + v1[1] * v1[1]) + (v1[2] * v1[2] + v1[3] * v1[3]);
                    u32x4 w; w.x = pk2(v0[0], v0[1]); w.y = pk2(v0[2], v0[3]); w.z = pk2(v1[0], v1[1]); w.w = pk2(v1[2], v1[3]);
                    *(u32x4*)(cq + (size_t)r * QR + T * 256 + bj * 128 + colp) = w; }
                s += shx(s, 16, fq * 16 + fr); s += shx(s, 32, fq * 16 + fr);
                if (fq == 0) part[(size_t)r * 8 + T * 4 + wc] = s; } EPI_ROWS_END
        } else if (T == 2) {
            bf16_t* dst = (bf16_t*)(ws + (wc >= 2 ? WS_KIR : WS_KR)); const int c = (colp & 63);
            EPI_ROWS_BEGIN { const float rs = rs8[ai][m]; const int pos = r & (SEQ - 1);
                const f32x4 c0 = *(const f32x4*)(ctab + pos * 64 + c), c1 = *(const f32x4*)(ctab + pos * 64 + c + 4), s0 = *(const f32x4*)(stab + pos * 64 + c), s1 = *(const f32x4*)(stab + pos * 64 + c + 4);
                const f32x4 a0 = acc[ai][0][m][0] * rs, a1 = acc[ai][0][m][1] * rs, b0 = acc[ai][1][m][0] * rs, b1 = acc[ai][1][m][1] * rs;
                const f32x4 o0 = a0 * c0 - b0 * s0, o1 = a1 * c1 - b1 * s1, p0 = b0 * c0 + a0 * s0, p1 = b1 * c1 + a1 * s1;
                u32x4 w; w.x = pk2(o0[0], o0[1]); w.y = pk2(o0[2], o0[3]); w.z = pk2(o1[0], o1[1]); w.w = pk2(o1[2], o1[3]);
                *(u32x4*)(dst + (size_t)r * 128 + c) = w;
                w.x = pk2(p0[0], p0[1]); w.y = pk2(p0[2], p0[3]); w.z = pk2(p1[0], p1[1]); w.w = pk2(p1[2], p1[3]);
                *(u32x4*)(dst + (size_t)r * 128 + 64 + c) = w; } EPI_ROWS_END
        } else if (T == 3) {
            bf16_t* vv = (bf16_t*)(ws + WS_VV); float* wi = (float*)(ws + WS_WI);
            EPI_ROWS_BEGIN { const float rs = rs8[ai][m];
                const f32x4 v0 = acc[ai][0][m][0] * rs, v1 = acc[ai][0][m][1] * rs;
                u32x4 w; w.x = pk2(v0[0], v0[1]); w.y = pk2(v0[2], v0[3]); w.z = pk2(v1[0], v1[1]); w.w = pk2(v1[2], v1[3]);
                *(u32x4*)(vv + (size_t)r * 128 + colp) = w;
                if (colp < 16) { const float sc = rs * 0.02209708691207961f;
                    *(f32x4*)(wi + (size_t)r * 16 + colp) = acc[ai][1][m][0] * sc; *(f32x4*)(wi + (size_t)r * 16 + colp + 4) = acc[ai][1][m][1] * sc; } } EPI_ROWS_END
        } else if (T < 20) {
            const int seg = (T - 4) >> 2; const int cbase = ((T - 4) & 3) * 256 + colp;
            if (seg == 1) {
                float* logf = (float*)(ws + WS_LOGF);
                f32x4 lbv[2][2];
#pragma unroll
                for (int bj = 0; bj < 2; ++bj) { lbv[bj][0] = *(const f32x4*)(lb + cbase + bj * 128); lbv[bj][1] = *(const f32x4*)(lb + cbase + bj * 128 + 4); }
                EPI_ROWS_BEGIN { const float rs = rs8[ai][m];
#pragma unroll
                    for (int bj = 0; bj < 2; ++bj) { const int cc = cbase + bj * 128;
                        const f32x4 l0 = lbv[bj][0], l1 = lbv[bj][1];
                        f32x4 v0 = acc[ai][bj][m][0] * rs, v1 = acc[ai][bj][m][1] * rs;
#pragma unroll
                        for (int e = 0; e < 4; ++e) { v0[e] = __logf(l0[e] + (1.0f - l0[e]) * sigmoidf_(v0[e])); v1[e] = __logf(l1[e] + (1.0f - l1[e]) * sigmoidf_(v1[e])); }
                        *(f32x4*)(logf + (size_t)r * 1024 + cc) = v0; *(f32x4*)(logf + (size_t)r * 1024 + cc + 4) = v1; } } EPI_ROWS_END
            } else {
                bf16_t* dst = (bf16_t*)(ws + (seg == 0 ? WS_QT : (seg == 2 ? WS_VH : WS_SG)));
                EPI_ROWS_BEGIN { const float rs = rs8[ai][m];
#pragma unroll
                    for (int bj = 0; bj < 2; ++bj) { f32x4 v0 = acc[ai][bj][m][0] * rs, v1 = acc[ai][bj][m][1] * rs;
                        if (seg != 2) {
#pragma unroll
                            for (int e = 0; e < 4; ++e) { v0[e] = siluf_(v0[e]); v1[e] = siluf_(v1[e]); } }
                        u32x4 w; w.x = pk2(v0[0], v0[1]); w.y = pk2(v0[2], v0[3]); w.z = pk2(v1[0], v1[1]); w.w = pk2(v1[2], v1[3]);
                        *(u32x4*)(dst + (size_t)r * 1024 + cbase + bj * 128) = w; } } EPI_ROWS_END
            }
        } else {
            bf16_t* Rg = (bf16_t*)(ws + WS_RG); bf16_t* Sb = (bf16_t*)(ws + WS_SB); const int cc = (T - 20) * 128 + colp;
            EPI_ROWS_BEGIN { const float rs = rs8[ai][m];
                f32x4 a0 = acc[ai][0][m][0] * rs, a1 = acc[ai][0][m][1] * rs, b0 = acc[ai][1][m][0] * rs, b1 = acc[ai][1][m][1] * rs;
#pragma unroll
                for (int e = 0; e < 4; ++e) { const float ea0 = __expf(-a0[e]), eb0 = __expf(-b0[e]), ea1 = __expf(-a1[e]), eb1 = __expf(-b1[e]);
                    a0[e] = (1.0f + eb0) * __builtin_amdgcn_rcpf(1.0f + ea0); b0[e] = __builtin_amdgcn_rcpf(1.0f + eb0);
                    a1[e] = (1.0f + eb1) * __builtin_amdgcn_rcpf(1.0f + ea1); b1[e] = __builtin_amdgcn_rcpf(1.0f + eb1); }
                u32x4 w; w.x = pk2(a0[0], a0[1]); w.y = pk2(a0[2], a0[3]); w.z = pk2(a1[0], a1[1]); w.w = pk2(a1[2], a1[3]);
                *(u32x4*)(Rg + (size_t)r * DM + cc) = w;
                w.x = pk2(b0[0], b0[1]); w.y = pk2(b0[2], b0[3]); w.z = pk2(b1[0], b1[1]); w.w = pk2(b1[2], b1[3]);
                *(u32x4*)(Sb + (size_t)r * DM + cc) = w; } EPI_ROWS_END
        }
        return false;
    }
};

struct EpiQ {
    unsigned char* ws;
    __device__ __forceinline__ bool operator()(Acc& acc, const pg8::Unit& u, int wr, int wc, int fr, int fq) const {
        const int row0 = u.pm * 256 + wr * 64 + fr; const int colp = wc * 32 + 8 * fq; const int T = u.pn;
        const int head = 2 * T + (colp >> 6), c = colp & 63;
        unsigned dbase, pitchb; float osc;
        if (head < 8) { dbase = (unsigned)WS_Q + (unsigned)(head * 128 + c) * 2u; pitchb = 2048u; osc = 0.08838834764831845f; } else { dbase = (unsigned)WS_QI + (unsigned)((head - 8) * 128 + c) * 2u; pitchb = 4096u; osc = 1.0f; }
        float rs8[2][4];
#pragma unroll
        for (int ai = 0; ai < 2; ++ai) { f32x4 pa[4], pb[4];
#pragma unroll
            for (int m = 0; m < 4; ++m) { const unsigned o = (unsigned)WS_SSQCQ + (unsigned)(row0 + ai * 128 + m * 16) * 32u; pa[m] = *(const f32x4*)(ws + o); pb[m] = *(const f32x4*)(ws + o + 16u); }
#pragma unroll
            for (int m = 0; m < 4; ++m) { const float ssq = ((pa[m][0] + pa[m][1]) + (pa[m][2] + pa[m][3])) + ((pb[m][0] + pb[m][1]) + (pb[m][2] + pb[m][3]));
                rs8[ai][m] = __builtin_amdgcn_rsqf(ssq * (1.0f / QR) + EPS) * osc; } }
#pragma unroll
        for (int ai = 0; ai < 2; ++ai)
#pragma unroll
        for (int mp = 0; mp < 2; ++mp) {
            f32x4 c0[2], c1[2], s0[2], s1[2];
#pragma unroll
            for (int mm = 0; mm < 2; ++mm) { const unsigned to = (unsigned)(((row0 + ai * 128 + (2 * mp + mm) * 16) & (SEQ - 1)) * 64 + c) * 4u;
                c0[mm] = *(const f32x4*)(ws + ((unsigned)WS_COS + to)); c1[mm] = *(const f32x4*)(ws + ((unsigned)WS_COS + to + 16u)); s0[mm] = *(const f32x4*)(ws + ((unsigned)WS_SIN + to)); s1[mm] = *(const f32x4*)(ws + ((unsigned)WS_SIN + to + 16u)); }
#pragma unroll
            for (int mm = 0; mm < 2; ++mm) { const int m = 2 * mp + mm; const unsigned r = (unsigned)(row0 + ai * 128 + m * 16); const float rs = rs8[ai][m];
                const f32x4 a0 = acc[ai][0][m][0] * rs, a1 = acc[ai][0][m][1] * rs, b0 = acc[ai][1][m][0] * rs, b1 = acc[ai][1][m][1] * rs;
                const f32x4 o0 = a0 * c0[mm] - b0 * s0[mm], o1 = a1 * c1[mm] - b1 * s1[mm], p0 = b0 * c0[mm] + a0 * s0[mm], p1 = b1 * c1[mm] + a1 * s1[mm];
                u32x4 w; w.x = pk2(o0[0], o0[1]); w.y = pk2(o0[2], o0[3]); w.z = pk2(o1[0], o1[1]); w.w = pk2(o1[2], o1[3]);
                *(u32x4*)(ws + (dbase + r * pitchb)) = w;
                w.x = pk2(p0[0], p0[1]); w.y = pk2(p0[2], p0[3]); w.z = pk2(p1[0], p1[1]); w.w = pk2(p1[2], p1[3]);
                *(u32x4*)(ws + (dbase + r * pitchb + 128u)) = w; }
        }
        return false;
    }
};

struct EpiMerged {
    unsigned char* ws;
    __device__ __forceinline__ bool operator()(Acc& acc, const pg8::Unit& u, int wr, int wc, int fr, int fq) const {
        const int row0 = u.pm * 256 + wr * 64 + fr; const int colp = wc * 32 + 8 * fq;
        const bf16_t* G = (const bf16_t*)(ws + (u.aux == 0 ? WS_RG : WS_SB)); bf16_t* mg = (bf16_t*)(ws + WS_MERGED);
#pragma unroll
        for (int ai = 0; ai < 2; ++ai)
#pragma unroll
        for (int mp = 0; mp < 2; ++mp) {
            u32x4 gw[2][2];
#pragma unroll
            for (int mm = 0; mm < 2; ++mm)
#pragma unroll
                for (int bj = 0; bj < 2; ++bj) gw[mm][bj] = *(const u32x4*)(G + (size_t)(row0 + ai * 128 + (2 * mp + mm) * 16) * DM + u.pn * 256 + bj * 128 + colp);
#pragma unroll
            for (int mm = 0; mm < 2; ++mm)
#pragma unroll
                for (int bj = 0; bj < 2; ++bj) { const u32x4 w = gw[mm][bj]; const int m = 2 * mp + mm;
                    const f32x4 g0 = (f32x4){bf2f(w.x & 0xffffu), bf2f(w.x >> 16), bf2f(w.y & 0xffffu), bf2f(w.y >> 16)}, g1 = (f32x4){bf2f(w.z & 0xffffu), bf2f(w.z >> 16), bf2f(w.w & 0xffffu), bf2f(w.w >> 16)};
                    if (u.aux == 0) { acc[ai][bj][m][0] *= g0; acc[ai][bj][m][1] *= g1; }
                    else { const f32x4 v0 = acc[ai][bj][m][0] * g0, v1 = acc[ai][bj][m][1] * g1;
                        u32x4 q; q.x = pk2(v0[0], v0[1]); q.y = pk2(v0[2], v0[3]); q.z = pk2(v1[0], v1[1]); q.w = pk2(v1[2], v1[3]);
                        *(u32x4*)(mg + (size_t)(row0 + ai * 128 + m * 16) * DM + u.pn * 256 + bj * 128 + colp) = q; } }
        }
        return u.aux == 0;
    }
};

struct EpiX1 {
    unsigned char* ws; const float* x; float* x1;
    __device__ __forceinline__ bool operator()(Acc& acc, const pg8::Unit& u, int wr, int wc, int fr, int fq) const {
        const int row0 = u.pm * 256 + wr * 64 + fr; const int colp = wc * 32 + 8 * fq;
        bf16_t* x1b = (bf16_t*)(ws + WS_X1B); float* part = (float*)(ws + WS_SSQ2);
#pragma unroll
        for (int ai = 0; ai < 2; ++ai)
#pragma unroll
            for (int mp = 0; mp < 2; ++mp) {
                f32x4 xv[2][2][2];
#pragma unroll
                for (int mm = 0; mm < 2; ++mm)
#pragma unroll
                    for (int bj = 0; bj < 2; ++bj) { const size_t o = (size_t)(row0 + ai * 128 + (2 * mp + mm) * 16) * DM + u.pn * 256 + bj * 128 + colp; xv[mm][bj][0] = *(const f32x4*)(x + o); xv[mm][bj][1] = *(const f32x4*)(x + o + 4); }
#pragma unroll
                for (int mm = 0; mm < 2; ++mm) { const int m = 2 * mp + mm; const int r = row0 + ai * 128 + m * 16; float s = 0.f;
#pragma unroll
                    for (int bj = 0; bj < 2; ++bj) { const size_t o = (size_t)r * DM + u.pn * 256 + bj * 128 + colp;
                        const f32x4 v0 = acc[ai][bj][m][0] + xv[mm][bj][0], v1 = acc[ai][bj][m][1] + xv[mm][bj][1];
                        s += (v0[0] * v0[0] + v0[1] * v0[1]) + (v0[2] * v0[2] + v0[3] * v0[3]) + (v1[0] * v1[0] + v1[1] * v1[1]) + (v1[2] * v1[2] + v1[3] * v1[3]);
                        u32x4 w; w.x = pk2(v0[0], v0[1]); w.y = pk2(v0[2], v0[3]); w.z = pk2(v1[0], v1[1]); w.w = pk2(v1[2], v1[3]);
                        *(u32x4*)(x1b + o) = w; }
                    s += shx(s, 16, fq * 16 + fr); s += shx(s, 32, fq * 16 + fr);
                    if (fq == 0) part[(size_t)r * 32 + u.pn * 4 + wc] = s; }
            }
        return false;
    }
};

struct EpiGateUp {
    unsigned char* ws;
    __device__ __forceinline__ bool operator()(Acc& acc, const pg8::Unit& u, int wr, int wc, int fr, int fq) const {
        const int row0 = u.pm * 256 + wr * 64 + fr; const int colp = wc * 32 + 8 * fq;
        const float* rss = (const float*)(ws + WS_RSS); bf16_t* act = (bf16_t*)(ws + WS_ACT);
        float rs8[2][4];
#pragma unroll
        for (int ai = 0; ai < 2; ++ai)
#pragma unroll
            for (int m = 0; m < 4; ++m) rs8[ai][m] = rss[row0 + ai * 128 + m * 16];
        EPI_ROWS_BEGIN { const float rs = rs8[ai][m];
            f32x4 a0 = acc[ai][0][m][0] * rs, a1 = acc[ai][0][m][1] * rs; const f32x4 u0 = acc[ai][1][m][0] * rs, u1 = acc[ai][1][m][1] * rs;
#pragma unroll
            for (int e = 0; e < 4; ++e) { a0[e] = siluf_(a0[e]) * u0[e]; a1[e] = siluf_(a1[e]) * u1[e]; }
            u32x4 w; w.x = pk2(a0[0], a0[1]); w.y = pk2(a0[2], a0[3]); w.z = pk2(a1[0], a1[1]); w.w = pk2(a1[2], a1[3]);
            *(u32x4*)(act + (size_t)r * DEXP + u.pn * 128 + colp) = w; } EPI_ROWS_END
        return false;
    }
};

struct EpiDown {
    unsigned char* ws;
    __device__ __forceinline__ bool operator()(Acc& acc, const pg8::Unit& u, int wr, int wc, int fr, int fq) const {
        const int row0 = u.pm * 256 + wr * 64 + fr; const int colp = wc * 32 + 8 * fq;
        const float* gs = (const float*)(ws + WS_GS); bf16_t* ys = (bf16_t*)(ws + WS_YS);
        float g8[2][4];
#pragma unroll
        for (int ai = 0; ai < 2; ++ai)
#pragma unroll
            for (int m = 0; m < 4; ++m) g8[ai][m] = gs[row0 + ai * 128 + m * 16];
        EPI_ROWS_BEGIN { const float g = g8[ai][m];
#pragma unroll
            for (int bj = 0; bj < 2; ++bj) { const f32x4 v0 = acc[ai][bj][m][0] * g, v1 = acc[ai][bj][m][1] * g;
                u32x4 w; w.x = pk2(v0[0], v0[1]); w.y = pk2(v0[2], v0[3]); w.z = pk2(v1[0], v1[1]); w.w = pk2(v1[2], v1[3]);
                *(u32x4*)(ys + (size_t)r * DM + u.pn * 256 + bj * 128 + colp) = w; } } EPI_ROWS_END
        return false;
    }
};

struct EpiNull {
    __device__ __forceinline__ bool operator()(Acc& acc, const pg8::Unit& u, int wr, int wc, int fr, int fq) const {
#pragma unroll
        for (int ai = 0; ai < 2; ++ai)
#pragma unroll
            for (int bj = 0; bj < 2; ++bj)
#pragma unroll
                for (int m = 0; m < 4; ++m)
#pragma unroll
                    for (int n = 0; n < 2; ++n) asm volatile("" :: "v"(acc[ai][bj][m][n]));
        return false;
    }
};

template <int MODE> struct EpiProbeStore {
    unsigned char* ws;
    __device__ __forceinline__ bool operator()(Acc& acc, const pg8::Unit& u, int wr, int wc, int fr, int fq) const {
        const int row0 = u.pm * 256 + wr * 64 + fr; const int colp = wc * 32 + 8 * fq; unsigned char* base = ws + WS_KV;
#pragma unroll
        for (int ai = 0; ai < 2; ++ai)
#pragma unroll
            for (int m = 0; m < 4; ++m)
#pragma unroll
                for (int bj = 0; bj < 2; ++bj) { const int r = row0 + ai * 128 + m * 16;
                    u32x4 w; w.x = pk2(acc[ai][bj][m][0][0], acc[ai][bj][m][0][1]); w.y = pk2(acc[ai][bj][m][0][2], acc[ai][bj][m][0][3]); w.z = pk2(acc[ai][bj][m][1][0], acc[ai][bj][m][1][1]); w.w = pk2(acc[ai][bj][m][1][2], acc[ai][bj][m][1][3]);
                    size_t off;
                    if (MODE == 0) off = ((size_t)r * 2048 + (u.pn & 7) * 256 + bj * 128 + colp) * 2;
                    else off = ((((size_t)(u.pm * 8 + (u.pn & 7)) * 8 + (wr * 4 + wc)) * 16 + (ai * 8 + m * 2 + bj)) * 1024 + (size_t)(fq * 16 + fr) * 16) & (size_t)(64 * 1024 * 1024 - 1);
                    *(u32x4*)(base + off) = w; }
        return false;
    }
};

struct Frame { LAS unsigned char* lds; int tid, lane, wave, G, gw, NGW; };
__device__ __forceinline__ Frame make_frame(LAS unsigned char* lds, int wave) { Frame F; F.lds = lds; F.lane = opaque_i(lane_id()); F.wave = wave; F.tid = wave * 64 + F.lane; F.G = gridDim.x; F.gw = blockIdx.x * 8 + F.wave; F.NGW = F.G * 8; return F; }
constexpr int LDS_PHASE_BYTES = 148480;
constexpr int LDS_BYTES = LDS_PHASE_BYTES + 256;

#define XB_TMO      128
#define XB_XCNT(j)  (256  + 64 * (j))
#define XB_XSUB(j)  (1280 + 64 * (j))
#define XB_XGEN(j)  (2304 + 64 * (j))
#define XB_TOP      3328
#define XB_TOPGEN   3392
#define XCD_BAR_WORDS 3456
#define XB_SPIN_CAP (1u << 22)
__device__ __forceinline__ unsigned xb_ld(unsigned* p)              { return __hip_atomic_load(p, __ATOMIC_RELAXED, __HIP_MEMORY_SCOPE_AGENT); }
__device__ __forceinline__ unsigned xb_add(unsigned* p, unsigned v) { return __hip_atomic_fetch_add(p, v, __ATOMIC_RELAXED, __HIP_MEMORY_SCOPE_AGENT); }
__device__ __forceinline__ unsigned xb_xcc_id() { return (unsigned)__builtin_amdgcn_s_getreg((3 << 11) | 20) & 0xFu; }
#define XB_SPIN(cond, bar) do { unsigned _sp = 0; while (cond) { __builtin_amdgcn_s_sleep(1); \
    if ((++_sp & 255u) == 0u) { if (xb_ld(&(bar)[XB_TMO])) break; if (_sp > XB_SPIN_CAP) { atomicAdd(&(bar)[XB_TMO], 1u); break; } } } } while (0)
struct XcdBarrier { unsigned* bar; unsigned x; volatile LAS unsigned* st; int wave; };
__device__ __forceinline__ XcdBarrier xcd_barrier_post(unsigned* bar, volatile LAS unsigned* st, int wave) {
    XcdBarrier b; b.bar = bar; b.x = xb_xcc_id(); b.st = st; b.wave = wave;
    if (wave == 0 && lane_id() == 0) (void)xb_add(&bar[XB_XCNT(b.x)], 1u);
    return b;
}
__device__ __forceinline__ void xcd_barrier_complete(unsigned* bar, unsigned x, unsigned& nloc, unsigned& nx) {
    const unsigned G = gridDim.x * gridDim.y * gridDim.z;
    unsigned sum, cnt, mine, sp = 0u;
    for (;;) {
        sum = 0u; cnt = 0u; mine = 0u;
#pragma unroll
        for (unsigned j = 0; j < 16; ++j) { const unsigned c = xb_ld(&bar[XB_XCNT(j)]); sum += c; cnt += (c > 0u) ? 1u : 0u; mine = (j == x) ? c : mine; }
        if (sum == G) break;
        __builtin_amdgcn_s_sleep(1);
        if ((++sp & 255u) == 0u) { if (xb_ld(&bar[XB_TMO])) break; if (sp > XB_SPIN_CAP) { atomicAdd(&bar[XB_TMO], 1u); break; } }
    }
    nloc = mine > 0u ? mine : 1u; nx = cnt > 0u ? cnt : 1u;
}
__device__ __forceinline__ void xcd_barrier(const XcdBarrier& b) {
    asm volatile("s_waitcnt vmcnt(0)" ::: "memory");
    __syncthreads();
    if (b.wave == 0 && lane_id() == 0) {
        unsigned* bar = b.bar;
        __builtin_amdgcn_s_waitcnt(0);
        unsigned nloc = b.st[0], nx = b.st[1];
        if (nloc == 0u) { xcd_barrier_complete(bar, b.x, nloc, nx); b.st[0] = nloc; b.st[1] = nx; }
        const unsigned old = xb_add(&bar[XB_XSUB(b.x)], 1u);
        const unsigned gen = old / nloc;
        if (old + 1u == (gen + 1u) * nloc) {
            __builtin_amdgcn_fence(__ATOMIC_RELEASE, "agent");
            asm volatile("s_waitcnt vmcnt(0)" ::: "memory");
            const unsigned og = xb_add(&bar[XB_TOP], 1u);
            const unsigned tg = og / nx;
            if (og + 1u == (tg + 1u) * nx) xb_add(&bar[XB_TOPGEN], 1u);
            else XB_SPIN(xb_ld(&bar[XB_TOPGEN]) == tg, bar);
            __builtin_amdgcn_fence(__ATOMIC_ACQUIRE, "agent");
            xb_add(&bar[XB_XGEN(b.x)], 1u);
            asm volatile("s_waitcnt vmcnt(0)" ::: "memory");
        } else {
            XB_SPIN(xb_ld(&bar[XB_XGEN(b.x)]) == gen, bar);
            __builtin_amdgcn_fence(__ATOMIC_ACQUIRE, "agent");
            asm volatile("s_waitcnt vmcnt(0)" ::: "memory");
        }
    }
    __syncthreads();
}

typedef short s16x4 __attribute__((ext_vector_type(4)));
struct TrDesc { const float* src; int ld, c0, nvalid; const float* gain; bf16_t* dst; int Kd, r0, k0; };
__device__ __forceinline__ void tr_load(const TrDesc& d, f32x4 (&v)[16], float (&gv)[16], int lane) {
    const int lg = lane >> 4, li = lane & 15; const bool ok = (4 * li) < d.nvalid;
#pragma unroll
    for (int i = 0; i < 16; ++i) { const int k = 4 * i + lg; v[i] = ok ? *(const f32x4*)(d.src + (size_t)(d.k0 + k) * d.ld + d.c0 + 4 * li) : (f32x4){0.f, 0.f, 0.f, 0.f}; }
    if (d.gain) {
#pragma unroll
        for (int i = 0; i < 16; ++i) gv[i] = d.gain[d.k0 + 4 * i + lg]; }
}
__device__ __forceinline__ void tr_to_lds(const TrDesc& d, f32x4 (&v)[16], const float (&gv)[16], LAS unsigned char* scr, int lane) {
    const int lg = lane >> 4, li = lane & 15;
    if (d.gain) {
#pragma unroll
        for (int i = 0; i < 16; ++i) v[i] *= gv[i]; }
#pragma unroll
    for (int i = 0; i < 16; ++i) { const int k = 4 * i + lg; u32x2 w; w.x = pk2(v[i][0], v[i][1]); w.y = pk2(v[i][2], v[i][3]);
        *(LAS u32x2*)(scr + k * 128 + ((((li >> 2) ^ (k & 3) ^ ((k >> 3) & 1)) << 5) | ((li & 3) * 8))) = w; }
}
__device__ __forceinline__ void tr_from_lds(const TrDesc& d, LAS unsigned char* scr, int lane) {
    const int lg = lane >> 4, li = lane & 15;
    LDS_WAIT(); asm volatile("" ::: "memory");
    const int q = li >> 2, p = li & 3;
#pragma unroll
    for (int nb = 0; nb < 4; ++nb)
#pragma unroll
        for (int ch = 0; ch < 2; ++ch) { const int c = 4 * ch + lg; const int ka = 8 * c + q, kb = ka + 4;
            const s16x4 lo = __builtin_amdgcn_ds_read_tr16_b64_v4i16((LAS s16x4*)(scr + ka * 128 + ((nb ^ (ka & 3) ^ ((ka >> 3) & 1)) << 5) + 8 * p));
            const s16x4 hi = __builtin_amdgcn_ds_read_tr16_b64_v4i16((LAS s16x4*)(scr + kb * 128 + ((nb ^ (kb & 3) ^ ((kb >> 3) & 1)) << 5) + 8 * p));
            const u32x2 l2 = __builtin_bit_cast(u32x2, lo), h2 = __builtin_bit_cast(u32x2, hi); u32x4 o; o.x = l2.x; o.y = l2.y; o.z = h2.x; o.w = h2.y;
            *(u32x4*)(d.dst + (size_t)(d.r0 + 16 * nb + li) * d.Kd + d.k0 + 8 * c) = o; }
    LDS_WAIT(); asm volatile("" ::: "memory");
}
template <class DescFn>
__device__ __forceinline__ void tr_loop(int first, int hi, int stride, LAS unsigned char* scr, int lane, const DescFn& D) {
    if (first >= hi) return;
    f32x4 v[16]; float gv[16];
    TrDesc cur = D(first); tr_load(cur, v, gv, lane);
#pragma unroll 1
    for (int it = first;;) {
        tr_to_lds(cur, v, gv, scr, lane);
        const int nx = it + stride; const bool has = nx < hi; TrDesc nd = cur;
        if (has) { nd = D(nx); tr_load(nd, v, gv, lane); }
        tr_from_lds(cur, scr, lane);
        if (!has) break;
        cur = nd; it = nx;
    }
}
__device__ __forceinline__ void map_in(int G64, int& src0, int& nv) {
    nv = 64;
    if (G64 < 8) { src0 = 64 * G64; }
    else if (G64 < 12) { src0 = (G64 == 8) ? 512 : (G64 == 9) ? 768 : (G64 == 10) ? 576 : 832; }
    else if (G64 < 14) { src0 = 640 + 64 * (G64 - 12); }
    else if (G64 == 14) { src0 = 896; nv = 16; }
    else if (G64 == 15) { src0 = 0; nv = 0; }
    else if (G64 < 80) { src0 = 912 + 64 * (G64 - 16); }
    else { const int q = 64 * (G64 - 80); const int j = q >> 8, bj = (q >> 7) & 1, pos0 = q & 127; src0 = (bj ? 7056 : 5008) + 128 * j + pos0; }
}
__device__ __forceinline__ void sincos_d(float angf, float& c, float& s) {
    const double x = (double)angf; const double n = rint(x * 0.63661977236758134308);
    double r = fma(-n, 1.57079632679489655800e+00, x); r = fma(-n, 6.12323399573676603587e-17, r);
    const double r2 = r * r;
    double sp = 1.0 / 6227020800.0; sp = fma(sp, r2, -1.0 / 39916800.0); sp = fma(sp, r2, 1.0 / 362880.0); sp = fma(sp, r2, -1.0 / 5040.0); sp = fma(sp, r2, 1.0 / 120.0); sp = fma(sp, r2, -1.0 / 6.0);
    const double sn = fma(r * r2, sp, r);
    double cp = -1.0 / 87178291200.0; cp = fma(cp, r2, 1.0 / 479001600.0); cp = fma(cp, r2, -1.0 / 3628800.0); cp = fma(cp, r2, 1.0 / 40320.0); cp = fma(cp, r2, -1.0 / 720.0); cp = fma(cp, r2, 1.0 / 24.0); cp = fma(cp, r2, -0.5);
    const double cs = fma(r2, cp, 1.0);
    const int q = ((int)n) & 3;
    const double cc = (q == 0) ? cs : (q == 1) ? -sn : (q == 2) ? -cs : sn;
    const double ss = (q == 0) ? sn : (q == 1) ? cs : (q == 2) ? -sn : -cs;
    c = (float)cc; s = (float)ss;
}
__device__ __forceinline__ void p0_prep(const Frame& F, const Params& P) {
    unsigned char* ws = P.ws;
    LAS unsigned char* scr = F.lds + F.wave * 16384;
    const int gtid = blockIdx.x * 512 + F.tid, GT = F.G * 512;
    if (gtid < 1024) ((int*)(ws + WS_CTL))[gtid] = 0;
    if (gtid < 1024) ((float*)(ws + WS_LB))[gtid] = 1.0f / (1.0f + expf(P.lb_logits[1024 + gtid] - P.lb_logits[gtid]));
    for (int i = gtid; i < SEQ * 64; i += GT) { const int pos = i >> 6, j = i & 63;
        const float inv = (float)(1.0 / pow(10000.0, (double)(2 * j) / 128.0)); const float ang = (float)pos * inv; float c, s; sincos_d(ang, c, s);
        ((float*)(ws + WS_COS))[i] = c; ((float*)(ws + WS_SIN))[i] = s; }
    for (int i = gtid; i < 48 * DM; i += GT) { const int j = i / DM, k = i % DM;
        const float v = (j < 4) ? P.w_grp[k * 4 + j] : (j < 36) ? P.w_exp[k * 32 + (j - 4)] : 0.f;
        ((bf16_t*)(ws + WS_WRT))[i] = (bf16_t)f2bf(v * P.g_norm2[k]); }
    constexpr int I_IN = 32 * 144;
    tr_loop(F.gw, I_IN, F.NGW, scr, F.lane, [&](int it) { const int kb = it / 144, nb = it % 144; int src0, nv; map_in(nb, src0, nv);
        TrDesc d; d.src = P.w_in; d.ld = DIN; d.c0 = src0; d.nvalid = nv; d.gain = P.g_norm1; d.dst = (bf16_t*)(ws + WS_WTIN); d.Kd = DM; d.r0 = 64 * nb; d.k0 = 64 * kb; return d; });
    for (int m = F.gw; m < NTOK; m += F.NGW) {
        const f32x4* xr = (const f32x4*)(P.x + (size_t)m * DM) + F.lane; f32x4 v[8]; float s = 0.f;
#pragma unroll
        for (int j = 0; j < 8; ++j) { v[j] = xr[64 * j]; s += (v[j][0] * v[j][0] + v[j][1] * v[j][1]) + (v[j][2] * v[j][2] + v[j][3] * v[j][3]); }
        s = wave_sum(s, F.lane);
        if (F.lane == 0) ((float*)(ws + WS_RSTD1))[m] = 1.0f / sqrtf(s * (1.0f / DM) + EPS);
        u32x2* o = (u32x2*)((bf16_t*)(ws + WS_XB) + (size_t)m * DM) + F.lane;
#pragma unroll
        for (int j = 0; j < 8; ++j) { u32x2 w; w.x = pk2(v[j][0], v[j][1]); w.y = pk2(v[j][2], v[j][3]); o[64 * j] = w; }
    }
}
__device__ __forceinline__ void conv_gateup(const Frame& F, const Params& P, int jlo, int jhi) {
    LAS unsigned char* scr = F.lds + F.wave * 16384;
    for (int u = F.gw; u < 2048; u += F.NGW) { const int e = u >> 6, nb = (u >> 2) & 15, kq = u & 3;
        const int p0 = 64 * nb, T = p0 >> 8, bj = (p0 >> 7) & 1, pos = p0 & 127, col = 128 * T + pos;
        tr_loop(jlo, jhi, 1, scr, F.lane, [&](int j) { TrDesc d; d.src = (bj ? P.w_up : P.w_gate) + (size_t)e * DM * DEXP; d.ld = DEXP; d.c0 = col; d.nvalid = 64; d.gain = P.g_norm2;
            d.dst = (bf16_t*)(P.ws + WS_WGUT) + (size_t)e * 1024 * DM; d.Kd = DM; d.r0 = p0; d.k0 = 64 * (8 * kq + j); return d; }); }
}
__device__ __forceinline__ void conv_down(const Frame& F, const Params& P, int jlo, int jhi) {
    LAS unsigned char* scr = F.lds + F.wave * 16384;
    for (int u = F.gw; u < 2048; u += F.NGW) { const int e = u >> 6, nb = (u >> 1) & 31, kh = u & 1;
        tr_loop(jlo, jhi, 1, scr, F.lane, [&](int j) { TrDesc d; d.src = P.w_down + (size_t)e * DEXP * DM; d.ld = DM; d.c0 = 64 * nb; d.nvalid = 64; d.gain = nullptr;
            d.dst = (bf16_t*)(P.ws + WS_WDT) + (size_t)e * DM * DEXP; d.Kd = DEXP; d.r0 = 64 * nb; d.k0 = 64 * (4 * kh + j); return d; }); }
}

__device__ __forceinline__ void conv_small(const Frame& F, const Params& P, int lo, int hi) {
    unsigned char* ws = P.ws; LAS unsigned char* scr = F.lds + F.wave * 16384;
    constexpr int I_QQ = 8 * 48, I_PA = 16 * 32, I_O = 32 * 32, NIT = I_QQ + 2 * I_PA + I_O;
    tr_loop(lo + F.gw, hi < NIT ? hi : NIT, F.NGW, scr, F.lane, [&](int it) { TrDesc d; d.nvalid = 64;
        int r = it;
        if (r < I_QQ) { const int kb = r / 48, nb = r % 48; const int p0 = 64 * nb, T = p0 >> 8, bj = (p0 >> 7) & 1, pos = p0 & 127, head = 2 * T + (pos >> 6), col = (pos & 63) + 64 * bj;
            d.gain = P.g_cq; d.dst = (bf16_t*)(ws + WS_WTQQ); d.Kd = QR; d.r0 = p0; d.k0 = 64 * kb;
            if (head < 8) { d.src = P.w_uq; d.ld = 1024; d.c0 = head * 128 + col; } else { d.src = P.w_qidx; d.ld = 2048; d.c0 = (head - 8) * 128 + col; }
            return d; }
        r -= I_QQ; d.gain = nullptr;
        if (r < I_PA) { const int kb = r / 32, nb = r % 32; d.src = P.w_pa; d.ld = DM; d.c0 = 64 * nb; d.dst = (bf16_t*)(ws + WS_WTPA); d.Kd = 1024; d.r0 = 64 * nb; d.k0 = 64 * kb; return d; }
        r -= I_PA;
        if (r < I_PA) { const int kb = r / 32, nb = r % 32; d.src = P.w_pb; d.ld = DM; d.c0 = 64 * nb; d.dst = (bf16_t*)(ws + WS_WTPB); d.Kd = 1024; d.r0 = 64 * nb; d.k0 = 64 * kb; return d; }
        r -= I_PA;
        { const int kb = r / 32, nb = r % 32; d.src = P.w_o; d.ld = DM; d.c0 = 64 * nb; d.dst = (bf16_t*)(ws + WS_WTO); d.Kd = DM; d.r0 = 64 * nb; d.k0 = 64 * kb; return d; } });
}

#ifndef P3_NOBAR_PROBE
#define P3_NOBAR_PROBE 0
#endif
__device__ __forceinline__ unsigned key16(unsigned u) { return (u & 0x8000u) ? (~u & 0xffffu) : (u | 0x8000u); }
__device__ __forceinline__ void p3_task(const Frame& F, const Params& P, int b, int blk, bool do_sel) {
    unsigned char* ws = P.ws; LAS unsigned char* lds = F.lds;
    const bf16_t* qi = (const bf16_t*)(ws + WS_QI); const bf16_t* kir = (const bf16_t*)(ws + WS_KIR); const float* wi = (const float*)(ws + WS_WI);
    unsigned short* sel = (unsigned short*)(ws + WS_SEL); int* nsel = (int*)(ws + WS_NSEL);
    const int lane = F.lane, w = F.wave, tid = F.tid; const int t0 = 16 * blk; const int hb = lane >> 5, r = lane & 31;
    constexpr int P3_PITCH = 4096 + 32;
    LAS _Float16* sc = (LAS _Float16*)lds;
    LAS unsigned char* kb = lds + 16 * P3_PITCH * 2;
    bf16x8 af[8];
    { const size_t tokA = (size_t)b * SEQ + t0 + 2 * w + ((r >> 2) & 1); const int head = (r & 3) + 4 * (r >> 3); const bf16_t* p = qi + (tokA * 16 + head) * 128 + 8 * hb;
#pragma unroll
      for (int s = 0; s < 8; ++s) af[s] = *(const bf16x8*)(p + 16 * s); }
    float wreg[16];
    { const float* p = wi + ((size_t)b * SEQ + t0 + 2 * w + hb) * 16;
#pragma unroll
      for (int q = 0; q < 4; ++q) { const f32x4 v = *(const f32x4*)(p + 4 * q); wreg[4 * q] = v[0]; wreg[4 * q + 1] = v[1]; wreg[4 * q + 2] = v[2]; wreg[4 * q + 3] = v[3]; } }
    const int ntiles = (t0 + 16 + 31) >> 5;
    const int skey = tid >> 4, schunk = tid & 15; const unsigned soff = (unsigned)(skey * 256 + ((schunk ^ (skey & 15)) * 16));
    const unsigned kgo = (unsigned)WS_KIR + (((unsigned)b * SEQ + skey) * 128u + 8u * schunk) * 2u;
    __syncthreads();
    u32x4 st0 = *(const u32x4*)(ws + kgo), st1 = st0, st2 = st0;
    if (1 < ntiles) st1 = *(const u32x4*)(ws + kgo + 8192u);
    if (2 < ntiles) st2 = *(const u32x4*)(ws + kgo + 16384u);
    *(LAS u32x4*)(kb + soff) = st0;
    if (3 < ntiles) st0 = *(const u32x4*)(ws + kgo + 3u * 8192u);
    bf16x8 bqA[8], bqB[8]; f32x16 accA, accB;
#pragma unroll
    for (int e = 0; e < 16; ++e) { accA[e] = 0.f; accB[e] = 0.f; }
#pragma unroll
    for (int s = 0; s < 8; ++s) { bqA[s] = (bf16x8){0, 0, 0, 0, 0, 0, 0, 0}; bqB[s] = (bf16x8){0, 0, 0, 0, 0, 0, 0, 0}; }
#define P3_EPI2(ACC, S0, SUM) { const f32x2 rl_ = (f32x2){__int_as_float(max(__float_as_int(ACC[2 * (S0)]), 0)), __int_as_float(max(__float_as_int(ACC[2 * (S0) + 1]), 0))};     \
        SUM = __builtin_elementwise_fma(rl_, (f32x2){wreg[2 * (S0)], wreg[2 * (S0) + 1]}, SUM); }
#define P3_ITER(IEXPR, PAR, BQR, BQU, ACCW, ACCE, ST) { const int i_ = (IEXPR);     \
        if (P3_NOBAR_PROBE && !do_sel) { } else __syncthreads(); \
        __builtin_amdgcn_sched_barrier(0);     \
        *(LAS u32x4*)(kb + (1 - (PAR)) * 8192 + soff) = ST;     \
        { const int tl_ = (i_ + 4 < ntiles) ? (i_ + 4) : (ntiles - 1); ST = *(const u32x4*)((ws + (size_t)tl_ * 8192u) + kgo); } \
        _Pragma("unroll") for (int s = 0; s < 8; ++s) BQR[s] = *(const LAS bf16x8*)(kfrag[s] + (PAR) * 8192); \
        { f32x2 s2_ = (f32x2){0.f, 0.f}; \
            _Pragma("unroll") for (int s = 0; s < 8; ++s) { \
                if (s == 0) ACCW = __builtin_amdgcn_mfma_f32_32x32x16_bf16(af[0], BQU[0], zero16, 0, 0, 0); \
                else ACCW = __builtin_amdgcn_mfma_f32_32x32x16_bf16(af[s], BQU[s], ACCW, 0, 0, 0); \
                P3_EPI2(ACCE, s, s2_) \
                __builtin_amdgcn_sched_group_barrier(0x008, 1, 0); __builtin_amdgcn_sched_group_barrier(0x100, 1, 0); __builtin_amdgcn_sched_group_barrier(0x002, 3, 0); } \
            { const int ts_ = ((i_ >= 2) && (i_ - 2 < ntiles)) ? (i_ - 2) : 128;     \
              scrow[32 * ts_] = (_Float16)(s2_[0] + s2_[1]); } } \
        __builtin_amdgcn_sched_barrier(0); LDS_WAIT(); }
    f32x16 zero16;
#pragma unroll
    for (int e = 0; e < 16; ++e) zero16[e] = 0.f;
    const LAS unsigned char* kfrag[8];
#pragma unroll
    for (int s = 0; s < 8; ++s) kfrag[s] = kb + r * 256 + (((2 * s + hb) ^ (r & 15)) * 16);
    LAS _Float16* scrow = sc + (2 * w + hb) * P3_PITCH + r;
    for (int i = 0; i <= ntiles + 1; i += 6) {
        P3_ITER(i, 0, bqA, bqB, accB, accA, st1)
        P3_ITER(i + 1, 1, bqB, bqA, accA, accB, st2)
        P3_ITER(i + 2, 0, bqA, bqB, accB, accA, st0)
        P3_ITER(i + 3, 1, bqB, bqA, accA, accB, st1)
        P3_ITER(i + 4, 0, bqA, bqB, accB, accA, st2)
        P3_ITER(i + 5, 1, bqB, bqA, accA, accB, st0)
    }
#undef P3_ITER
#undef P3_EPI2
    if (!do_sel) return;
    typedef short s16x2 __attribute__((ext_vector_type(2)));
    for (int i = 0; i < 2; ++i) {
        const int t = t0 + 2 * w + i; const size_t tok = (size_t)b * SEQ + t; const int n = t + 1;
        unsigned short* so = sel + tok * 256;
        if (n <= 256) {
#pragma unroll
            for (int j = 0; j < 4; ++j) { const int s = 64 * j + lane; if (s < n) so[s] = (unsigned short)s; }
            if (lane == 0) nsel[tok] = n;
            continue;
        }
        LAS unsigned short* row = (LAS unsigned short*)(sc + (2 * w + i) * P3_PITCH);
        const int nceil = (n + 127) & ~127;
        for (int s = n + lane; s < nceil; s += 64) row[s] = 0xFC00u;
        LDS_WAIT(); __builtin_amdgcn_wave_barrier();
        s16x2 e[32];
#pragma unroll
        for (int j2 = 0; j2 < 32; ++j2) {
            if (128 * j2 < n) { const s16x2 u = *(const LAS s16x2*)(row + 128 * j2 + 2 * lane);
                const s16x2 m = u >> 15; const s16x2 k16 = u ^ (m | (s16x2){(short)0x8000, (short)0x8000});
                e[j2] = __builtin_bit_cast(s16x2, (__builtin_bit_cast(unsigned, k16) >> 1) & 0x7fff7fffu); }
            else e[j2] = (s16x2){0, 0};
        }
#define P3_COUNT_LT(C, OUT) { const s16x2 c2_ = (s16x2){(short)(C), (short)(C)}; s16x2 a_ = (s16x2){0, 0}; \
            _Pragma("unroll") for (int j2 = 0; j2 < 32; ++j2) { if (128 * j2 < n) a_ += (e[j2] - c2_) >> 15; } \
            OUT = -((int)a_[0] + (int)a_[1]); }
        const int nel = nceil;
        int thr = 0;
#pragma unroll 1
        for (int bit = 14; bit >= 0; --bit) { const int cand = thr | (1 << bit); int lt; P3_COUNT_LT(cand, lt);
            lt = wave_sum_i(lt, lane); if (nel - lt >= 256) thr = cand; }
        int lt0, lt1; P3_COUNT_LT(thr, lt0); P3_COUNT_LT(thr + 1, lt1);
#undef P3_COUNT_LT
        const int held = 2 * ((nceil + 127) >> 7);
        const int cgt = held - lt1, ceq = lt1 - lt0;
        int pg = cgt, pe = ceq;
#pragma unroll
        for (int o = 1; o < 64; o <<= 1) { const int a = shl_i(pg, lane - o, lane), c = shl_i(pe, lane - o, lane); if (lane >= o) { pg += a; pe += c; } }
        const int ngt = shl_i(pg, 63, lane); const int need = 256 - ngt;
        const int eqb = pe - ceq;
        const int take_eq = max(0, min(ceq, need - eqb));
        int pos = (pg - cgt) + min(eqb, need); int eqt = 0;
#pragma unroll
        for (int j2 = 0; j2 < 32; ++j2) {
            if (128 * j2 < n) {
#pragma unroll
                for (int h2 = 0; h2 < 2; ++h2) { const int k = (int)e[j2][h2];
                    const bool iseq = (k == thr); const bool take = (k > thr) || (iseq && eqt < take_eq);
                    if (take) { so[pos] = (unsigned short)(128 * j2 + 2 * lane + h2); ++pos; if (iseq) ++eqt; } }
            }
        }
        if (lane == 0) nsel[tok] = 256;
    }
}

#ifndef P4_PROBE
#define P4_PROBE 0
#endif
__device__ __forceinline__ void p4_token(const Frame& F, const Params& P, int tok, const int n, const u32x2 selrow, const bool rep) {
    const unsigned char* ws = P.ws;
    const int lane = F.lane; const int fr = lane & 15, g = lane >> 4;
    LAS unsigned char* vb0 = F.lds + F.wave * 16384;
    LAS unsigned short* selL = (LAS unsigned short*)(F.lds + 131072 + F.wave * 512);
    const unsigned bbase = (unsigned)(tok >> 12) * SEQ;
    *(LAS u32x2*)(selL + 4 * lane) = selrow;
    LDS_WAIT(); __builtin_amdgcn_wave_barrier();
    const int nch = (n + 31) >> 5;
#define P4_DMA(CH) do { LAS unsigned char* vb_ = vb0 + ((CH) & 1) * 8192; \
        _Pragma("unroll") for (int i_ = 0; i_ < 8; ++i_) { const int rho_ = 4 * i_ + g; const int slot_ = 32 * (CH) + rho_; const unsigned key_ = (slot_ < n) ? (unsigned)selL[slot_] : 0u; \
            __builtin_amdgcn_global_load_lds((const unsigned*)(ws + (unsigned)WS_VV + (bbase + key_) * 256u + 16u * (unsigned)(fr ^ (2 * (rho_ & 7)))), (LAS unsigned*)(vb_ + 1024 * i_), 16, 0, 0); } } while (0)
    const bool do_pv = !(P4_PROBE == 2 && rep);
#define P4_KDMA(CH) do { LAS unsigned char* kb_ = vb0 + ((CH) & 3) * 4096; \
        _Pragma("unroll") for (int i_ = 0; i_ < 4; ++i_) { const int rho_ = 4 * i_ + g; const int slot_ = 16 * (CH) + rho_; const unsigned key_ = (slot_ < n) ? (unsigned)selL[slot_] : 0u; \
            __builtin_amdgcn_global_load_lds((const unsigned*)(ws + (unsigned)WS_KR + (bbase + key_) * 256u + 16u * (unsigned)(fr ^ rho_)), (LAS unsigned*)(kb_ + 1024 * i_), 16, 0, 0); } } while (0)
    bf16x8 qf[4];
#pragma unroll
    for (int s = 0; s < 4; ++s) { if (fr < 8) qf[s] = *(const bf16x8*)(ws + (unsigned)WS_Q + ((unsigned)tok * 1024u + fr * 128u + 32u * s + 8u * g) * 2u); else qf[s] = (bf16x8){0, 0, 0, 0, 0, 0, 0, 0}; }
    f32x4 acc[16];
    P4_KDMA(0); P4_KDMA(1); P4_KDMA(2);
#pragma unroll
    for (int T = 0; T < 16; ++T) {
        if (T + 3 < 16) P4_KDMA(T + 3);
        if (T <= 12) asm volatile("s_waitcnt vmcnt(12)" ::: "memory"); else if (T == 13) asm volatile("s_waitcnt vmcnt(8)" ::: "memory"); else if (T == 14) asm volatile("s_waitcnt vmcnt(4)" ::: "memory"); else asm volatile("s_waitcnt vmcnt(0)" ::: "memory");
        const LAS unsigned char* kc = vb0 + (T & 3) * 4096 + fr * 256; f32x4 a = (f32x4){0.f, 0.f, 0.f, 0.f};
#pragma unroll
        for (int s = 0; s < 4; ++s) a = __builtin_amdgcn_mfma_f32_16x16x32_bf16(*(const LAS bf16x8*)(kc + (((4 * s + g) ^ fr) * 16)), qf[s], a, 0, 0, 0);
        acc[T] = a;
        LDS_WAIT();
    }
#undef P4_KDMA
    if (do_pv) { P4_DMA(0); P4_DMA(1); }
    float mx = -3.0e38f;
#pragma unroll
    for (int T = 0; T < 16; ++T)
#pragma unroll
        for (int e = 0; e < 4; ++e) { const int slot = 16 * T + 4 * g + e; const float v = (slot < n) ? acc[T][e] : -3.0e38f; acc[T][e] = v; mx = fmaxf(mx, v); }
    mx = fmaxf(mx, shx(mx, 16, lane)); mx = fmaxf(mx, shx(mx, 32, lane));
    float sum = 0.f; unsigned pb[8][4];
#pragma unroll
    for (int T = 0; T < 16; ++T) { float p[4];
#pragma unroll
        for (int e = 0; e < 4; ++e) { p[e] = __expf(acc[T][e] - mx); sum += p[e]; }
        pb[T >> 1][(T & 1) * 2] = pk2(p[0], p[1]); pb[T >> 1][(T & 1) * 2 + 1] = pk2(p[2], p[3]); }
    sum += shx(sum, 16, lane); sum += shx(sum, 32, lane);
    const float inv = 1.0f / sum;
    f32x4 o[8];
#pragma unroll
    for (int dt = 0; dt < 8; ++dt) o[dt] = (f32x4){0.f, 0.f, 0.f, 0.f};
    const int q4 = fr >> 2, p4 = fr & 3;
#pragma unroll
    for (int c = 0; c < 8; ++c) {
        if (c < nch && do_pv) {
            if (c + 1 < 8) asm volatile("s_waitcnt vmcnt(8)" ::: "memory"); else asm volatile("s_waitcnt vmcnt(0)" ::: "memory");
            const LAS unsigned char* vb = vb0 + (c & 1) * 8192;
            u32x4 bw; bw.x = pb[c][0]; bw.y = pb[c][1]; bw.z = pb[c][2]; bw.w = pb[c][3]; const bf16x8 bfrag = __builtin_bit_cast(bf16x8, bw);
            const int r0 = 4 * g + q4, r1 = 16 + 4 * g + q4;
#pragma unroll
            for (int dt = 0; dt < 8; ++dt) {
                const int ch = 2 * dt + (p4 >> 1);
                const s16x4 lo = __builtin_amdgcn_ds_read_tr16_b64_v4i16((LAS s16x4*)(vb + r0 * 256 + ((ch ^ (2 * (r0 & 7))) * 16) + 8 * (p4 & 1)));
                const s16x4 hi = __builtin_amdgcn_ds_read_tr16_b64_v4i16((LAS s16x4*)(vb + r1 * 256 + ((ch ^ (2 * (r1 & 7))) * 16) + 8 * (p4 & 1)));
                const u32x2 l2 = __builtin_bit_cast(u32x2, lo), h2 = __builtin_bit_cast(u32x2, hi); u32x4 aw; aw.x = l2.x; aw.y = l2.y; aw.z = h2.x; aw.w = h2.y;
                o[dt] = __builtin_amdgcn_mfma_f32_16x16x32_bf16(__builtin_bit_cast(bf16x8, aw), bfrag, o[dt], 0, 0, 0); }
            LDS_WAIT();
            if (c + 2 < 8) { if (c + 2 < nch) P4_DMA(c + 2); else { P4_DMA(c + 2); } }
        }
    }
    asm volatile("s_waitcnt vmcnt(0)" ::: "memory");
#undef P4_DMA
    if (fr < 8 && !(P4_PROBE != 0 && rep)) {
#pragma unroll
        for (int dt = 0; dt < 8; ++dt) { u32x2 w; w.x = pk2(o[dt][0] * inv, o[dt][1] * inv); w.y = pk2(o[dt][2] * inv, o[dt][3] * inv);
            *(u32x2*)(P.ws + (unsigned)WS_YATT + ((unsigned)tok * 1024u + fr * 128u + 16u * dt + 4u * g) * 2u) = w; }
    }
    __builtin_amdgcn_wave_barrier();
}

__device__ __forceinline__ void p4_tokens(const Frame& F, const Params& P, const bool rep) {
    const unsigned char* ws = P.ws; int tok = F.gw; if (tok >= NTOK) return;
    int n = ((const int*)(ws + WS_NSEL))[tok]; u32x2 row = *(const u32x2*)(ws + (unsigned)WS_SEL + (unsigned)tok * 512u + 8u * F.lane);
    for (;;) {
        const int nxt = tok + F.NGW; const int tl = nxt < NTOK ? nxt : tok;
        const int n2 = ((const int*)(ws + WS_NSEL))[tl]; const u32x2 row2 = *(const u32x2*)(ws + (unsigned)WS_SEL + (unsigned)tl * 512u + 8u * F.lane);
        p4_token(F, P, tok, n, row, rep);
        if (nxt >= NTOK) break;
        tok = nxt; n = n2; row = row2;
    }
}

__device__ __forceinline__ void h1_pass(const Frame& F, const Params& P, int ubase, bool rep) {
    unsigned char* ws = P.ws; LAS unsigned char* lds = F.lds;
    const int us = F.tid >> 7, d = F.tid & 127; const int uidx = ubase + us;
    const int b = uidx >> 9, c = (uidx >> 3) & 63, h = uidx & 7; const unsigned tok0 = (unsigned)(b * SEQ + 64 * c); const unsigned col0 = 128u * h;
    LAS bf16_t* KtL = (LAS bf16_t*)(lds + us * 36864); LAS bf16_t* VtL = KtL + 128 * 72;
    const unsigned e0 = (tok0 * 1024u + col0 + d);
    __syncthreads();
    float cum[64];
#pragma unroll
    for (int t = 0; t < 64; ++t) cum[t] = *(const float*)(ws + (unsigned)WS_LOGF + (e0 + 1024u * t) * 4u);
#pragma unroll
    for (int t = 1; t < 64; ++t) cum[t] += cum[t - 1];
    const float cmid = cum[31], clast = cum[63];
#pragma unroll
    for (int tg = 0; tg < 64; tg += 8) {
        unsigned short qraw[8], vraw[8];
#pragma unroll
        for (int i = 0; i < 8; ++i) { const unsigned a = (e0 + 1024u * (tg + i)) * 2u; qraw[i] = *(const bf16_t*)(ws + (unsigned)WS_QT + a); vraw[i] = *(const bf16_t*)(ws + (unsigned)WS_VH + a); }
#pragma unroll
        for (int i = 0; i < 8; ++i) { const int t = tg + i; const float g = (t == 0) ? cum[0] : (cum[t] - cum[t - 1]);
            const float e = __expf(cum[t] - cmid), ei = __expf(cmid - cum[t]), el = __expf(clast - cum[t]); const float k1 = 1.0f - __expf(g);
            const unsigned a = (e0 + 1024u * t) * 2u;
            const bf16_t qb = (bf16_t)f2bf(bf2f(qraw[i]) * e);
            if (!rep) *(bf16_t*)(ws + (unsigned)WS_QT + a) = qb; else *(bf16_t*)(ws + (unsigned)WS_KT + a) = qb;
            *(bf16_t*)(ws + (unsigned)WS_KT + a) = (bf16_t)f2bf(k1 * ei);
            KtL[d * 72 + t] = (bf16_t)f2bf(k1 * el); VtL[d * 72 + t] = vraw[i]; }
        asm volatile("" ::: "memory"); __builtin_amdgcn_sched_barrier(0);
    }
    ((float*)(ws + WS_AVEC))[(size_t)uidx * 128 + d] = __expf(cmid); ((float*)(ws + WS_DECAY))[(size_t)uidx * 128 + d] = __expf(clast);
    __syncthreads();
    const int lane2 = opaque_i(F.lane); const int fr = lane2 & 15, g = lane2 >> 4, wu = F.wave & 1;
    bf16x8 kf[8][2];
#pragma unroll
    for (int dt = 0; dt < 8; ++dt) { kf[dt][0] = *(const LAS bf16x8*)(KtL + (16 * dt + fr) * 72 + 8 * g); kf[dt][1] = *(const LAS bf16x8*)(KtL + (16 * dt + fr) * 72 + 32 + 8 * g); }
    bf16_t* KVb = (bf16_t*)(ws + WS_KV) + (size_t)uidx * 16384;
#pragma unroll
    for (int vi = 0; vi < 4; ++vi) { const int vt = 4 * wu + vi;
        const bf16x8 a0 = *(const LAS bf16x8*)(VtL + (16 * vt + fr) * 72 + 8 * g), a1 = *(const LAS bf16x8*)(VtL + (16 * vt + fr) * 72 + 32 + 8 * g);
#pragma unroll
        for (int dt = 0; dt < 8; ++dt) { f32x4 acc = (f32x4){0.f, 0.f, 0.f, 0.f};
            acc = __builtin_amdgcn_mfma_f32_16x16x32_bf16(a0, kf[dt][0], acc, 0, 0, 0); acc = __builtin_amdgcn_mfma_f32_16x16x32_bf16(a1, kf[dt][1], acc, 0, 0, 0);
#pragma unroll
            for (int e = 0; e < 4; ++e) KVb[(16 * vt + 4 * g + e) * 128 + 16 * dt + fr] = (bf16_t)f2bf(acc[e]); }
        __builtin_amdgcn_sched_barrier(0); }
}
__device__ __forceinline__ void h2_scan(const Frame& F, const Params& P) {
    unsigned char* ws = P.ws; bf16_t* KV = (bf16_t*)(ws + WS_KV); const float* decay = (const float*)(ws + WS_DECAY);
    for (int idx = blockIdx.x * 512 + F.tid; idx < 32 * 4096; idx += F.G * 512) {
    const int bh = idx >> 12, rem = idx & 4095, v = rem >> 5, d4 = rem & 31; const int b = bh >> 3, h = bh & 7;
    f32x4 S = (f32x4){0.f, 0.f, 0.f, 0.f};
    for (int c0 = 0; c0 < 64; c0 += 16) {
        u32x2 kv[16]; f32x4 dc[16];
#pragma unroll
        for (int j = 0; j < 16; ++j) { const size_t u = (size_t)((b * 64 + c0 + j) * 8 + h); kv[j] = *(const u32x2*)(KV + u * 16384 + v * 128 + 4 * d4); dc[j] = *(const f32x4*)(decay + u * 128 + 4 * d4); }
#pragma unroll
        for (int j = 0; j < 16; ++j) { const size_t u = (size_t)((b * 64 + c0 + j) * 8 + h);
            u32x2 o; o.x = pk2(S[0], S[1]); o.y = pk2(S[2], S[3]);
            *(u32x2*)(KV + u * 16384 + v * 128 + 4 * d4) = o;
            S[0] = dc[j][0] * S[0] + bf2f(kv[j].x & 0xffffu); S[1] = dc[j][1] * S[1] + bf2f(kv[j].x >> 16); S[2] = dc[j][2] * S[2] + bf2f(kv[j].y & 0xffffu); S[3] = dc[j][3] * S[3] + bf2f(kv[j].y >> 16); }
    }
    }
}
__device__ __forceinline__ void h3_unit(const Frame& F, const Params& P, int bc) {
    const unsigned char* ws = P.ws; LAS unsigned char* lds = F.lds;
    const int lane = F.lane, fr = lane & 15, g = lane >> 4, h = F.wave; const int b = bc >> 6, c = bc & 63; const int uidx = bc * 8 + h;
    const unsigned tok0 = (unsigned)(b * SEQ + 64 * c); const unsigned col0 = 128u * h;
    const unsigned rowoff = ((tok0 + fr) * 1024u + col0 + 8u * g) * 2u;
    LAS unsigned char* Vt = lds + h * 16384; LAS float* ex = (LAS float*)(lds + 131072);
    __syncthreads();
    { const unsigned vo = (unsigned)WS_VH + ((tok0 + (lane >> 4)) * 1024u + col0 + 8u * (lane & 15)) * 2u;
#pragma unroll 4
      for (int it = 0; it < 16; ++it) { const int t = 4 * it + (lane >> 4), chunk = lane & 15;
        const u32x4 wv = *(const u32x4*)(ws + vo + (unsigned)it * 4u * 2048u);
#pragma unroll
        for (int e = 0; e < 8; ++e) { const int v = 8 * chunk + e; const unsigned wd = ((const unsigned*)&wv)[e >> 1]; const unsigned short val = (e & 1) ? (unsigned short)(wd >> 16) : (unsigned short)(wd & 0xffffu);
            *(LAS unsigned short*)(Vt + v * 128 + (((t >> 2) ^ (v & 15)) * 8) + (t & 3) * 2) = val; } } }
    LDS_WAIT(); __builtin_amdgcn_wave_barrier();
    const unsigned soff = (unsigned)WS_KV + ((unsigned)uidx * 16384u + (unsigned)fr * 128u + 8u * g) * 2u;
    const unsigned aoff = (unsigned)WS_AVEC + ((unsigned)uidx * 128u + 8u * g) * 4u;
#pragma unroll 1
    for (int jh = 0; jh < 2; ++jh) {
        bf16x8 qf[2][4];
#pragma unroll
        for (int jj = 0; jj < 2; ++jj)
#pragma unroll
            for (int ks = 0; ks < 4; ++ks) qf[jj][ks] = *(const bf16x8*)(ws + (unsigned)WS_QT + rowoff + (unsigned)(16 * (2 * jh + jj)) * 2048u + 64u * ks);
        unsigned bfr[2][2][4];
#pragma unroll
        for (int jj = 0; jj < 2; ++jj)
#pragma unroll
            for (int p = 0; p < 2; ++p)
#pragma unroll
                for (int e = 0; e < 4; ++e) bfr[jj][p][e] = 0u;
#pragma unroll
        for (int i = 0; i < 4; ++i) {
            if (i <= 2 * jh + 1) {
                bf16x8 kf[4];
#pragma unroll
                for (int ks = 0; ks < 4; ++ks) kf[ks] = *(const bf16x8*)(ws + (unsigned)WS_KT + rowoff + (unsigned)(16 * i) * 2048u + 64u * ks);
#pragma unroll
                for (int jj = 0; jj < 2; ++jj) { const int j = 2 * jh + jj;
                    if (i <= j) { f32x4 st = (f32x4){0.f, 0.f, 0.f, 0.f};
#pragma unroll
                        for (int ks = 0; ks < 4; ++ks) st = __builtin_amdgcn_mfma_f32_16x16x32_bf16(kf[ks], qf[jj][ks], st, 0, 0, 0);
                        if (i == j) {
#pragma unroll
                            for (int e = 0; e < 4; ++e) st[e] = (4 * g + e <= fr) ? st[e] : 0.f; }
                        bfr[jj][i >> 1][(i & 1) * 2] = pk2(st[0], st[1]); bfr[jj][i >> 1][(i & 1) * 2 + 1] = pk2(st[2], st[3]); } }
            }
        }
#pragma unroll
        for (int ks = 0; ks < 4; ++ks) { const f32x4 a0 = *(const f32x4*)(ws + aoff + 128u * ks), a1 = *(const f32x4*)(ws + aoff + 128u * ks + 16u);
#pragma unroll
            for (int jj = 0; jj < 2; ++jj) { const u32x4 qw = __builtin_bit_cast(u32x4, qf[jj][ks]); u32x4 o;
                o.x = pk2(bf2f(qw.x & 0xffffu) * a0[0], bf2f(qw.x >> 16) * a0[1]); o.y = pk2(bf2f(qw.y & 0xffffu) * a0[2], bf2f(qw.y >> 16) * a0[3]);
                o.z = pk2(bf2f(qw.z & 0xffffu) * a1[0], bf2f(qw.z >> 16) * a1[1]); o.w = pk2(bf2f(qw.w & 0xffffu) * a1[2], bf2f(qw.w >> 16) * a1[3]);
                qf[jj][ks] = __builtin_bit_cast(bf16x8, o); } }
        f32x4 acc[8][2];
#pragma unroll
        for (int vt = 0; vt < 8; ++vt) { acc[vt][0] = (f32x4){0.f, 0.f, 0.f, 0.f}; acc[vt][1] = (f32x4){0.f, 0.f, 0.f, 0.f}; }
#pragma unroll
        for (int vt = 0; vt < 8; ++vt) {
            const int v = 16 * vt + fr;
#pragma unroll
            for (int p = 0; p < 2; ++p) {
                if (p <= jh) {
                    const u32x2 lo = *(const LAS u32x2*)(Vt + v * 128 + (((8 * p + g) ^ (v & 15)) * 8)), hi = *(const LAS u32x2*)(Vt + v * 128 + (((8 * p + 4 + g) ^ (v & 15)) * 8));
                    u32x4 aw; aw.x = lo.x; aw.y = lo.y; aw.z = hi.x; aw.w = hi.y; const bf16x8 af = __builtin_bit_cast(bf16x8, aw);
#pragma unroll
                    for (int jj = 0; jj < 2; ++jj) { u32x4 bw; bw.x = bfr[jj][p][0]; bw.y = bfr[jj][p][1]; bw.z = bfr[jj][p][2]; bw.w = bfr[jj][p][3];
                        acc[vt][jj] = __builtin_amdgcn_mfma_f32_16x16x32_bf16(af, __builtin_bit_cast(bf16x8, bw), acc[vt][jj], 0, 0, 0); }
                }
            }
#pragma unroll
            for (int ks = 0; ks < 4; ++ks) {
                const bf16x8 af = *(const bf16x8*)(ws + soff + (unsigned)(16 * vt) * 256u + 64u * ks);
#pragma unroll
                for (int jj = 0; jj < 2; ++jj) acc[vt][jj] = __builtin_amdgcn_mfma_f32_16x16x32_bf16(af, qf[jj][ks], acc[vt][jj], 0, 0, 0);
            }
            if ((vt & 3) == 3) asm volatile("" ::: "memory");
        }
#pragma unroll
        for (int jj = 0; jj < 2; ++jj) { float s = 0.f;
#pragma unroll
            for (int vt = 0; vt < 8; ++vt) s += (acc[vt][jj][0] * acc[vt][jj][0] + acc[vt][jj][1] * acc[vt][jj][1]) + (acc[vt][jj][2] * acc[vt][jj][2] + acc[vt][jj][3] * acc[vt][jj][3]);
            s += shx(s, 16, lane); s += shx(s, 32, lane);
            if (g == 0) ex[(16 * (2 * jh + jj) + fr) * 8 + h] = s; }
        __syncthreads();
        const unsigned ooff = ((tok0 + fr) * 1024u + col0 + 4u * g) * 2u;
#pragma unroll
        for (int jj = 0; jj < 2; ++jj) { const int t = 16 * (2 * jh + jj) + fr;
            const f32x4 e0 = *(const LAS f32x4*)(ex + t * 8), e1 = *(const LAS f32x4*)(ex + t * 8 + 4);
            const float rs = __builtin_amdgcn_rsqf((((e0[0] + e0[1]) + (e0[2] + e0[3])) + ((e1[0] + e1[1]) + (e1[2] + e1[3]))) * (1.0f / 1024.0f) + EPS);
#pragma unroll
            for (int vt = 0; vt < 8; ++vt) { const unsigned o = ooff + (unsigned)(16 * (2 * jh + jj)) * 2048u + 32u * vt;
                const u32x2 sgw = *(const u32x2*)(ws + (unsigned)WS_SG + o); const f32x4 gh = *(const f32x4*)(P.g_hnorm + col0 + 16 * vt + 4 * g);
                const float y0 = acc[vt][jj][0] * rs * gh[0] * bf2f(sgw.x & 0xffffu), y1 = acc[vt][jj][1] * rs * gh[1] * bf2f(sgw.x >> 16);
                const float y2 = acc[vt][jj][2] * rs * gh[2] * bf2f(sgw.y & 0xffffu), y3 = acc[vt][jj][3] * rs * gh[3] * bf2f(sgw.y >> 16);
                u32x2 w; w.x = pk2(y0, y1); w.y = pk2(y2, y3); *(u32x2*)(P.ws + (unsigned)WS_YREC + o) = w; } }
        __syncthreads();
    }
}

__device__ __forceinline__ void p7_pass(const Frame& F, const Params& P, int task0, bool rep) {
    unsigned char* ws = P.ws; LAS unsigned char* lds = F.lds;
    const int lane = F.lane, fr = lane & 15, g = lane >> 4, w = F.wave; const int tt = w & 3, kh = w >> 2; const unsigned tok0 = (unsigned)task0 * 16u;
    constexpr int STG = 57344;
    LAS float* lgx = (LAS float*)(lds + 2 * STG);
    LAS int* hist = (LAS int*)(lds + 2 * STG + 2 * 64 * 48 * 4);
    if (F.tid < 32) hist[F.tid] = 0;
    const int l5 = lane & 31, lh = lane >> 5;
#define P7_DMA(KC) do { LAS unsigned char* st_ = lds + ((KC) & 1) * STG; \
        _Pragma("unroll") for (int i_ = 0; i_ < 4; ++i_) { const int row_ = 8 * w + 2 * i_ + lh; \
            __builtin_amdgcn_global_load_lds((const unsigned*)(ws + (unsigned)WS_X1B + (tok0 + row_) * 4096u + (unsigned)(KC) * 512u + 16u * (unsigned)(l5 ^ (row_ & 15))), (LAS unsigned*)(st_ + (8 * w + 2 * i_) * 512), 16, 0, 0); } \
        _Pragma("unroll") for (int i_ = 0; i_ < 3; ++i_) { const int row_ = 6 * w + 2 * i_ + lh; \
            __builtin_amdgcn_global_load_lds((const unsigned*)(ws + (unsigned)WS_WRT + (unsigned)row_ * 4096u + (unsigned)(KC) * 512u + 16u * (unsigned)(l5 ^ (row_ & 15))), (LAS unsigned*)(st_ + 32768 + (6 * w + 2 * i_) * 512), 16, 0, 0); } } while (0)
    if (!rep) { int* tokrow = (int*)(ws + WS_TOKROW); for (int i = (task0 >> 2) * 159 + F.tid; i < (task0 >> 2) * 159 + 159; i += 512) tokrow[i] = 0; }
    f32x4 acc[3];
#pragma unroll
    for (int nt = 0; nt < 3; ++nt) acc[nt] = (f32x4){0.f, 0.f, 0.f, 0.f};
    __syncthreads();
    P7_DMA(0);
#pragma unroll 1
    for (int kc = 0; kc < 8; ++kc) {
        if (kc + 1 < 8) { P7_DMA(kc + 1); asm volatile("s_waitcnt vmcnt(7)" ::: "memory"); } else asm volatile("s_waitcnt vmcnt(0)" ::: "memory");
        __syncthreads();
        const LAS unsigned char* st = lds + (kc & 1) * STG;
#pragma unroll
        for (int q = 0; q < 4; ++q) { const int c = 4 * (4 * kh + q) + g;
            const bf16x8 a = *(const LAS bf16x8*)(st + (16 * tt + fr) * 512 + ((c ^ fr) * 16));
#pragma unroll
            for (int nt = 0; nt < 3; ++nt) acc[nt] = __builtin_amdgcn_mfma_f32_16x16x32_bf16(a, *(const LAS bf16x8*)(st + 32768 + (16 * nt + fr) * 512 + ((c ^ fr) * 16)), acc[nt], 0, 0, 0); }
        LDS_WAIT();
        __syncthreads();
    }
#undef P7_DMA
#pragma unroll
    for (int nt = 0; nt < 3; ++nt)
#pragma unroll
        for (int e = 0; e < 4; ++e) lgx[(kh * 64 + 16 * tt + 4 * g + e) * 48 + 16 * nt + fr] = acc[nt][e];
    __syncthreads();
    if (kh == 0 && lane < 16) {
        const unsigned tok = tok0 + 16u * tt + lane; const float* part = (const float*)(ws + WS_SSQ2) + (size_t)tok * 32; float ssq = 0.f;
#pragma unroll
        for (int q = 0; q < 8; ++q) { const f32x4 v = *(const f32x4*)(part + 4 * q); ssq += (v[0] + v[1]) + (v[2] + v[3]); }
        const float rs = 1.0f / sqrtf(ssq * (1.0f / DM) + EPS);
        const LAS float* l = lgx + (16 * tt + lane) * 48; const LAS float* l2 = l + 64 * 48;
        float gl0 = (l[0] + l2[0]) * rs + P.b_grp[0]; int grp = 0; float gmax = gl0; float glv[4]; glv[0] = gl0;
#pragma unroll
        for (int j = 1; j < 4; ++j) { const float v = (l[j] + l2[j]) * rs + P.b_grp[j]; glv[j] = v; if (v > gmax) { gmax = v; grp = j; } }
        float gsum = 0.f;
#pragma unroll
        for (int j = 0; j < 4; ++j) gsum += expf(glv[j] - gmax);
        const float pg = 1.0f / gsum;
        float m1 = -3.0e38f, m2 = -3.0e38f; int i1 = 0, i2 = 0;
#pragma unroll
        for (int i = 0; i < 8; ++i) { const float v = (l[4 + 8 * grp + i] + l2[4 + 8 * grp + i]) * rs + P.b_exp[8 * grp + i];
            if (v > m1) { m2 = m1; i2 = i1; m1 = v; i1 = i; } else if (v > m2) { m2 = v; i2 = i; } }
        const float r2 = expf(m2 - m1); const float g0 = pg / (1.0f + r2), g1 = pg * r2 / (1.0f + r2);
        const int e0 = grp * 8 + i1, e1 = grp * 8 + i2;
        const int r0 = __hip_atomic_fetch_add(hist + e0, 1, __ATOMIC_RELAXED, __HIP_MEMORY_SCOPE_WORKGROUP), r1 = __hip_atomic_fetch_add(hist + e1, 1, __ATOMIC_RELAXED, __HIP_MEMORY_SCOPE_WORKGROUP);
        ((int*)(ws + WS_ROUTE_E))[tok * 2] = e0 | (r0 << 8); ((int*)(ws + WS_ROUTE_E))[tok * 2 + 1] = e1 | (r1 << 8);
        ((float*)(ws + WS_ROUTE_G))[tok * 2] = g0; ((float*)(ws + WS_ROUTE_G))[tok * 2 + 1] = g1;
        ((float*)(ws + WS_RSTD1))[tok] = rs;
    }
    __syncthreads();
    if (F.tid < 32) ((int*)(ws + WS_CNTB))[(task0 >> 2) * 32 + F.tid] = hist[F.tid];
}

__device__ __forceinline__ void p7b_gather(const Frame& F, const Params& P, bool rep) {
    unsigned char* ws = P.ws; int* ctl = (int*)(ws + WS_CTL); const int lane = F.lane;
    int* tokrow = (int*)(ws + WS_TOKROW); const int* cb = (const int*)(ws + WS_CNTB);
    for (int tok0 = (F.wave * F.G + (int)blockIdx.x) * 64; tok0 < NTOK; tok0 += F.NGW * 64) {
        const int gi = tok0 >> 6;
        const int e = lane & 31; int tot = 0, lt = 0;
#pragma unroll 8
        for (int p = lane >> 5; p < NTOK / 64; p += 2) { const int v = cb[p * 32 + e]; tot += v; lt += (p < gi) ? v : 0; }
        tot += shl_i(tot, lane ^ 32, lane); lt += shl_i(lt, lane ^ 32, lane);
        const int c = (lane < 32) ? tot : 0; const int pad = (c + 255) & ~255;
        int incl = pad;
#pragma unroll
        for (int o = 1; o < 64; o <<= 1) { const int t = shl_i(incl, lane - o, lane); if (lane >= o) incl += t; }
        const int basev = incl - pad;
        if (gi == 0 && !rep) {
            const int total = shl_i(incl, 31, lane); if (lane == 0) ctl[128] = total >> 8;
            if (lane < 32) { for (int r = basev >> 8; r < (incl >> 8); ++r) ctl[256 + r] = lane; }
        }
        const int rowbase = basev + lt;
        const int tok = tok0 + lane;
        const int pk0 = ((const int*)(ws + WS_ROUTE_E))[tok * 2], pk1 = ((const int*)(ws + WS_ROUTE_E))[tok * 2 + 1];
        const int d0 = shl_i(rowbase, pk0 & 255, lane) + (pk0 >> 8), d1 = shl_i(rowbase, pk1 & 255, lane) + (pk1 >> 8);
        const float rs = ((const float*)(ws + WS_RSTD1))[tok];
        tokrow[d0] = tok; tokrow[d1] = tok;
        ((float*)(ws + WS_RSS))[d0] = rs; ((float*)(ws + WS_RSS))[d1] = rs;
        ((float*)(ws + WS_GS))[d0] = ((const float*)(ws + WS_ROUTE_G))[tok * 2]; ((float*)(ws + WS_GS))[d1] = ((const float*)(ws + WS_ROUTE_G))[tok * 2 + 1];
        ((int*)(ws + WS_DEST))[tok * 2] = d0; ((int*)(ws + WS_DEST))[tok * 2 + 1] = d1;
    }
}

__device__ __forceinline__ void p9_final(const Frame& F, const Params& P) {
    unsigned char* ws = P.ws; const bf16_t* ys = (const bf16_t*)(ws + WS_YS); const bf16_t* x1b = (const bf16_t*)(ws + WS_X1B); const int lane = F.lane;
    for (int tok = F.gw; tok < NTOK; tok += F.NGW) {
        const int d0 = ((const int*)(ws + WS_DEST))[tok * 2], d1 = ((const int*)(ws + WS_DEST))[tok * 2 + 1];
        f32x4* xr = (f32x4*)(P.out + (size_t)tok * DM) + lane; const u32x2* x0 = (const u32x2*)(x1b + (size_t)tok * DM) + lane;
        const u32x2* y0 = (const u32x2*)(ys + (size_t)d0 * DM) + lane; const u32x2* y1 = (const u32x2*)(ys + (size_t)d1 * DM) + lane;
        f32x4 v[8]; float s = 0.f;
#pragma unroll
        for (int j = 0; j < 8; ++j) { const u32x2 x = x0[64 * j], a = y0[64 * j], b = y1[64 * j];
            v[j][0] = bf2f(x.x & 0xffffu) + (bf2f(a.x & 0xffffu) + bf2f(b.x & 0xffffu)); v[j][1] = bf2f(x.x >> 16) + (bf2f(a.x >> 16) + bf2f(b.x >> 16));
            v[j][2] = bf2f(x.y & 0xffffu) + (bf2f(a.y & 0xffffu) + bf2f(b.y & 0xffffu)); v[j][3] = bf2f(x.y >> 16) + (bf2f(a.y >> 16) + bf2f(b.y >> 16));
            s += (v[j][0] * v[j][0] + v[j][1] * v[j][1]) + (v[j][2] * v[j][2] + v[j][3] * v[j][3]); }
        s = wave_sum(s, lane); const float rs = 1.0f / sqrtf(s * (1.0f / DM) + EPS);
#pragma unroll
        for (int j = 0; j < 8; ++j) { const f32x4 gf = *((const f32x4*)P.g_final + 64 * j + lane); xr[64 * j] = v[j] * rs * gf; }
    }
}

#ifndef PHMASK
#define PHMASK 0xFFFFFF
#endif
#ifndef SELREP
#define SELREP 0
#endif
#ifndef REPMASK
#define REPMASK 0
#endif
#define TS_READ(v) asm volatile("s_memrealtime %0\n\ts_waitcnt lgkmcnt(0)" : "=s"(v) :: "memory")
#ifdef TS_A0
#define TS_MARK(k) { if (blockIdx.x == TS_BLOCK && threadIdx.x == 0) { unsigned long long t_; TS_READ(t_); __hip_atomic_store((unsigned long long*)(ws + WS_BAR + 15360) + (k), t_, __ATOMIC_RELAXED, __HIP_MEMORY_SCOPE_AGENT); } }
#else
#define TS_MARK(k)
#endif
#define PH(k) for (int _rep = 0; _rep < 1 + ((REPMASK >> (k)) & 1); ++_rep) if constexpr ((PHMASK >> (k)) & 1)
__global__ void __launch_bounds__(512, 2) mega_fwd(Params P) {
    extern __shared__ __attribute__((aligned(16))) unsigned char lds_raw[];
    cg::grid_group grid = cg::this_grid();
    LAS unsigned char* lds = (LAS unsigned char*)lds_raw; const int G = gridDim.x;
    const int wave_id = __builtin_amdgcn_readfirstlane((int)(threadIdx.x >> 6));
    unsigned char* ws = P.ws;
    const float* ctab = (const float*)(ws + WS_COS); const float* stab = (const float*)(ws + WS_SIN);
    volatile LAS unsigned* bst = (volatile LAS unsigned*)(lds + LDS_PHASE_BYTES);
    if (wave_id == 0 && lane_id() < 2) bst[lane_id()] = 0u;
    __syncthreads();
    const XcdBarrier xbar = xcd_barrier_post((unsigned*)(ws + WS_BAR), bst, wave_id);
#ifdef TS_A0
    TS_MARK(12)
#endif
    if (ws == nullptr) grid.sync();
    PH(0) { const Frame F = make_frame(lds, wave_id); p0_prep(F, P); }
    xcd_barrier(xbar);
    TS_MARK(0)
    const int skew = (blockIdx.x >> 3) & 3;
    const bool skew_first = skew != 0;
    if (skew_first) { const Frame F = make_frame(lds, wave_id); conv_small(F, P, 0, skew == 3 ? 2432 : 2048); conv_down(F, P, 0, (4 * skew) / 3); __syncthreads(); }
#ifdef P1_DELAY_US
    { const unsigned long long t0 = __builtin_amdgcn_s_memrealtime(); const unsigned long long dt = (unsigned long long)(skew * P1_DELAY_US) * 100ull;
      while (__builtin_amdgcn_s_memrealtime() - t0 < dt) __builtin_amdgcn_s_sleep(8); }
#endif
    PH(1) { SchedDense S; S.A = (const char*)(ws + WS_XB); S.Bt = (const char*)(ws + WS_WTIN); S.nM = NTOK / 256; S.nN = NP1 / 256; S.G = G; S.c = blockIdx.x; S.tstep = (size_t)256 * DM * 2;
      EpiIn E; E.ws = ws; E.rstd1 = (const float*)(ws + WS_RSTD1); E.lb = (const float*)(ws + WS_LB); E.ctab = ctab; E.stab = stab;
      if (_rep == 0) pg8::gemm_phase(lds, DM, S, E, wave_id); else {
#if defined(EPI_PROBE_MODE)
        EpiProbeStore<EPI_PROBE_MODE> E0; E0.ws = ws; pg8::gemm_phase(lds, DM, S, E0, wave_id);
#else
        EpiNull E0; pg8::gemm_phase(lds, DM, S, E0, wave_id);
#endif
      } }
    { const Frame F = make_frame(lds, wave_id); if (skew != 3) { conv_small(F, P, skew == 0 ? 0 : 2048, 2432); conv_down(F, P, (4 * skew) / 3, 4); } }
    xcd_barrier(xbar);
    TS_MARK(1)
    PH(2) { SchedDense S; S.A = (const char*)(ws + WS_CQ); S.Bt = (const char*)(ws + WS_WTQQ); S.nM = NTOK / 256; S.nN = 3072 / 256; S.G = G; S.c = blockIdx.x; S.tstep = (size_t)256 * QR * 2;
      EpiQ E; E.ws = ws;
      pg8::gemm_phase(lds, QR, S, E, wave_id); }
    PH(3) { const Frame F = make_frame(lds, wave_id); for (int u = 4 * blockIdx.x; u < 2048; u += 4 * G) h1_pass(F, P, u, _rep != 0); }
    xcd_barrier(xbar);
    TS_MARK(2)
    PH(4) { const Frame F = make_frame(lds, wave_id); for (int task = blockIdx.x; task < 1024; task += G) { const int bb = task >> 8, j = task & 255; p3_task(F, P, bb, (bb & 1) ? 255 - j : j, (_rep == 0) || SELREP); } }
    __syncthreads();
    PH(5) { const Frame F = make_frame(lds, wave_id); h2_scan(F, P); }
    xcd_barrier(xbar);
    TS_MARK(3)
#if defined(DUMP) && DUMP == 3
    { const Frame F = make_frame(lds, wave_id); const float* src = (const float*)(ws + WS_KV);
      for (size_t i = (size_t)blockIdx.x * 512 + F.tid; i < (size_t)NTOK * DM; i += (size_t)G * 512) P.out[i] = src[i];
      return; }
#endif
#if defined(DUMP) && DUMP == 2
    { const Frame F = make_frame(lds, wave_id); const bf16_t* s0 = (const bf16_t*)(ws + WS_QT); const bf16_t* s1 = (const bf16_t*)(ws + WS_KT);
      for (size_t i = (size_t)blockIdx.x * 512 + F.tid; i < (size_t)NTOK * DM; i += (size_t)G * 512) { const size_t r = i / DM, c = i % DM; P.out[i] = bf2f((c < 1024 ? s0 : s1)[r * 1024 + (c & 1023)]); }
      return; }
#endif
    PH(6) { const Frame F = make_frame(lds, wave_id); p4_tokens(F, P, _rep != 0); }
    PH(7) { const Frame F = make_frame(lds, wave_id); for (int bc = blockIdx.x; bc < 256; bc += G) h3_unit(F, P, bc); }
    xcd_barrier(xbar);
    TS_MARK(4)
#ifdef DUMP
    { const Frame F = make_frame(lds, wave_id); const bf16_t* src = (const bf16_t*)(ws + (DUMP == 0 ? WS_YATT : WS_YREC));
      for (size_t i = (size_t)blockIdx.x * 512 + F.tid; i < (size_t)NTOK * DM; i += (size_t)G * 512) { const size_t r = i / DM, c = i % DM; P.out[i] = bf2f(src[r * 1024 + (c & 1023)]); }
      return; }
#endif
    PH(8) { SchedMerged S; S.A0 = (const char*)(ws + WS_YATT); S.A1 = (const char*)(ws + WS_YREC); S.B0 = (const char*)(ws + WS_WTPA); S.B1 = (const char*)(ws + WS_WTPB);
      S.nM = NTOK / 256; S.nN = DM / 256; S.G = G; S.c = blockIdx.x; S.tstep = (size_t)256 * 1024 * 2;
      EpiMerged E; E.ws = ws;
      if (skew_first) { const Frame F = make_frame(lds, wave_id); conv_gateup(F, P, 0, skew); __syncthreads(); }
      pg8::gemm_phase(lds, 1024, S, E, wave_id);
      if (skew != 3) { const Frame F = make_frame(lds, wave_id); conv_gateup(F, P, skew, 3); } }
    xcd_barrier(xbar);
    TS_MARK(5)
    if (skew_first) { PH(9) { const Frame F = make_frame(lds, wave_id); conv_gateup(F, P, 3, 3 + (5 * skew) / 3); } __syncthreads(); }
    PH(10) { SchedDense S; S.A = (const char*)(ws + WS_MERGED); S.Bt = (const char*)(ws + WS_WTO); S.nM = NTOK / 256; S.nN = DM / 256; S.G = G; S.c = blockIdx.x; S.tstep = (size_t)256 * DM * 2;
      EpiX1 E; E.ws = ws; E.x = P.x; E.x1 = P.out;
      pg8::gemm_phase(lds, DM, S, E, wave_id); }
    TS_MARK(13)
    if (skew != 3) { PH(9) { const Frame F = make_frame(lds, wave_id); conv_gateup(F, P, 3 + (5 * skew) / 3, 8); } }
    TS_MARK(14)
    xcd_barrier(xbar);
    TS_MARK(6)
    PH(12) { const Frame F = make_frame(lds, wave_id); for (int t = 4 * blockIdx.x; t < NTOK / 16; t += 4 * G) p7_pass(F, P, t, _rep != 0); }
    xcd_barrier(xbar);
    TS_MARK(7)
    PH(13) { const Frame F = make_frame(lds, wave_id); p7b_gather(F, P, _rep != 0); }
    xcd_barrier(xbar);
    TS_MARK(8)
    const int* ctl = (const int*)(ws + WS_CTL);
    PH(14) { SchedMoeG S; S.gA = (const char*)(ws + WS_X1B); S.tokrow = (const int*)(ws + WS_TOKROW); S.Bt = (const char*)(ws + WS_WGUT); S.tile_e = ctl + 256; S.ntiles = __builtin_amdgcn_readfirstlane(ctl[128]); S.NCT = 4; S.G = G; S.c = blockIdx.x; S.tstep = (size_t)256 * DM * 2;
      EpiGateUp E; E.ws = ws;
      pg8::gemm_phase<EpiGateUp, SchedMoeG, true>(lds, DM, S, E, wave_id); }
    xcd_barrier(xbar);
    TS_MARK(9)
    PH(15) { SchedMoe S; S.A = (const char*)(ws + WS_ACT); S.Bt = (const char*)(ws + WS_WDT); S.tile_e = ctl + 256; S.ntiles = __builtin_amdgcn_readfirstlane(ctl[128]); S.NCT = 8; S.G = G; S.c = blockIdx.x; S.tstep = (size_t)256 * DEXP * 2;
      EpiDown E; E.ws = ws;
      pg8::gemm_phase(lds, DEXP, S, E, wave_id); }
    xcd_barrier(xbar);
    TS_MARK(10)
    PH(16) { const Frame F = make_frame(lds, wave_id); p9_final(F, P); }
#ifdef TS_A0
    TS_MARK(11)
    if (blockIdx.x == TS_BLOCK && threadIdx.x == 0) { unsigned long long t0; TS_READ(t0);
      unsigned long long* tsb = (unsigned long long*)(ws + WS_BAR + 15360);
#define TS_LD(k) __hip_atomic_load(tsb + (k), __ATOMIC_RELAXED, __HIP_MEMORY_SCOPE_AGENT)
      const unsigned long long dt = 10ull * (TS_LD(TS_A1) - TS_LD(TS_A0)) + 1024000ull * ((TS_LD(TS_B1) - TS_LD(TS_B0)) / 800ull);
      for (;;) { unsigned long long t1; TS_READ(t1); if (t1 - t0 >= dt) break; __builtin_amdgcn_s_sleep(8); } }
#endif
}

extern "C" void kernel_launch(void* const* d_in, const int* in_sizes, int n_in, void* d_out, int out_size, void* d_ws, size_t ws_size, hipStream_t stream) {
    static int grid = 0;
    if (grid == 0) {
        if (n_in != 20 || out_size != NTOK * DM || ws_size < WS_END) { fprintf(stderr, "kernel_launch: unexpected shapes (n_in %d out %d ws %zu, need %zu)\n", n_in, out_size, ws_size, (size_t)WS_END); grid = -1; return; }
        int dev = 0, cus = 0, per_cu = 0;
        if (hipGetDevice(&dev) != hipSuccess || hipDeviceGetAttribute(&cus, hipDeviceAttributeMultiprocessorCount, dev) != hipSuccess) { grid = -1; return; }
        if (hipFuncSetAttribute((const void*)mega_fwd, hipFuncAttributeMaxDynamicSharedMemorySize, LDS_BYTES) != hipSuccess) { fprintf(stderr, "kernel_launch: hipFuncSetAttribute failed\n"); grid = -1; return; }
        if (hipOccupancyMaxActiveBlocksPerMultiprocessor(&per_cu, (const void*)mega_fwd, 512, LDS_BYTES) != hipSuccess || per_cu < 1) { fprintf(stderr, "kernel_launch: occupancy query says %d\n", per_cu); (void)hipGetLastError(); grid = -1; return; }
        grid = cus;
        if (grid > 256) grid = 256;
    }
    if (grid < 0) return;
    if (hipMemsetAsync((unsigned char*)d_ws + WS_BAR, 0, 16384, stream) != hipSuccess) { fprintf(stderr, "kernel_launch: memset of the barrier words failed\n"); return; }
    Params p{};
    const float** pp = (const float**)&p;
    for (int i = 0; i < 20; ++i) pp[i] = (const float*)d_in[i];
    p.out = (float*)d_out; p.ws = (unsigned char*)d_ws;
    void* args[] = {&p};
    hipError_t e = hipLaunchCooperativeKernel((const void*)mega_fwd, dim3(grid), dim3(512), args, LDS_BYTES, stream);
    if (e != hipSuccess) fprintf(stderr, "cooperative launch failed: %s (grid %d)\n", hipGetErrorString(e), grid);
}
```

```cpp
#include <hip/hip_runtime.h>
#include <hip/hip_cooperative_groups.h>
#include <cstdio>
#include <cstdint>
namespace cg = cooperative_groups;

#define LAS __attribute__((address_space(3)))
typedef unsigned short bf16_t;
typedef short bf16x8 __attribute__((ext_vector_type(8)));
typedef float f32x4 __attribute__((ext_vector_type(4)));
typedef float f32x2 __attribute__((ext_vector_type(2)));
typedef float f32x16 __attribute__((ext_vector_type(16)));
typedef unsigned u32x4 __attribute__((ext_vector_type(4)));
typedef unsigned u32x2 __attribute__((ext_vector_type(2)));

constexpr int NTOK = 16384, DM = 2048, SEQ = 4096, NBATCH = 4;
constexpr int DIN = 9104, NP1 = 9216;
constexpr int QR = 512;
constexpr int NEXP = 32, DEXP = 512;
constexpr int XS_ROWS = 40704;
constexpr float EPS = 1e-6f;

constexpr size_t MiB = 1u << 20;
constexpr size_t WS_R0 = 0;
constexpr size_t WS_R1 = 64 * MiB;
constexpr size_t WS_R2 = 100 * MiB;
constexpr size_t WS_R3 = 228 * MiB;
constexpr size_t WS_R4 = 292 * MiB;
constexpr size_t WS_R5 = 420 * MiB;
constexpr size_t WS_R6 = 452 * MiB;
constexpr size_t WS_R7 = 484 * MiB;
constexpr size_t WS_R8 = 516 * MiB;
constexpr size_t WS_R9 = 548 * MiB;
constexpr size_t WS_R10 = 564 * MiB;
constexpr size_t WS_R11 = 580 * MiB;
constexpr size_t WS_MISC = 599 * MiB;
constexpr size_t WS_END = 607 * MiB;

constexpr size_t WS_XB = WS_R0, WS_QI = WS_R0, WS_YATT = WS_R0, WS_YREC = WS_R0 + 32 * MiB, WS_X1B = WS_R0, WS_ACT = WS_R3;
constexpr size_t WS_WTIN = WS_R1, WS_Q = WS_R1;
constexpr size_t WS_RG = WS_R2, WS_SB = WS_R2 + 64 * MiB, WS_WGUT = WS_R5;
constexpr size_t WS_LOGF = WS_R3, WS_SCG = WS_R3, WS_MERGED = WS_R3;
constexpr size_t WS_SEL = 548 * MiB, WS_SCJUNK = 548 * MiB + 8 * MiB;
constexpr size_t WS_KV = WS_R4, WS_WDT = WS_R4 + 64 * MiB;
constexpr size_t WS_QT = WS_R5, WS_XS = WS_R5, WS_YS = WS_R5;
constexpr size_t WS_VH = WS_R6, WS_SG = WS_R7, WS_KT = WS_R8, WS_CQ = WS_R9;
constexpr size_t WS_KR = WS_R10, WS_KIR = WS_R10 + 4 * MiB, WS_VV = WS_R10 + 8 * MiB, WS_WI = WS_R10 + 12 * MiB, WS_COS = WS_R10 + 13 * MiB, WS_SIN = WS_R10 + 14 * MiB;
constexpr size_t WS_WTQQ = WS_R11, WS_WTPA = WS_R11 + 3 * MiB, WS_WTPB = WS_R11 + 7 * MiB, WS_WTO = WS_R11 + 11 * MiB;
constexpr size_t WS_RSTD1 = WS_MISC;
constexpr size_t WS_SSQCQ = WS_MISC + 64 * 1024;
constexpr size_t WS_SSQ2 = WS_MISC + 576 * 1024;
constexpr size_t WS_NSEL = WS_MISC + 2624 * 1024;
constexpr size_t WS_LB = WS_MISC + 2688 * 1024;
constexpr size_t WS_AVEC = WS_MISC + 2692 * 1024;
constexpr size_t WS_DECAY = WS_MISC + 3716 * 1024;
constexpr size_t WS_ROUTE_E = WS_MISC + 4740 * 1024;
constexpr size_t WS_ROUTE_G = WS_MISC + 4868 * 1024;
constexpr size_t WS_DEST = WS_MISC + 4996 * 1024;
constexpr size_t WS_RSS = WS_MISC + 5124 * 1024;
constexpr size_t WS_GS = WS_MISC + 5284 * 1024;
constexpr size_t WS_WRT = WS_MISC + 5444 * 1024;
constexpr size_t WS_CTL = WS_MISC + 5636 * 1024;
constexpr size_t WS_BAR = WS_MISC + 5640 * 1024;
constexpr size_t WS_TOKROW = WS_MISC + 5656 * 1024;
constexpr size_t WS_CNTB = WS_MISC + 5824 * 1024;
constexpr size_t WS_BST = WS_MISC + 5856 * 1024;
constexpr size_t WS_COSB = WS_MISC + 5864 * 1024, WS_SINB = WS_MISC + 6376 * 1024;
static_assert(WS_TOKROW + 163840 <= WS_CNTB && WS_CNTB + 32768 <= WS_BST && WS_BST + 2048 <= WS_COSB && WS_SINB + 524288 <= WS_END, "ws map");

__device__ __forceinline__ float bf2f(unsigned b) { return __uint_as_float(b << 16); }
__device__ __forceinline__ unsigned f2bf(float f) { unsigned u = __float_as_uint(f); return (u + 0x7fffu + ((u >> 16) & 1u)) >> 16; }
typedef __bf16 bf16v2 __attribute__((ext_vector_type(2)));
__device__ __forceinline__ unsigned pk2(float lo, float hi) { f32x2 v = {lo, hi}; bf16v2 b = __builtin_convertvector(v, bf16v2); return __builtin_bit_cast(unsigned, b); }
__device__ __forceinline__ float shx(float v, int m, int lane) { return __int_as_float(__builtin_amdgcn_ds_bpermute((lane ^ m) << 2, __float_as_int(v))); }
__device__ __forceinline__ int shx_i(int v, int m, int lane) { return __builtin_amdgcn_ds_bpermute((lane ^ m) << 2, v); }
__device__ __forceinline__ int shl_i(int v, int src, int) { return __builtin_amdgcn_ds_bpermute(src << 2, v); }
__device__ __forceinline__ float wave_sum(float v, int lane) {
#pragma unroll
    for (int o = 1; o < 64; o <<= 1) v += shx(v, o, lane);
    return v;
}
template <int N> struct IntC { static constexpr int value = N; };
__device__ __forceinline__ int wave_sum_u(int v) {
    v += __builtin_amdgcn_update_dpp(0, v, 0xB1, 0xf, 0xf, true);
    v += __builtin_amdgcn_update_dpp(0, v, 0x4E, 0xf, 0xf, true);
    v += __builtin_amdgcn_update_dpp(0, v, 0x141, 0xf, 0xf, true);
    v += __builtin_amdgcn_update_dpp(0, v, 0x140, 0xf, 0xf, true);
    return __builtin_amdgcn_readlane(v, 0) + __builtin_amdgcn_readlane(v, 16) + __builtin_amdgcn_readlane(v, 32) + __builtin_amdgcn_readlane(v, 48);
}
__device__ __forceinline__ int wave_scan_incl(int v) {
    v += __builtin_amdgcn_update_dpp(0, v, 0x111, 0xf, 0xf, true);
    v += __builtin_amdgcn_update_dpp(0, v, 0x112, 0xf, 0xf, true);
    v += __builtin_amdgcn_update_dpp(0, v, 0x114, 0xf, 0xf, true);
    v += __builtin_amdgcn_update_dpp(0, v, 0x118, 0xf, 0xf, true);
    v += __builtin_amdgcn_update_dpp(0, v, 0x142, 0xa, 0xf, false);
    v += __builtin_amdgcn_update_dpp(0, v, 0x143, 0xc, 0xf, false);
    return v;
}
__device__ __forceinline__ int wave_sum_i(int v, int lane) {
#pragma unroll
    for (int o = 1; o < 64; o <<= 1) v += shx_i(v, o, lane);
    return v;
}
__device__ __forceinline__ float sigmoidf_(float x) { return __builtin_amdgcn_rcpf(1.0f + __expf(-x)); }
__device__ __forceinline__ float siluf_(float x) { return x * sigmoidf_(x); }
__device__ __forceinline__ int opaque_i(int x) { asm volatile("" : "+v"(x)); return x; }
__device__ __forceinline__ int lane_id() { int x; asm volatile("v_mbcnt_lo_u32_b32 %0, -1, 0\n\tv_mbcnt_hi_u32_b32 %0, -1, %0" : "=v"(x)); return x; }
#define LDS_WAIT() asm volatile("s_waitcnt lgkmcnt(0)" ::: "memory")
#define VM_WAIT() asm volatile("s_waitcnt vmcnt(0)" ::: "memory")

namespace pg8 {
constexpr int BM = 256, BK = 64, HALF = 128, HTB = HALF * BK * 2, STAGE_BYTES = 8 * HTB, NXCD = 8, WGM = 8;
__host__ __device__ __forceinline__ int lds_byte(int r, int c) { const int st = (r >> 4) * 2 + (c >> 5), rr = r & 15, cc = c & 31, ob = rr * 64 + cc * 2; return st * 1024 + (ob ^ (((ob >> 9) & 1) << 5)); }
__host__ __device__ __forceinline__ void stage_rc(int b, int& R, int& C) { const int st = b / 1024, sb = b % 1024, swz = sb ^ (((sb >> 9) & 1) << 5); R = (st >> 1) * 16 + swz / 64; C = (st & 1) * 32 + (swz % 64) / 2; }
__host__ __device__ __forceinline__ int perm32(int rho) { const int n = rho >> 4, i = rho & 15; return 8 * (i >> 2) + 4 * n + (i & 3); }

struct Unit { const char* A; const char* B; int pm, pn, aux; };

__device__ __forceinline__ bool static_tile(long L, int nM, int nN, int& pm, int& pn) {
    const int nwg = nM * nN; if (L >= nwg) return false;
    int wgid = (int)L; { const int q = nwg / NXCD, r = nwg % NXCD, xcd = wgid % NXCD, off = wgid / NXCD; wgid = (xcd < r ? xcd * (q + 1) : r * (q + 1) + (xcd - r) * q) + off; }
    const int nig = WGM * nN, gid = wgid / nig, fm = gid * WGM, gsz = (nM - fm) < WGM ? (nM - fm) : WGM;
    pm = fm + ((wgid % nig) % gsz); pn = (wgid % nig) / gsz; return true;
}

template <class Epi, class Sched, bool GATHER = false>
__device__ __forceinline__ void gemm_phase(LAS unsigned char* lds, const int K, const Sched& S, const Epi& E, const int wid) {
    const int lane = opaque_i(lane_id()), tid = wid * 64 + lane, wr = wid >> 2, wc = wid & 3, fr = lane & 15, fq = lane >> 4;
    const int nt = K / BK;
    unsigned voffA[2], voffB[2]; int rowA[2]; unsigned colA2[2];
#pragma unroll
    for (int i = 0; i < 2; ++i) { int R, C; stage_rc(tid * 16 + i * 8192, R, C); const int Rb = (R & ~31) + perm32(R & 31);
        voffA[i] = (unsigned)(R * K + C) * 2u; voffB[i] = (unsigned)(Rb * K + C) * 2u; rowA[i] = R; colA2[i] = (unsigned)C * 2u; }
    unsigned gC[2][2]; int tN[2][2]; bool gnx = false;
    const size_t kstep = (size_t)(BK * 2);
    const size_t hstep = (size_t)HALF * K * 2;
    const unsigned ldsw = (unsigned)wid * 1024u;
    const int aoff = lds_byte(wr * 64 + fr, fq * 8), boff = lds_byte(wc * 32 + fr, fq * 8);
#define PG8_SA(b, h) (((b) * 2 + (h)) * HTB)
#define PG8_SB(b, h) ((4 + (b) * 2 + (h)) * HTB)
#define PG8_STAGE(bufoff, gbase, voff) do { _Pragma("unroll") for (int _i = 0; _i < 2; ++_i) \
        __builtin_amdgcn_global_load_lds((const unsigned*)((const char*)(gbase) + (voff)[_i]), (LAS unsigned*)(lds + (bufoff) + ldsw + _i * 8192), 16, 0, 0); } while (0)
#define PG8_GLOADRAW(dst, U) do { _Pragma("unroll") for (int _h = 0; _h < 2; ++_h) _Pragma("unroll") for (int _i = 0; _i < 2; ++_i) \
        dst[_h][_i] = S.tokrow[(U).pm * 256 + 128 * _h + rowA[_i]]; } while (0)
#define PG8_GOFF(T, I) ((unsigned)(T) * (unsigned)(K * 2) + colA2[I])
#define PG8_STAGE_A(bufoff, nx, h, kt) do { if constexpr (GATHER) { _Pragma("unroll") for (int _i = 0; _i < 2; ++_i) \
            __builtin_amdgcn_global_load_lds((const unsigned*)(S.gA + (((nx) && gnx) ? PG8_GOFF(tN[h][_i], _i) : gC[h][_i]) + (size_t)(kt) * kstep), (LAS unsigned*)(lds + (bufoff) + ldsw + _i * 8192), 16, 0, 0); } \
        else { PG8_STAGE(bufoff, ((nx) ? nA : cA) + (size_t)(h) * hstep + (size_t)(kt) * kstep, voffA); } } while (0)
#define PG8_LDA(dst, b, h) do { _Pragma("unroll") for (int m = 0; m < 4; ++m) _Pragma("unroll") for (int k = 0; k < 2; ++k) dst[m][k] = *(const LAS bf16x8*)(lds + PG8_SA(b, h) + aoff + m * 2048 + k * 1024); } while (0)
#define PG8_LDB(dst, b, h) do { _Pragma("unroll") for (int n = 0; n < 2; ++n) _Pragma("unroll") for (int k = 0; k < 2; ++k) dst[n][k] = *(const LAS bf16x8*)(lds + PG8_SB(b, h) + boff + n * 2048 + k * 1024); } while (0)
#define PG8_MMA(ai, bj, At, Bt) do { __builtin_amdgcn_s_setprio(1); _Pragma("unroll") for (int m = 0; m < 4; ++m) _Pragma("unroll") for (int n = 0; n < 2; ++n) _Pragma("unroll") for (int k = 0; k < 2; ++k) \
        acc[ai][bj][m][n] = __builtin_amdgcn_mfma_f32_16x16x32_bf16(Bt[n][k], At[m][k], acc[ai][bj][m][n], 0, 0, 0); __builtin_amdgcn_s_setprio(0); } while (0)
#define PG8_WAIT_V(n) asm volatile("s_waitcnt vmcnt(" #n ")" ::: "memory")
#define PG8_WAIT_L(n) asm volatile("s_waitcnt lgkmcnt(" #n ")" ::: "memory")
#define PG8_BAR __builtin_amdgcn_s_barrier()
#define PG8_SCHED __builtin_amdgcn_sched_barrier(0)
    Unit cur, nxt; int ui = 0;
    if (!S.next(0, cur)) return;
    f32x4 acc[2][2][4][2];
#pragma unroll
    for (int a = 0; a < 2; ++a)
#pragma unroll
        for (int b = 0; b < 2; ++b)
#pragma unroll
            for (int m = 0; m < 4; ++m)
#pragma unroll
                for (int n = 0; n < 2; ++n) acc[a][b][m][n] = (f32x4){0.f, 0.f, 0.f, 0.f};
    bf16x8 At[4][2], B0[2][2], B1[2][2];
    const char* cA = cur.A; const char* cB = cur.B; const char* nA = cA;
    if constexpr (GATHER) { PG8_GLOADRAW(tN, cur);
#pragma unroll
        for (int _h = 0; _h < 2; ++_h)
#pragma unroll
            for (int _i = 0; _i < 2; ++_i) gC[_h][_i] = PG8_GOFF(tN[_h][_i], _i); }
    PG8_STAGE(PG8_SB(0, 0), cB, voffB); PG8_STAGE(PG8_SB(0, 1), cB + hstep, voffB); PG8_STAGE_A(PG8_SA(0, 0), false, 0, 0); PG8_STAGE_A(PG8_SA(0, 1), false, 1, 0);
    if (wr == 1) PG8_BAR;
    PG8_WAIT_V(2); PG8_BAR;
    PG8_STAGE(PG8_SB(1, 0), cB + kstep, voffB); PG8_STAGE_A(PG8_SA(1, 0), false, 0, 1); PG8_STAGE(PG8_SB(1, 1), cB + hstep + kstep, voffB);
    PG8_WAIT_V(6); PG8_BAR;
    for (;;) {
        const bool has_next = S.next(ui + 1, nxt);
        nA = has_next ? nxt.A : cA; const char* nB = has_next ? nxt.B : cB;
        if constexpr (GATHER) { gnx = has_next; if (has_next) { PG8_GLOADRAW(tN, nxt); } }
#pragma unroll 1
        for (int t = 0; t < nt; t += 2) {
            const bool last = (t == nt - 2);
            const char* b2 = last ? nB : cB + (size_t)(t + 2) * kstep; const char* b3 = b2 + kstep;
            const int t2 = last ? 0 : t + 2;
            PG8_LDB(B0, 0, 0); PG8_LDB(B1, 0, 1); PG8_SCHED; PG8_LDA(At, 0, 0); PG8_STAGE_A(PG8_SA(1, 1), false, 1, t + 1);
            PG8_WAIT_V(8); PG8_WAIT_L(0); PG8_BAR; PG8_MMA(0, 0, At, B0); PG8_MMA(0, 1, At, B1); PG8_BAR; PG8_SCHED;
            PG8_LDA(At, 0, 1); PG8_STAGE(PG8_SB(0, 0), b2, voffB); PG8_STAGE(PG8_SB(0, 1), b2 + hstep, voffB); PG8_STAGE_A(PG8_SA(0, 0), last, 0, t2);
            PG8_WAIT_V(8); PG8_WAIT_L(0); PG8_BAR; PG8_MMA(1, 0, At, B0); PG8_MMA(1, 1, At, B1); PG8_BAR; PG8_SCHED;
            PG8_LDB(B0, 1, 0); PG8_LDB(B1, 1, 1); PG8_SCHED; PG8_LDA(At, 1, 0); PG8_STAGE_A(PG8_SA(0, 1), last, 1, t2);
            PG8_WAIT_V(8); PG8_WAIT_L(0); PG8_BAR; PG8_MMA(0, 0, At, B0); PG8_MMA(0, 1, At, B1); PG8_BAR; PG8_SCHED;
            PG8_LDA(At, 1, 1); PG8_STAGE(PG8_SB(1, 0), b3, voffB); PG8_STAGE(PG8_SB(1, 1), b3 + hstep, voffB); PG8_STAGE_A(PG8_SA(1, 0), last, 0, t2 + 1);
            PG8_WAIT_V(8); PG8_WAIT_L(0); PG8_BAR; PG8_MMA(1, 0, At, B0); PG8_MMA(1, 1, At, B1); PG8_BAR; PG8_SCHED;
        }
        if (wr == 0) PG8_BAR;
        const bool keep = E(acc, cur, wr, wc, fr, fq);
        if (!has_next) break;
        if (!keep) {
#pragma unroll
            for (int a = 0; a < 2; ++a)
#pragma unroll
                for (int b = 0; b < 2; ++b)
#pragma unroll
                    for (int m = 0; m < 4; ++m)
#pragma unroll
                        for (int n = 0; n < 2; ++n) acc[a][b][m][n] = (f32x4){0.f, 0.f, 0.f, 0.f};
        }
        cur = nxt; cA = nA; cB = nB; ++ui;
        if constexpr (GATHER) {
#pragma unroll
            for (int _h = 0; _h < 2; ++_h)
#pragma unroll
                for (int _i = 0; _i < 2; ++_i) gC[_h][_i] = PG8_GOFF(tN[_h][_i], _i); }
        if (wr == 1) PG8_BAR;
    }
    PG8_WAIT_V(0);
    PG8_BAR;
#undef PG8_SA
#undef PG8_SB
#undef PG8_STAGE
#undef PG8_STAGE_A
#undef PG8_GLOADRAW
#undef PG8_GOFF
#undef PG8_LDA
#undef PG8_LDB
#undef PG8_MMA
#undef PG8_WAIT_V
#undef PG8_WAIT_L
#undef PG8_BAR
#undef PG8_SCHED
}
}
#define XB2_XARR(j) (3600 + (j))
#define XB2_TOP     3620
#define XB2_LATE    3624

struct Params {
    const float* x; const float* g_norm1; const float* w_in; const float* g_cq; const float* w_uq; const float* w_qidx; const float* lb_logits; const float* g_hnorm;
    const float* w_pa; const float* w_pb; const float* w_o; const float* g_norm2; const float* w_grp; const float* b_grp; const float* w_exp; const float* b_exp;
    const float* w_gate; const float* w_up; const float* w_down; const float* g_final;
    float* out; unsigned char* ws;
};

struct SchedDense {
    const char* A; const char* Bt; int nM, nN, G, c; size_t tstep;
    __device__ __forceinline__ bool next(int i, pg8::Unit& u) const {
        int pm, pn; if (!pg8::static_tile((long)i * G + c, nM, nN, pm, pn)) return false;
        u.pm = pm; u.pn = pn; u.aux = 0; u.A = A + (size_t)pm * tstep; u.B = Bt + (size_t)pn * tstep; return true;
    }
};
struct SchedMerged {
    const char* A0; const char* A1; const char* B0; const char* B1; int nM, nN, G, c; size_t tstep;
    __device__ __forceinline__ bool next(int i, pg8::Unit& u) const {
        int pm, pn; if (!pg8::static_tile((long)(i >> 1) * G + c, nM, nN, pm, pn)) return false;
        const int part = i & 1; u.pm = pm; u.pn = pn; u.aux = part;
        u.A = (part ? A1 : A0) + (size_t)pm * tstep; u.B = (part ? B1 : B0) + (size_t)pn * tstep; return true;
    }
};
struct SchedMoe {
    const char* A; const char* Bt; const int* tile_e; int ntiles, NCT, G, c; size_t tstep;
    __device__ __forceinline__ bool next(int i, pg8::Unit& u) const {
        const long L = (long)i * G + c; if (L >= (long)ntiles * NCT) return false;
        const int rt = (int)(L / NCT), ct = (int)(L % NCT); const int e = __builtin_amdgcn_readfirstlane(tile_e[rt]);
        u.pm = rt; u.pn = ct; u.aux = e; u.A = A + (size_t)rt * tstep; u.B = Bt + ((size_t)e * NCT + ct) * tstep; return true;
    }
};

struct SchedMoeB {
    const char* A; const char* Bt; const LAS int* tile_e; int ntiles, G, c, H, msplit; size_t tstep;
    __device__ __forceinline__ bool next(int i, pg8::Unit& u) const {
        long L;
        if (c < H) { L = 8L * msplit + c + (long)i * H; if (L >= 8L * ntiles) return false; }
        else { L = (c - H) + (long)i * (G - H); if (L >= 8L * msplit) return false; }
        const int rt = (int)(L >> 3), ct = (int)(L & 7); const int e = __builtin_amdgcn_readfirstlane(tile_e[rt]);
        u.pm = rt; u.pn = ct; u.aux = e; u.A = A + (size_t)rt * tstep; u.B = Bt + ((size_t)e * 8 + ct) * tstep; return true;
    }
};

struct SchedMoeG {
    const char* gA; const int* tokrow; const char* Bt; const LAS int* tile_e; int ntiles, NCT, G, c; size_t tstep;
    __device__ __forceinline__ bool next(int i, pg8::Unit& u) const {
        const long L = (long)i * G + c; if (L >= (long)ntiles * NCT) return false;
        const int rt = (int)(L / NCT), ct = (int)(L % NCT); const int e = __builtin_amdgcn_readfirstlane(tile_e[rt]);
        u.pm = rt; u.pn = ct; u.aux = e; u.A = gA; u.B = Bt + ((size_t)e * NCT + ct) * tstep; return true;
    }
};

typedef f32x4 Acc[2][2][4][2];
#define EPI_ROWS_BEGIN _Pragma("unroll") for (int ai = 0; ai < 2; ++ai) _Pragma("unroll") for (int m = 0; m < 4; ++m) { const int r = row0 + ai * 128 + m * 16;
#define EPI_ROWS_END }

struct EpiIn {
    unsigned char* ws; const float* rstd1; const float* lb; const float* ctab; const float* stab;
    __device__ __forceinline__ bool operator()(Acc& acc, const pg8::Unit& u, int wr, int wc, int fr, int fq) const {
        const int row0 = u.pm * 256 + wr * 64 + fr; const int colp = wc * 32 + 8 * fq; const int T = u.pn;
        float rs8[2][4];
#pragma unroll
        for (int ai = 0; ai < 2; ++ai)
#pragma unroll
            for (int m = 0; m < 4; ++m) rs8[ai][m] = rstd1[row0 + ai * 128 + m * 16];
        if (T < 2) {
            bf16_t* cq = (bf16_t*)(ws + WS_CQ); float* part = (float*)(ws + WS_SSQCQ);
            EPI_ROWS_BEGIN { const float rs = rs8[ai][m]; float s = 0.f;
#pragma unroll
                for (int bj = 0; bj < 2; ++bj) { const f32x4 v0 = acc[ai][bj][m][0] * rs, v1 = acc[ai][bj][m][1] * rs;
                    s += (v0[0] * v0[0] + v0[1] * v0[1]) + (v0[2] * v0[2] + v0[3] * v0[3]) + (v1[0] * v1[0] + v1[1] * v1[1]) + (v1[2] * v1[2] + v1[3] * v1[3]);
                    u32x4 w; w.x = pk2(v0[0], v0[1]); w.y = pk2(v0[2], v0[3]); w.z = pk2(v1[0], v1[1]); w.w = pk2(v1[2], v1[3]);
                    *(u32x4*)(cq + (size_t)r * QR + T * 256 + bj * 128 + colp) = w; }
                s += shx(s, 16, fq * 16 + fr); s += shx(s, 32, fq * 16 + fr);
                if (fq == 0) part[(size_t)r * 8 + T * 4 + wc] = s; } EPI_ROWS_END
        } else if (T == 2) {
            bf16_t* dst = (bf16_t*)(ws + (wc >= 2 ? WS_KIR : WS_KR)); const int c = (colp & 63);
            u32x4 tb[2][2];
#define RP_LOAD(BUF, RG) { const unsigned to_ = (unsigned)(((row0 + ((RG) >> 2) * 128 + ((RG) & 3) * 16) & (SEQ - 1)) * 64 + c) * 2u; \
                tb[BUF][0] = *(const u32x4*)(ws + ((unsigned)WS_COSB + to_)); tb[BUF][1] = *(const u32x4*)(ws + ((unsigned)WS_SINB + to_)); }
            RP_LOAD(0, 0)
#pragma unroll
            for (int rg = 0; rg < 8; ++rg) { const int ai = rg >> 2, m = rg & 3; const int r = row0 + ai * 128 + m * 16; const float rs = rs8[ai][m];
                if (rg + 1 < 8) { if ((rg & 1) == 0) RP_LOAD(1, rg + 1) else RP_LOAD(0, rg + 1) }
                const u32x4 cw = tb[rg & 1][0], sw = tb[rg & 1][1];
                const f32x4 c0 = (f32x4){bf2f(cw.x & 0xffffu), bf2f(cw.x >> 16), bf2f(cw.y & 0xffffu), bf2f(cw.y >> 16)}, c1 = (f32x4){bf2f(cw.z & 0xffffu), bf2f(cw.z >> 16), bf2f(cw.w & 0xffffu), bf2f(cw.w >> 16)};
                const f32x4 s0 = (f32x4){bf2f(sw.x & 0xffffu), bf2f(sw.x >> 16), bf2f(sw.y & 0xffffu), bf2f(sw.y >> 16)}, s1 = (f32x4){bf2f(sw.z & 0xffffu), bf2f(sw.z >> 16), bf2f(sw.w & 0xffffu), bf2f(sw.w >> 16)};
                const f32x4 a0 = acc[ai][0][m][0] * rs, a1 = acc[ai][0][m][1] * rs, b0 = acc[ai][1][m][0] * rs, b1 = acc[ai][1][m][1] * rs;
                const f32x4 o0 = a0 * c0 - b0 * s0, o1 = a1 * c1 - b1 * s1, p0 = b0 * c0 + a0 * s0, p1 = b1 * c1 + a1 * s1;
                u32x4 w; w.x = pk2(o0[0], o0[1]); w.y = pk2(o0[2], o0[3]); w.z = pk2(o1[0], o1[1]); w.w = pk2(o1[2], o1[3]);
                *(u32x4*)(dst + (size_t)r * 128 + c) = w;
                w.x = pk2(p0[0], p0[1]); w.y = pk2(p0[2], p0[3]); w.z = pk2(p1[0], p1[1]); w.w = pk2(p1[2], p1[3]);
                *(u32x4*)(dst + (size_t)r * 128 + 64 + c) = w; }
#undef RP_LOAD
        } else if (T == 3) {
            bf16_t* vv = (bf16_t*)(ws + WS_VV); float* wi = (float*)(ws + WS_WI);
            EPI_ROWS_BEGIN { const float rs = rs8[ai][m];
                const f32x4 v0 = acc[ai][0][m][0] * rs, v1 = acc[ai][0][m][1] * rs;
                u32x4 w; w.x = pk2(v0[0], v0[1]); w.y = pk2(v0[2], v0[3]); w.z = pk2(v1[0], v1[1]); w.w = pk2(v1[2], v1[3]);
                *(u32x4*)(vv + (size_t)r * 128 + colp) = w;
                if (colp < 16) { const float sc = rs * 0.02209708691207961f;
                    *(f32x4*)(wi + (size_t)r * 16 + colp) = acc[ai][1][m][0] * sc; *(f32x4*)(wi + (size_t)r * 16 + colp + 4) = acc[ai][1][m][1] * sc; } } EPI_ROWS_END
        } else if (T < 20) {
            const int seg = (T - 4) >> 2; const int cbase = ((T - 4) & 3) * 256 + colp;
            if (seg == 1) {
                float* logf = (float*)(ws + WS_LOGF);
                f32x4 lbv[2][2];
#pragma unroll
                for (int bj = 0; bj < 2; ++bj) { lbv[bj][0] = *(const f32x4*)(lb + cbase + bj * 128); lbv[bj][1] = *(const f32x4*)(lb + cbase + bj * 128 + 4); }
                EPI_ROWS_BEGIN { const float rs = rs8[ai][m];
#pragma unroll
                    for (int bj = 0; bj < 2; ++bj) { const int cc = cbase + bj * 128;
                        const f32x4 l0 = lbv[bj][0], l1 = lbv[bj][1];
                        f32x4 v0 = acc[ai][bj][m][0] * rs, v1 = acc[ai][bj][m][1] * rs;
#pragma unroll
                        for (int e = 0; e < 4; ++e) { v0[e] = __logf(l0[e] + (1.0f - l0[e]) * sigmoidf_(v0[e])); v1[e] = __logf(l1[e] + (1.0f - l1[e]) * sigmoidf_(v1[e])); }
                        *(f32x4*)(logf + (size_t)r * 1024 + cc) = v0; *(f32x4*)(logf + (size_t)r * 1024 + cc + 4) = v1; } } EPI_ROWS_END
            } else {
                bf16_t* dst = (bf16_t*)(ws + (seg == 0 ? WS_QT : (seg == 2 ? WS_VH : WS_SG)));
                EPI_ROWS_BEGIN { const float rs = rs8[ai][m];
#pragma unroll
                    for (int bj = 0; bj < 2; ++bj) { f32x4 v0 = acc[ai][bj][m][0] * rs, v1 = acc[ai][bj][m][1] * rs;
                        if (seg != 2) {
#pragma unroll
                            for (int e = 0; e < 4; ++e) { v0[e] = siluf_(v0[e]); v1[e] = siluf_(v1[e]); } }
                        u32x4 w; w.x = pk2(v0[0], v0[1]); w.y = pk2(v0[2], v0[3]); w.z = pk2(v1[0], v1[1]); w.w = pk2(v1[2], v1[3]);
                        *(u32x4*)(dst + (size_t)r * 1024 + cbase + bj * 128) = w; } } EPI_ROWS_END
            }
        } else {
            bf16_t* Rg = (bf16_t*)(ws + WS_RG); bf16_t* Sb = (bf16_t*)(ws + WS_SB); const int cc = (T - 20) * 128 + colp;
            EPI_ROWS_BEGIN { const float rs = rs8[ai][m];
                f32x4 a0 = acc[ai][0][m][0] * rs, a1 = acc[ai][0][m][1] * rs, b0 = acc[ai][1][m][0] * rs, b1 = acc[ai][1][m][1] * rs;
#pragma unroll
                for (int e = 0; e < 4; ++e) { const float ea0 = __expf(-a0[e]), eb0 = __expf(-b0[e]), ea1 = __expf(-a1[e]), eb1 = __expf(-b1[e]);
                    a0[e] = (1.0f + eb0) * __builtin_amdgcn_rcpf(1.0f + ea0); b0[e] = __builtin_amdgcn_rcpf(1.0f + eb0);
                    a1[e] = (1.0f + eb1) * __builtin_amdgcn_rcpf(1.0f + ea1); b1[e] = __builtin_amdgcn_rcpf(1.0f + eb1); }
                u32x4 w; w.x = pk2(a0[0], a0[1]); w.y = pk2(a0[2], a0[3]); w.z = pk2(a1[0], a1[1]); w.w = pk2(a1[2], a1[3]);
                *(u32x4*)(Rg + (size_t)r * DM + cc) = w;
                w.x = pk2(b0[0], b0[1]); w.y = pk2(b0[2], b0[3]); w.z = pk2(b1[0], b1[1]); w.w = pk2(b1[2], b1[3]);
                *(u32x4*)(Sb + (size_t)r * DM + cc) = w; } EPI_ROWS_END
        }
        return false;
    }
};

struct EpiQ {
    unsigned char* ws;
    __device__ __forceinline__ bool operator()(Acc& acc, const pg8::Unit& u, int wr, int wc, int fr, int fq) const {
        const int row0 = u.pm * 256 + wr * 64 + fr; const int colp = wc * 32 + 8 * fq; const int T = u.pn;
        const int head = 2 * T + (colp >> 6), c = colp & 63;
        unsigned dbase, pitchb; float osc;
        if (head < 8) { dbase = (unsigned)WS_Q + (unsigned)(head * 128 + c) * 2u; pitchb = 2048u; osc = 0.08838834764831845f; } else { dbase = (unsigned)WS_QI + (unsigned)((head - 8) * 128 + c) * 2u; pitchb = 4096u; osc = 1.0f; }
#pragma unroll
        for (int ai = 0; ai < 2; ++ai) {
            f32x4 pa[4], pb[4]; u32x4 cw[4], sw[4];
#pragma unroll
            for (int m = 0; m < 4; ++m) { const unsigned o = (unsigned)WS_SSQCQ + (unsigned)(row0 + ai * 128 + m * 16) * 32u; pa[m] = *(const f32x4*)(ws + o); pb[m] = *(const f32x4*)(ws + o + 16u); }
#pragma unroll
            for (int m = 0; m < 4; ++m) { const unsigned to = (unsigned)(((row0 + ai * 128 + m * 16) & (SEQ - 1)) * 64 + c) * 2u;
                cw[m] = *(const u32x4*)(ws + ((unsigned)WS_COSB + to)); sw[m] = *(const u32x4*)(ws + ((unsigned)WS_SINB + to)); }
#pragma unroll
            for (int m = 0; m < 4; ++m) { const unsigned r = (unsigned)(row0 + ai * 128 + m * 16);
                const float ssq = ((pa[m][0] + pa[m][1]) + (pa[m][2] + pa[m][3])) + ((pb[m][0] + pb[m][1]) + (pb[m][2] + pb[m][3]));
                const float rs = __builtin_amdgcn_rsqf(ssq * (1.0f / QR) + EPS) * osc;
                const f32x4 c0 = (f32x4){bf2f(cw[m].x & 0xffffu), bf2f(cw[m].x >> 16), bf2f(cw[m].y & 0xffffu), bf2f(cw[m].y >> 16)}, c1 = (f32x4){bf2f(cw[m].z & 0xffffu), bf2f(cw[m].z >> 16), bf2f(cw[m].w & 0xffffu), bf2f(cw[m].w >> 16)};
                const f32x4 s0 = (f32x4){bf2f(sw[m].x & 0xffffu), bf2f(sw[m].x >> 16), bf2f(sw[m].y & 0xffffu), bf2f(sw[m].y >> 16)}, s1 = (f32x4){bf2f(sw[m].z & 0xffffu), bf2f(sw[m].z >> 16), bf2f(sw[m].w & 0xffffu), bf2f(sw[m].w >> 16)};
                const f32x4 a0 = acc[ai][0][m][0] * rs, a1 = acc[ai][0][m][1] * rs, b0 = acc[ai][1][m][0] * rs, b1 = acc[ai][1][m][1] * rs;
                const f32x4 o0 = a0 * c0 - b0 * s0, o1 = a1 * c1 - b1 * s1, p0 = b0 * c0 + a0 * s0, p1 = b1 * c1 + a1 * s1;
                u32x4 w; w.x = pk2(o0[0], o0[1]); w.y = pk2(o0[2], o0[3]); w.z = pk2(o1[0], o1[1]); w.w = pk2(o1[2], o1[3]);
                *(u32x4*)(ws + (dbase + r * pitchb)) = w;
                w.x = pk2(p0[0], p0[1]); w.y = pk2(p0[2], p0[3]); w.z = pk2(p1[0], p1[1]); w.w = pk2(p1[2], p1[3]);
                *(u32x4*)(ws + (dbase + r * pitchb + 128u)) = w; }
        }
        return false;
    }
};

struct EpiMerged {
    unsigned char* ws;
    __device__ __forceinline__ bool operator()(Acc& acc, const pg8::Unit& u, int wr, int wc, int fr, int fq) const {
        const int row0 = u.pm * 256 + wr * 64 + fr; const int colp = wc * 32 + 8 * fq;
        const bf16_t* G = (const bf16_t*)(ws + (u.aux == 0 ? WS_RG : WS_SB)); bf16_t* mg = (bf16_t*)(ws + WS_MERGED);
        u32x4 gw[3][2];
#define MG_LOAD(BUF, RG) { _Pragma("unroll") for (int bj = 0; bj < 2; ++bj) gw[BUF][bj] = *(const u32x4*)(G + (size_t)(row0 + ((RG) >> 2) * 128 + ((RG) & 3) * 16) * DM + u.pn * 256 + bj * 128 + colp); }
        MG_LOAD(0, 0) MG_LOAD(1, 1)
#pragma unroll
        for (int rg = 0; rg < 8; ++rg) { const int ai = rg >> 2, m = rg & 3;
            if (rg + 2 < 8) { if ((rg + 2) % 3 == 0) MG_LOAD(0, rg + 2) else if ((rg + 2) % 3 == 1) MG_LOAD(1, rg + 2) else MG_LOAD(2, rg + 2) }
#pragma unroll
            for (int bj = 0; bj < 2; ++bj) { const u32x4 w = gw[rg % 3][bj];
                const f32x4 g0 = (f32x4){bf2f(w.x & 0xffffu), bf2f(w.x >> 16), bf2f(w.y & 0xffffu), bf2f(w.y >> 16)}, g1 = (f32x4){bf2f(w.z & 0xffffu), bf2f(w.z >> 16), bf2f(w.w & 0xffffu), bf2f(w.w >> 16)};
                if (u.aux == 0) { acc[ai][bj][m][0] *= g0; acc[ai][bj][m][1] *= g1; }
                else { const f32x4 v0 = acc[ai][bj][m][0] * g0, v1 = acc[ai][bj][m][1] * g1;
                    u32x4 q; q.x = pk2(v0[0], v0[1]); q.y = pk2(v0[2], v0[3]); q.z = pk2(v1[0], v1[1]); q.w = pk2(v1[2], v1[3]);
                    *(u32x4*)(mg + (size_t)(row0 + ai * 128 + m * 16) * DM + u.pn * 256 + bj * 128 + colp) = q; } }
        }
#undef MG_LOAD
        return u.aux == 0;
    }
};

struct EpiX1 {
    unsigned char* ws; const float* x; float* x1;
    __device__ __forceinline__ bool operator()(Acc& acc, const pg8::Unit& u, int wr, int wc, int fr, int fq) const {
        const int row0 = u.pm * 256 + wr * 64 + fr; const int colp = wc * 32 + 8 * fq;
        bf16_t* x1b = (bf16_t*)(ws + WS_X1B); float* part = (float*)(ws + WS_SSQ2);
        f32x4 xv[2][2][2][2];
#define X1_LOAD(BUF, AI, MP) { _Pragma("unroll") for (int mm = 0; mm < 2; ++mm) _Pragma("unroll") for (int bj = 0; bj < 2; ++bj) { \
            const size_t o_ = (size_t)(row0 + (AI) * 128 + (2 * (MP) + mm) * 16) * DM + u.pn * 256 + bj * 128 + colp; xv[BUF][mm][bj][0] = *(const f32x4*)(x + o_); xv[BUF][mm][bj][1] = *(const f32x4*)(x + o_ + 4); } }
        X1_LOAD(0, 0, 0)
#pragma unroll
        for (int k = 0; k < 4; ++k) { const int ai = k >> 1, mp = k & 1;
            if (k + 1 < 4) { if ((k & 1) == 0) X1_LOAD(1, (k + 1) >> 1, (k + 1) & 1) else X1_LOAD(0, (k + 1) >> 1, (k + 1) & 1) }
#pragma unroll
            for (int mm = 0; mm < 2; ++mm) { const int m = 2 * mp + mm; const int r = row0 + ai * 128 + m * 16; float s = 0.f;
#pragma unroll
                for (int bj = 0; bj < 2; ++bj) { const size_t o = (size_t)r * DM + u.pn * 256 + bj * 128 + colp;
                    const f32x4 v0 = acc[ai][bj][m][0] + xv[k & 1][mm][bj][0], v1 = acc[ai][bj][m][1] + xv[k & 1][mm][bj][1];
                    s += (v0[0] * v0[0] + v0[1] * v0[1]) + (v0[2] * v0[2] + v0[3] * v0[3]) + (v1[0] * v1[0] + v1[1] * v1[1]) + (v1[2] * v1[2] + v1[3] * v1[3]);
                    u32x4 w; w.x = pk2(v0[0], v0[1]); w.y = pk2(v0[2], v0[3]); w.z = pk2(v1[0], v1[1]); w.w = pk2(v1[2], v1[3]);
                    *(u32x4*)(x1b + o) = w; }
                s += shx(s, 16, fq * 16 + fr); s += shx(s, 32, fq * 16 + fr);
                if (fq == 0) part[(size_t)r * 32 + u.pn * 4 + wc] = s; }
        }
#undef X1_LOAD
        return false;
    }
};

struct EpiGateUp {
    unsigned char* ws; unsigned* bar; int G, c, full; unsigned xcd, nloc;
    __device__ __forceinline__ bool operator()(Acc& acc, const pg8::Unit& u, int wr, int wc, int fr, int fq) const {
        const int row0 = u.pm * 256 + wr * 64 + fr; const int colp = wc * 32 + 8 * fq;
        const float* rss = (const float*)(ws + WS_RSS); bf16_t* act = (bf16_t*)(ws + WS_ACT);
        float rs8[2][4];
#pragma unroll
        for (int ai = 0; ai < 2; ++ai)
#pragma unroll
            for (int m = 0; m < 4; ++m) rs8[ai][m] = rss[row0 + ai * 128 + m * 16];
        EPI_ROWS_BEGIN { const float rs = rs8[ai][m];
            f32x4 a0 = acc[ai][0][m][0] * rs, a1 = acc[ai][0][m][1] * rs; const f32x4 u0 = acc[ai][1][m][0] * rs, u1 = acc[ai][1][m][1] * rs;
#pragma unroll
            for (int e = 0; e < 4; ++e) { a0[e] = siluf_(a0[e]) * u0[e]; a1[e] = siluf_(a1[e]) * u1[e]; }
            u32x4 w; w.x = pk2(a0[0], a0[1]); w.y = pk2(a0[2], a0[3]); w.z = pk2(a1[0], a1[1]); w.w = pk2(a1[2], a1[3]);
            *(u32x4*)(act + (size_t)r * DEXP + u.pn * 128 + colp) = w; } EPI_ROWS_END
        { const int rnd = (u.pm * 4 + u.pn - c) / G;
          if (rnd >= full - 1) {
            asm volatile("s_waitcnt vmcnt(0)" ::: "memory"); __syncthreads();
            if ((wr | wc | fr | fq) == 0) {
                if (rnd == full - 1) { const unsigned old = __hip_atomic_fetch_add(bar + XB2_XARR(xcd), 1u, __ATOMIC_RELAXED, __HIP_MEMORY_SCOPE_AGENT);
                    if (old + 1u == nloc) { __builtin_amdgcn_fence(__ATOMIC_RELEASE, "agent"); asm volatile("s_waitcnt vmcnt(0)" ::: "memory");
                        (void)__hip_atomic_fetch_add(bar + XB2_TOP, 1u, __ATOMIC_RELAXED, __HIP_MEMORY_SCOPE_AGENT); } }
                else { __builtin_amdgcn_fence(__ATOMIC_RELEASE, "agent"); asm volatile("s_waitcnt vmcnt(0)" ::: "memory");
                    (void)__hip_atomic_fetch_add(bar + XB2_LATE, 1u, __ATOMIC_RELAXED, __HIP_MEMORY_SCOPE_AGENT); } } } }
        return false;
    }
};

struct EpiDown {
    unsigned char* ws;
    __device__ __forceinline__ bool operator()(Acc& acc, const pg8::Unit& u, int wr, int wc, int fr, int fq) const {
        const int row0 = u.pm * 256 + wr * 64 + fr; const int colp = wc * 32 + 8 * fq;
        const float* gs = (const float*)(ws + WS_GS); bf16_t* ys = (bf16_t*)(ws + WS_YS);
        float g8[2][4];
#pragma unroll
        for (int ai = 0; ai < 2; ++ai)
#pragma unroll
            for (int m = 0; m < 4; ++m) g8[ai][m] = gs[row0 + ai * 128 + m * 16];
        EPI_ROWS_BEGIN { const float g = g8[ai][m];
#pragma unroll
            for (int bj = 0; bj < 2; ++bj) { const f32x4 v0 = acc[ai][bj][m][0] * g, v1 = acc[ai][bj][m][1] * g;
                u32x4 w; w.x = pk2(v0[0], v0[1]); w.y = pk2(v0[2], v0[3]); w.z = pk2(v1[0], v1[1]); w.w = pk2(v1[2], v1[3]);
                *(u32x4*)(ys + (size_t)r * DM + u.pn * 256 + bj * 128 + colp) = w; } } EPI_ROWS_END
        return false;
    }
};

struct EpiNull {
    __device__ __forceinline__ bool operator()(Acc& acc, const pg8::Unit& u, int wr, int wc, int fr, int fq) const {
#pragma unroll
        for (int ai = 0; ai < 2; ++ai)
#pragma unroll
            for (int bj = 0; bj < 2; ++bj)
#pragma unroll
                for (int m = 0; m < 4; ++m)
#pragma unroll
                    for (int n = 0; n < 2; ++n) asm volatile("" :: "v"(acc[ai][bj][m][n]));
        return false;
    }
};

template <int MODE> struct EpiProbeStore {
    unsigned char* ws;
    __device__ __forceinline__ bool operator()(Acc& acc, const pg8::Unit& u, int wr, int wc, int fr, int fq) const {
        const int row0 = u.pm * 256 + wr * 64 + fr; const int colp = wc * 32 + 8 * fq; unsigned char* base = ws + WS_KV;
#pragma unroll
        for (int ai = 0; ai < 2; ++ai)
#pragma unroll
            for (int m = 0; m < 4; ++m)
#pragma unroll
                for (int bj = 0; bj < 2; ++bj) { const int r = row0 + ai * 128 + m * 16;
                    u32x4 w; w.x = pk2(acc[ai][bj][m][0][0], acc[ai][bj][m][0][1]); w.y = pk2(acc[ai][bj][m][0][2], acc[ai][bj][m][0][3]); w.z = pk2(acc[ai][bj][m][1][0], acc[ai][bj][m][1][1]); w.w = pk2(acc[ai][bj][m][1][2], acc[ai][bj][m][1][3]);
                    size_t off;
                    if (MODE == 0) off = ((size_t)r * 2048 + (u.pn & 7) * 256 + bj * 128 + colp) * 2;
                    else off = ((((size_t)(u.pm * 8 + (u.pn & 7)) * 8 + (wr * 4 + wc)) * 16 + (ai * 8 + m * 2 + bj)) * 1024 + (size_t)(fq * 16 + fr) * 16) & (size_t)(64 * 1024 * 1024 - 1);
                    *(u32x4*)(base + off) = w; }
        return false;
    }
};

struct Frame { LAS unsigned char* lds; int tid, lane, wave, G, gw, NGW; };
__device__ __forceinline__ Frame make_frame(LAS unsigned char* lds, int wave) { Frame F; F.lds = lds; F.lane = opaque_i(lane_id()); F.wave = wave; F.tid = wave * 64 + F.lane; F.G = gridDim.x; F.gw = blockIdx.x * 8 + F.wave; F.NGW = F.G * 8; return F; }
constexpr int LDS_PHASE_BYTES = 163840;
constexpr int LDS_BYTES = LDS_PHASE_BYTES;

#define XB_TMO      128
#define XB_XCNT(j)  (256  + 64 * (j))
#define XB_XSUB(j)  (1280 + 64 * (j))
#define XB_XGEN(j)  (2304 + 64 * (j))
#define XB_TOP      3328
#define XB_TOPGEN   3392
#define XCD_BAR_WORDS 3456
#define XB_DEP      3584
#define XB_SPIN_CAP (1u << 22)
__device__ __forceinline__ unsigned xb_ld(unsigned* p)              { return __hip_atomic_load(p, __ATOMIC_RELAXED, __HIP_MEMORY_SCOPE_AGENT); }
__device__ __forceinline__ unsigned xb_add(unsigned* p, unsigned v) { return __hip_atomic_fetch_add(p, v, __ATOMIC_RELAXED, __HIP_MEMORY_SCOPE_AGENT); }
__device__ __forceinline__ unsigned xb_xcc_id() { return (unsigned)__builtin_amdgcn_s_getreg((3 << 11) | 20) & 0xFu; }
#define XB_SPIN(cond, bar) do { unsigned _sp = 0; while (cond) { __builtin_amdgcn_s_sleep(1); \
    if ((++_sp & 255u) == 0u) { if (xb_ld(&(bar)[XB_TMO])) break; if (_sp > XB_SPIN_CAP) { atomicAdd(&(bar)[XB_TMO], 1u); break; } } } } while (0)
struct XcdBarrier { unsigned* bar; unsigned x; volatile unsigned* st; int wave; };
__device__ __forceinline__ XcdBarrier xcd_barrier_post(unsigned* bar, volatile unsigned* st, int wave) {
    XcdBarrier b; b.bar = bar; b.x = xb_xcc_id(); b.st = st; b.wave = wave;
    if (wave == 0 && lane_id() == 0) (void)xb_add(&bar[XB_XCNT(b.x)], 1u);
    return b;
}
__device__ __forceinline__ void xcd_barrier_complete(unsigned* bar, unsigned x, unsigned& nloc, unsigned& nx) {
    const unsigned G = gridDim.x * gridDim.y * gridDim.z;
    unsigned sum, cnt, mine, sp = 0u;
    for (;;) {
        sum = 0u; cnt = 0u; mine = 0u;
#pragma unroll
        for (unsigned j = 0; j < 16; ++j) { const unsigned c = xb_ld(&bar[XB_XCNT(j)]); sum += c; cnt += (c > 0u) ? 1u : 0u; mine = (j == x) ? c : mine; }
        if (sum == G) break;
        __builtin_amdgcn_s_sleep(1);
        if ((++sp & 255u) == 0u) { if (xb_ld(&bar[XB_TMO])) break; if (sp > XB_SPIN_CAP) { atomicAdd(&bar[XB_TMO], 1u); break; } }
    }
    nloc = mine > 0u ? mine : 1u; nx = cnt > 0u ? cnt : 1u;
}
__device__ __forceinline__ void xcd_barrier(const XcdBarrier& b) {
    asm volatile("s_waitcnt vmcnt(0)" ::: "memory");
    __syncthreads();
    if (b.wave == 0 && lane_id() == 0) {
        unsigned* bar = b.bar;
        __builtin_amdgcn_s_waitcnt(0);
        unsigned nloc = b.st[0], nx = b.st[1];
        if (nloc == 0u) { xcd_barrier_complete(bar, b.x, nloc, nx); b.st[0] = nloc; b.st[1] = nx; }
        const unsigned old = xb_add(&bar[XB_XSUB(b.x)], 1u);
        const unsigned gen = old / nloc;
        if (old + 1u == (gen + 1u) * nloc) {
            __builtin_amdgcn_fence(__ATOMIC_RELEASE, "agent");
            asm volatile("s_waitcnt vmcnt(0)" ::: "memory");
            const unsigned og = xb_add(&bar[XB_TOP], 1u);
            const unsigned tg = og / nx;
            if (og + 1u == (tg + 1u) * nx) xb_add(&bar[XB_TOPGEN], 1u);
            else XB_SPIN(xb_ld(&bar[XB_TOPGEN]) == tg, bar);
            __builtin_amdgcn_fence(__ATOMIC_ACQUIRE, "agent");
            xb_add(&bar[XB_XGEN(b.x)], 1u);
            asm volatile("s_waitcnt vmcnt(0)" ::: "memory");
        } else {
            XB_SPIN(xb_ld(&bar[XB_XGEN(b.x)]) == gen, bar);
            __builtin_amdgcn_fence(__ATOMIC_ACQUIRE, "agent");
            asm volatile("s_waitcnt vmcnt(0)" ::: "memory");
        }
    }
    __syncthreads();
}

typedef short s16x4 __attribute__((ext_vector_type(4)));
struct TrDesc { const float* src; int ld, c0, nvalid; const float* gain; bf16_t* dst; int Kd, r0, k0; };
__device__ __forceinline__ void tr_load(const TrDesc& d, f32x4 (&v)[16], float (&gv)[16], int lane) {
    const int lg = lane >> 4, li = lane & 15; const bool ok = (4 * li) < d.nvalid;
#pragma unroll
    for (int i = 0; i < 16; ++i) { const int k = 4 * i + lg; v[i] = ok ? *(const f32x4*)(d.src + (size_t)(d.k0 + k) * d.ld + d.c0 + 4 * li) : (f32x4){0.f, 0.f, 0.f, 0.f}; }
    if (d.gain) {
#pragma unroll
        for (int i = 0; i < 16; ++i) gv[i] = d.gain[d.k0 + 4 * i + lg]; }
}
__device__ __forceinline__ void tr_to_lds(const TrDesc& d, f32x4 (&v)[16], const float (&gv)[16], LAS unsigned char* scr, int lane) {
    const int lg = lane >> 4, li = lane & 15;
    if (d.gain) {
#pragma unroll
        for (int i = 0; i < 16; ++i) v[i] *= gv[i]; }
#pragma unroll
    for (int i = 0; i < 16; ++i) { const int k = 4 * i + lg; u32x2 w; w.x = pk2(v[i][0], v[i][1]); w.y = pk2(v[i][2], v[i][3]);
        *(LAS u32x2*)(scr + k * 128 + ((((li >> 2) ^ (k & 3) ^ ((k >> 3) & 1)) << 5) | ((li & 3) * 8))) = w; }
}
__device__ __forceinline__ void tr_from_lds(const TrDesc& d, LAS unsigned char* scr, int lane) {
    const int lg = lane >> 4, li = lane & 15;
    LDS_WAIT(); asm volatile("" ::: "memory");
    const int q = li >> 2, p = li & 3;
#pragma unroll
    for (int nb = 0; nb < 4; ++nb)
#pragma unroll
        for (int ch = 0; ch < 2; ++ch) { const int c = 4 * ch + lg; const int ka = 8 * c + q, kb = ka + 4;
            const s16x4 lo = __builtin_amdgcn_ds_read_tr16_b64_v4i16((LAS s16x4*)(scr + ka * 128 + ((nb ^ (ka & 3) ^ ((ka >> 3) & 1)) << 5) + 8 * p));
            const s16x4 hi = __builtin_amdgcn_ds_read_tr16_b64_v4i16((LAS s16x4*)(scr + kb * 128 + ((nb ^ (kb & 3) ^ ((kb >> 3) & 1)) << 5) + 8 * p));
            const u32x2 l2 = __builtin_bit_cast(u32x2, lo), h2 = __builtin_bit_cast(u32x2, hi); u32x4 o; o.x = l2.x; o.y = l2.y; o.z = h2.x; o.w = h2.y;
            *(u32x4*)(d.dst + (size_t)(d.r0 + 16 * nb + li) * d.Kd + d.k0 + 8 * c) = o; }
    LDS_WAIT(); asm volatile("" ::: "memory");
}
template <class DescFn>
__device__ __forceinline__ void tr_loop(int first, int hi, int stride, LAS unsigned char* scr, int lane, const DescFn& D) {
    if (first >= hi) return;
    f32x4 v[16]; float gv[16];
    TrDesc cur = D(first); tr_load(cur, v, gv, lane);
#pragma unroll 1
    for (int it = first;;) {
        tr_to_lds(cur, v, gv, scr, lane);
        const int nx = it + stride; const bool has = nx < hi; TrDesc nd = cur;
        if (has) { nd = D(nx); tr_load(nd, v, gv, lane); }
        tr_from_lds(cur, scr, lane);
        if (!has) break;
        cur = nd; it = nx;
    }
}
__device__ __forceinline__ void map_in(int G64, int& src0, int& nv) {
    nv = 64;
    if (G64 < 8) { src0 = 64 * G64; }
    else if (G64 < 12) { src0 = (G64 == 8) ? 512 : (G64 == 9) ? 768 : (G64 == 10) ? 576 : 832; }
    else if (G64 < 14) { src0 = 640 + 64 * (G64 - 12); }
    else if (G64 == 14) { src0 = 896; nv = 16; }
    else if (G64 == 15) { src0 = 0; nv = 0; }
    else if (G64 < 80) { src0 = 912 + 64 * (G64 - 16); }
    else { const int q = 64 * (G64 - 80); const int j = q >> 8, bj = (q >> 7) & 1, pos0 = q & 127; src0 = (bj ? 7056 : 5008) + 128 * j + pos0; }
}
__device__ __forceinline__ void sincos_d(float angf, float& c, float& s) {
    const double x = (double)angf; const double n = rint(x * 0.63661977236758134308);
    double r = fma(-n, 1.57079632679489655800e+00, x); r = fma(-n, 6.12323399573676603587e-17, r);
    const double r2 = r * r;
    double sp = 1.0 / 6227020800.0; sp = fma(sp, r2, -1.0 / 39916800.0); sp = fma(sp, r2, 1.0 / 362880.0); sp = fma(sp, r2, -1.0 / 5040.0); sp = fma(sp, r2, 1.0 / 120.0); sp = fma(sp, r2, -1.0 / 6.0);
    const double sn = fma(r * r2, sp, r);
    double cp = -1.0 / 87178291200.0; cp = fma(cp, r2, 1.0 / 479001600.0); cp = fma(cp, r2, -1.0 / 3628800.0); cp = fma(cp, r2, 1.0 / 40320.0); cp = fma(cp, r2, -1.0 / 720.0); cp = fma(cp, r2, 1.0 / 24.0); cp = fma(cp, r2, -0.5);
    const double cs = fma(r2, cp, 1.0);
    const int q = ((int)n) & 3;
    const double cc = (q == 0) ? cs : (q == 1) ? -sn : (q == 2) ? -cs : sn;
    const double ss = (q == 0) ? sn : (q == 1) ? cs : (q == 2) ? -sn : -cs;
    c = (float)cc; s = (float)ss;
}
__device__ __forceinline__ void p0_prep(const Frame& F, const Params& P) {
    unsigned char* ws = P.ws;
    LAS unsigned char* scr = F.lds + F.wave * 16384;
    const int gtid = blockIdx.x * 512 + F.tid, GT = F.G * 512;
    if (gtid < 1024) ((int*)(ws + WS_CTL))[gtid] = 0;
    if (gtid < 1024) ((float*)(ws + WS_LB))[gtid] = 1.0f / (1.0f + expf(P.lb_logits[1024 + gtid] - P.lb_logits[gtid]));
    for (int i = gtid; i < SEQ * 64; i += GT) { const int pos = i >> 6, j = i & 63;
        const float inv = (float)(1.0 / pow(10000.0, (double)(2 * j) / 128.0)); const float ang = (float)pos * inv; float c, s; sincos_d(ang, c, s);
        ((float*)(ws + WS_COS))[i] = c; ((float*)(ws + WS_SIN))[i] = s; ((bf16_t*)(ws + WS_COSB))[i] = (bf16_t)f2bf(c); ((bf16_t*)(ws + WS_SINB))[i] = (bf16_t)f2bf(s); }
    for (int i = gtid; i < 48 * DM; i += GT) { const int j = i / DM, k = i % DM;
        const float v = (j < 4) ? P.w_grp[k * 4 + j] : (j < 36) ? P.w_exp[k * 32 + (j - 4)] : 0.f;
        ((bf16_t*)(ws + WS_WRT))[i] = (bf16_t)f2bf(v * P.g_norm2[k]); }
    constexpr int I_IN = 32 * 144;
    tr_loop(F.gw, I_IN, F.NGW, scr, F.lane, [&](int it) { const int kb = it / 144, nb = it % 144; int src0, nv; map_in(nb, src0, nv);
        TrDesc d; d.src = P.w_in; d.ld = DIN; d.c0 = src0; d.nvalid = nv; d.gain = P.g_norm1; d.dst = (bf16_t*)(ws + WS_WTIN); d.Kd = DM; d.r0 = 64 * nb; d.k0 = 64 * kb; return d; });
    for (int m = F.gw; m < NTOK; m += F.NGW) {
        const f32x4* xr = (const f32x4*)(P.x + (size_t)m * DM) + F.lane; f32x4 v[8]; float s = 0.f;
#pragma unroll
        for (int j = 0; j < 8; ++j) { v[j] = xr[64 * j]; s += (v[j][0] * v[j][0] + v[j][1] * v[j][1]) + (v[j][2] * v[j][2] + v[j][3] * v[j][3]); }
        s = wave_sum(s, F.lane);
        if (F.lane == 0) ((float*)(ws + WS_RSTD1))[m] = 1.0f / sqrtf(s * (1.0f / DM) + EPS);
        u32x2* o = (u32x2*)((bf16_t*)(ws + WS_XB) + (size_t)m * DM) + F.lane;
#pragma unroll
        for (int j = 0; j < 8; ++j) { u32x2 w; w.x = pk2(v[j][0], v[j][1]); w.y = pk2(v[j][2], v[j][3]); o[64 * j] = w; }
    }
}
__device__ __forceinline__ void conv_gateup(const Frame& F, const Params& P, int jlo, int jhi) {
    LAS unsigned char* scr = F.lds + F.wave * 16384;
    for (int u = F.gw; u < 2048; u += F.NGW) { const int e = u >> 6, nb = (u >> 2) & 15, kq = u & 3;
        const int p0 = 64 * nb, T = p0 >> 8, bj = (p0 >> 7) & 1, pos = p0 & 127, col = 128 * T + pos;
        tr_loop(jlo, jhi, 1, scr, F.lane, [&](int j) { TrDesc d; d.src = (bj ? P.w_up : P.w_gate) + (size_t)e * DM * DEXP; d.ld = DEXP; d.c0 = col; d.nvalid = 64; d.gain = P.g_norm2;
            d.dst = (bf16_t*)(P.ws + WS_WGUT) + (size_t)e * 1024 * DM; d.Kd = DM; d.r0 = p0; d.k0 = 64 * (8 * kq + j); return d; }); }
}
__device__ __forceinline__ void conv_down(const Frame& F, const Params& P, int jlo, int jhi) {
    LAS unsigned char* scr = F.lds + F.wave * 16384;
    for (int u = F.gw; u < 2048; u += F.NGW) { const int e = u >> 6, nb = (u >> 1) & 31, kh = u & 1;
        tr_loop(jlo, jhi, 1, scr, F.lane, [&](int j) { TrDesc d; d.src = P.w_down + (size_t)e * DEXP * DM; d.ld = DM; d.c0 = 64 * nb; d.nvalid = 64; d.gain = nullptr;
            d.dst = (bf16_t*)(P.ws + WS_WDT) + (size_t)e * DM * DEXP; d.Kd = DEXP; d.r0 = 64 * nb; d.k0 = 64 * (4 * kh + j); return d; }); }
}

__device__ __forceinline__ void conv_small(const Frame& F, const Params& P, int lo, int hi) {
    unsigned char* ws = P.ws; LAS unsigned char* scr = F.lds + F.wave * 16384;
    constexpr int I_QQ = 8 * 48, I_PA = 16 * 32, I_O = 32 * 32, NIT = I_QQ + 2 * I_PA + I_O;
    tr_loop(lo + F.gw, hi < NIT ? hi : NIT, F.NGW, scr, F.lane, [&](int it) { TrDesc d; d.nvalid = 64;
        int r = it;
        if (r < I_QQ) { const int kb = r / 48, nb = r % 48; const int p0 = 64 * nb, T = p0 >> 8, bj = (p0 >> 7) & 1, pos = p0 & 127, head = 2 * T + (pos >> 6), col = (pos & 63) + 64 * bj;
            d.gain = P.g_cq; d.dst = (bf16_t*)(ws + WS_WTQQ); d.Kd = QR; d.r0 = p0; d.k0 = 64 * kb;
            if (head < 8) { d.src = P.w_uq; d.ld = 1024; d.c0 = head * 128 + col; } else { d.src = P.w_qidx; d.ld = 2048; d.c0 = (head - 8) * 128 + col; }
            return d; }
        r -= I_QQ; d.gain = nullptr;
        if (r < I_PA) { const int kb = r / 32, nb = r % 32; d.src = P.w_pa; d.ld = DM; d.c0 = 64 * nb; d.dst = (bf16_t*)(ws + WS_WTPA); d.Kd = 1024; d.r0 = 64 * nb; d.k0 = 64 * kb; return d; }
        r -= I_PA;
        if (r < I_PA) { const int kb = r / 32, nb = r % 32; d.src = P.w_pb; d.ld = DM; d.c0 = 64 * nb; d.dst = (bf16_t*)(ws + WS_WTPB); d.Kd = 1024; d.r0 = 64 * nb; d.k0 = 64 * kb; return d; }
        r -= I_PA;
        { const int kb = r / 32, nb = r % 32; d.src = P.w_o; d.ld = DM; d.c0 = 64 * nb; d.dst = (bf16_t*)(ws + WS_WTO); d.Kd = DM; d.r0 = 64 * nb; d.k0 = 64 * kb; return d; } });
}

#ifndef P3_NOBAR_PROBE
#define P3_NOBAR_PROBE 0
#endif
__device__ __forceinline__ unsigned key16(unsigned u) { return (u & 0x8000u) ? (~u & 0xffffu) : (u | 0x8000u); }
template <int R>
__device__ __forceinline__ void p3_select(unsigned short* so, int* nselp, const int n, const int lane, const unsigned (&raw)[32]) {
    typedef short s16x2 __attribute__((ext_vector_type(2)));
        s16x2 e[R];
#pragma unroll
        for (int j2 = 0; j2 < R; ++j2) {
            if (128 * j2 < n) { const s16x2 u = __builtin_bit_cast(s16x2, raw[j2]);
                const s16x2 m = u >> 15; const s16x2 k16 = u ^ (m | (s16x2){(short)0x8000, (short)0x8000});
                e[j2] = __builtin_bit_cast(s16x2, (__builtin_bit_cast(unsigned, k16) >> 1) & 0x7fff7fffu); }
            else e[j2] = (s16x2){0, 0};
        }
#define P3_COUNT_LT(C, OUT) { const s16x2 c2_ = (s16x2){(short)(C), (short)(C)}; s16x2 a_ = (s16x2){0, 0}; \
            _Pragma("unroll") for (int j2 = 0; j2 < R; ++j2) a_ += (e[j2] - c2_) >> 15; \
            OUT = -((int)a_[0] + (int)a_[1]); }
        constexpr int nel = 128 * R;
        int thr = 0;
#pragma unroll 1
        for (int bit = 14; bit >= 0; --bit) { const int cand = thr | (1 << bit); int lt; P3_COUNT_LT(cand, lt);
            lt = wave_sum_u(lt); if (nel - lt >= 256) thr = cand; }
        int lt0, lt1; P3_COUNT_LT(thr, lt0); P3_COUNT_LT(thr + 1, lt1);
#undef P3_COUNT_LT
        constexpr int held = 2 * R;
        const int cgt = held - lt1, ceq = lt1 - lt0;
        const int pg = wave_scan_incl(cgt), pe = wave_scan_incl(ceq);
        const int ngt = __builtin_amdgcn_readlane(pg, 63); const int need = 256 - ngt;
        const int eqb = pe - ceq;
        const int take_eq = max(0, min(ceq, need - eqb));
        int pos = (pg - cgt) + min(eqb, need); int eqt = 0;
#pragma unroll
        for (int j2 = 0; j2 < R; ++j2) {
            if (128 * j2 < n) {
#pragma unroll
                for (int h2 = 0; h2 < 2; ++h2) { const int k = (int)e[j2][h2];
                    const bool iseq = (k == thr); const bool take = (k > thr) || (iseq && eqt < take_eq);
                    if (take) { so[pos] = (unsigned short)(128 * j2 + 2 * lane + h2); ++pos; if (iseq) ++eqt; } }
            }
        }
        if (lane == 0) *nselp = 256;
}

__device__ __forceinline__ void p3_task(const Frame& F, const Params& P, int b, int blk, bool do_sel) {
    unsigned char* ws = P.ws; LAS unsigned char* lds = F.lds;
    const bf16_t* qi = (const bf16_t*)(ws + WS_QI); const float* wi = (const float*)(ws + WS_WI);
    unsigned short* sel = (unsigned short*)(ws + WS_SEL); int* nsel = (int*)(ws + WS_NSEL);
    const int lane = opaque_i(F.lane), w = F.wave, tid = 64 * w + lane; const int t0 = 32 * blk; const int hb = lane >> 5, r = lane & 31;
    LAS unsigned char* kb = lds;
    bf16x8 af0[8], af1[8];
    { const size_t tokA = (size_t)b * SEQ + t0 + 4 * w + ((r >> 2) & 1); const int head = (r & 3) + 4 * (r >> 3); const bf16_t* p = qi + (tokA * 16 + head) * 128 + 8 * hb;
#pragma unroll
      for (int s = 0; s < 8; ++s) { af0[s] = *(const bf16x8*)(p + 16 * s); af1[s] = *(const bf16x8*)(p + 2 * 2048 + 16 * s); } }
    float w0[16], w1[16];
    { const float* p = wi + ((size_t)b * SEQ + t0 + 4 * w + hb) * 16;
#pragma unroll
      for (int q = 0; q < 4; ++q) { const f32x4 v = *(const f32x4*)(p + 4 * q), u = *(const f32x4*)(p + 32 + 4 * q);
          w0[4 * q] = v[0]; w0[4 * q + 1] = v[1]; w0[4 * q + 2] = v[2]; w0[4 * q + 3] = v[3]; w1[4 * q] = u[0]; w1[4 * q + 1] = u[1]; w1[4 * q + 2] = u[2]; w1[4 * q + 3] = u[3]; } }
    const int ntiles = blk + 1;
    const int skey = tid >> 4, schunk = tid & 15; const unsigned soff = (unsigned)(skey * 256 + ((schunk ^ (skey & 15)) * 16));
    const unsigned kgo = (unsigned)WS_KIR + (((unsigned)b * SEQ + skey) * 128u + 8u * schunk) * 2u;
    const unsigned sg0 = (unsigned)WS_SCG + blockIdx.x * 262144u + (unsigned)(4 * w + hb) * 8192u + (unsigned)r * 2u, sg1 = sg0 + 2u * 8192u;
    const unsigned sjunk = (unsigned)WS_SCJUNK + (unsigned)lane * 2u;
    __syncthreads();
    u32x4 st0 = *(const u32x4*)(ws + kgo), st1 = st0;
    if (1 < ntiles) st1 = *(const u32x4*)(ws + kgo + 8192u);
    *(LAS u32x4*)(kb + soff) = st0;
    if (2 < ntiles) st0 = *(const u32x4*)(ws + kgo + 2u * 8192u);
    bf16x8 bq[8]; f32x16 acc0, acc1;
#pragma unroll
    for (int e = 0; e < 16; ++e) { acc0[e] = 0.f; acc1[e] = 0.f; }
#pragma unroll
    for (int s = 0; s < 8; ++s) bq[s] = (bf16x8){0, 0, 0, 0, 0, 0, 0, 0};
#define P3_EPI2(ACC, WR, S0, SUM) { const f32x2 rl_ = (f32x2){__int_as_float(max(__float_as_int(ACC[2 * (S0)]), 0)), __int_as_float(max(__float_as_int(ACC[2 * (S0) + 1]), 0))};     \
        SUM = __builtin_elementwise_fma(rl_, (f32x2){WR[2 * (S0)], WR[2 * (S0) + 1]}, SUM); }
#define P3_ITER(IEXPR, PAR, ST) { const int i_ = (IEXPR);     \
        if (P3_NOBAR_PROBE && !do_sel) { } else __syncthreads(); \
        __builtin_amdgcn_sched_barrier(0);     \
        *(LAS u32x4*)(kb + (1 - (PAR)) * 8192 + soff) = ST;     \
        { const int tl_ = (i_ + 3 < ntiles) ? (i_ + 3) : (ntiles - 1); ST = *(const u32x4*)((ws + (size_t)tl_ * 8192u) + kgo); } \
        { f32x2 s2_ = (f32x2){0.f, 0.f}; \
            _Pragma("unroll") for (int s = 0; s < 8; ++s) { \
                if (s == 0) acc0 = __builtin_amdgcn_mfma_f32_32x32x16_bf16(af0[0], bq[0], zero16, 0, 0, 0); \
                else acc0 = __builtin_amdgcn_mfma_f32_32x32x16_bf16(af0[s], bq[s], acc0, 0, 0, 0); \
                P3_EPI2(acc1, w1, s, s2_) \
                __builtin_amdgcn_sched_group_barrier(0x008, 1, 0); __builtin_amdgcn_sched_group_barrier(0x002, 4, 0); } \
            { const unsigned so_ = ((i_ >= 2) && (i_ - 2 < ntiles)) ? (sg1 + 64u * (unsigned)(i_ - 2)) : sjunk; *(_Float16*)(ws + so_) = (_Float16)(s2_[0] + s2_[1]); } } \
        { f32x2 s2_ = (f32x2){0.f, 0.f}; \
            _Pragma("unroll") for (int s = 0; s < 8; ++s) { \
                if (s == 0) acc1 = __builtin_amdgcn_mfma_f32_32x32x16_bf16(af1[0], bq[0], zero16, 0, 0, 0); \
                else acc1 = __builtin_amdgcn_mfma_f32_32x32x16_bf16(af1[s], bq[s], acc1, 0, 0, 0); \
                bq[s] = *(const LAS bf16x8*)(kfrag[s] + (PAR) * 8192); \
                P3_EPI2(acc0, w0, s, s2_) \
                __builtin_amdgcn_sched_group_barrier(0x008, 1, 0); __builtin_amdgcn_sched_group_barrier(0x100, 1, 0); __builtin_amdgcn_sched_group_barrier(0x002, 4, 0); } \
            { const unsigned so_ = ((i_ >= 1) && (i_ - 1 < ntiles)) ? (sg0 + 64u * (unsigned)(i_ - 1)) : sjunk; *(_Float16*)(ws + so_) = (_Float16)(s2_[0] + s2_[1]); } } \
        __builtin_amdgcn_sched_barrier(0); LDS_WAIT(); }
    f32x16 zero16;
#pragma unroll
    for (int e = 0; e < 16; ++e) zero16[e] = 0.f;
    const LAS unsigned char* kfrag[8];
#pragma unroll
    for (int s = 0; s < 8; ++s) kfrag[s] = kb + r * 256 + (((2 * s + hb) ^ (r & 15)) * 16);
    for (int i = 0; i <= ntiles + 1; i += 6) {
        P3_ITER(i, 0, st1)
        P3_ITER(i + 1, 1, st0)
        P3_ITER(i + 2, 0, st1)
        P3_ITER(i + 3, 1, st0)
        P3_ITER(i + 4, 0, st1)
        P3_ITER(i + 5, 1, st0)
    }
#undef P3_ITER
#undef P3_EPI2
    if (!do_sel) return;
    typedef short s16x2 __attribute__((ext_vector_type(2)));
#pragma unroll
    for (int i = 0; i < 4; ++i) { const int n = t0 + 4 * w + i + 1; const int nceil = (n + 127) & ~127;
        unsigned short* row = (unsigned short*)(ws + (unsigned)WS_SCG + blockIdx.x * 262144u + (unsigned)(4 * w + i) * 8192u);
        if (n > 256) { for (int s = n + lane; s < nceil; s += 64) row[s] = 0xFC00u; } }
    asm volatile("s_waitcnt vmcnt(0)" ::: "memory");
    auto ld_row = [&](int i, unsigned (&raw)[32]) __attribute__((always_inline)) { const int n = t0 + 4 * w + i + 1;
        const unsigned short* row = (const unsigned short*)(ws + (unsigned)WS_SCG + blockIdx.x * 262144u + (unsigned)(4 * w + i) * 8192u);
#pragma unroll
        for (int j2 = 0; j2 < 32; ++j2) raw[j2] = (n > 256 && 128 * j2 < n) ? __hip_atomic_load((const unsigned*)(row + 128 * j2 + 2 * lane), __ATOMIC_RELAXED, __HIP_MEMORY_SCOPE_AGENT) : 0u; };
    auto select = [&](int i, const unsigned (&raw)[32]) __attribute__((always_inline)) {
        const int t = t0 + 4 * w + i; const size_t tok = (size_t)b * SEQ + t; const int n = t + 1;
        if (n <= 256) { unsigned short* so = sel + tok * 256;
#pragma unroll
            for (int j = 0; j < 4; ++j) { const int s = 64 * j + lane; if (s < n) so[s] = (unsigned short)s; }
            if (lane == 0) nsel[tok] = n;
            return;
        }
        unsigned short* so = sel + tok * 256;
        if (n <= 1024) p3_select<8>(so, nsel + tok, n, lane, raw); else if (n <= 2048) p3_select<16>(so, nsel + tok, n, lane, raw); else if (n <= 3072) p3_select<24>(so, nsel + tok, n, lane, raw); else p3_select<32>(so, nsel + tok, n, lane, raw);
    };
    unsigned rawA[32], rawB[32];
    ld_row(0, rawA);
#pragma unroll 1
    for (int ip = 0; ip < 4; ip += 2) {
        ld_row(ip + 1, rawB); select(ip, rawA);
        if (ip + 2 < 4) ld_row(ip + 2, rawA);
        select(ip + 1, rawB);
    }
}

#ifndef P4_PROBE
#define P4_PROBE 0
#endif
__device__ __forceinline__ void p4_token(const Frame& F, const Params& P, int tok, const int n, const u32x2 selrow, const bool rep) {
    const unsigned char* ws = P.ws;
    const int lane = F.lane; const int fr = lane & 15, g = lane >> 4;
    LAS unsigned char* vb0 = F.lds + F.wave * 20480;
    LAS unsigned short* selL = (LAS unsigned short*)(vb0 + 4 * 4096);
    const unsigned bbase = (unsigned)(tok >> 12) * SEQ;
    *(LAS u32x2*)(selL + 4 * lane) = selrow;
    LDS_WAIT(); __builtin_amdgcn_wave_barrier();
    const int nch = (n + 31) >> 5;
    unsigned roff[64];
#pragma unroll
    for (int m = 0; m < 64; ++m) { const int slot_ = 4 * m + g; const unsigned key_ = (slot_ < n) ? (unsigned)selL[slot_] : 0u; roff[m] = (bbase + key_) * 256u; }
    const unsigned kswz0 = (unsigned)WS_KR + 16u * (unsigned)(fr ^ g), vswz0 = (unsigned)WS_VV + 16u * (unsigned)(fr ^ (2 * g));
    const bool do_pv = !(P4_PROBE == 2 && rep);
#define P4_KDMA1(CH, KB, I) __builtin_amdgcn_global_load_lds((const unsigned*)(ws + (roff[4 * (CH) + (I)] + ((kswz0 ^ (unsigned)(64 * (I))) - (unsigned)(1024 * (I))))), (LAS unsigned*)(KB), 16, 1024 * (I), 0)
#define P4_KDMA(CH) do { LAS unsigned char* kb_ = vb0 + ((CH) % 5) * 4096; P4_KDMA1(CH, kb_, 0); P4_KDMA1(CH, kb_, 1); P4_KDMA1(CH, kb_, 2); P4_KDMA1(CH, kb_, 3); } while (0)
#define P4_VDMA1(CH, VB, I) __builtin_amdgcn_global_load_lds((const unsigned*)(ws + (roff[4 * (CH) + (I)] + ((vswz0 ^ (unsigned)(128 * ((I) & 1))) - (unsigned)(1024 * (I))))), (LAS unsigned*)(VB), 16, 1024 * (I), 0)
#define P4_VDMA(CH) do { LAS unsigned char* vb_ = vb0 + ((CH) % 5) * 4096; P4_VDMA1(CH, vb_, 0); P4_VDMA1(CH, vb_, 1); P4_VDMA1(CH, vb_, 2); P4_VDMA1(CH, vb_, 3); } while (0)
    bf16x8 qf[4];
#pragma unroll
    for (int s = 0; s < 4; ++s) { if (fr < 8) qf[s] = *(const bf16x8*)(ws + (unsigned)WS_Q + ((unsigned)tok * 1024u + fr * 128u + 32u * s + 8u * g) * 2u); else qf[s] = (bf16x8){0, 0, 0, 0, 0, 0, 0, 0}; }
    f32x4 acc[16];
    P4_KDMA(0); P4_KDMA(1); P4_KDMA(2); P4_KDMA(3);
#pragma unroll
    for (int T = 0; T < 16; ++T) {
        if (T + 4 < 16) P4_KDMA(T + 4);
        if (T <= 11) asm volatile("s_waitcnt vmcnt(16)" ::: "memory"); else if (T == 12) asm volatile("s_waitcnt vmcnt(12)" ::: "memory"); else if (T == 13) asm volatile("s_waitcnt vmcnt(8)" ::: "memory");
        else if (T == 14) asm volatile("s_waitcnt vmcnt(4)" ::: "memory"); else asm volatile("s_waitcnt vmcnt(0)" ::: "memory");
        const LAS unsigned char* kc = vb0 + (T % 5) * 4096 + fr * 256; f32x4 a = (f32x4){0.f, 0.f, 0.f, 0.f};
#pragma unroll
        for (int s = 0; s < 4; ++s) a = __builtin_amdgcn_mfma_f32_16x16x32_bf16(*(const LAS bf16x8*)(kc + (((4 * s + g) ^ fr) * 16)), qf[s], a, 0, 0, 0);
        acc[T] = a;
        LDS_WAIT();
    }
    if (do_pv) { P4_VDMA(0); P4_VDMA(1); P4_VDMA(2); P4_VDMA(3); P4_VDMA(4); }
    float mx = -3.0e38f;
    if (n < 256) {
#pragma unroll
        for (int T = 0; T < 16; ++T)
#pragma unroll
            for (int e = 0; e < 4; ++e) { const int slot = 16 * T + 4 * g + e; if (slot >= n) acc[T][e] = -3.0e38f; }
    }
#pragma unroll
    for (int T = 0; T < 16; ++T)
#pragma unroll
        for (int e = 0; e < 4; ++e) mx = fmaxf(mx, acc[T][e]);
    mx = fmaxf(mx, shx(mx, 16, lane)); mx = fmaxf(mx, shx(mx, 32, lane));
    const float mxs = -mx * 1.4426950408889634f;
    float sum = 0.f; unsigned pb[8][4];
#pragma unroll
    for (int T = 0; T < 16; ++T) { float p[4];
#pragma unroll
        for (int e = 0; e < 4; ++e) { p[e] = __builtin_amdgcn_exp2f(__builtin_fmaf(acc[T][e], 1.4426950408889634f, mxs)); sum += p[e]; }
        pb[T >> 1][(T & 1) * 2] = pk2(p[0], p[1]); pb[T >> 1][(T & 1) * 2 + 1] = pk2(p[2], p[3]); }
    sum += shx(sum, 16, lane); sum += shx(sum, 32, lane);
    const float inv = 1.0f / sum;
    f32x4 o[8];
#pragma unroll
    for (int dt = 0; dt < 8; ++dt) o[dt] = (f32x4){0.f, 0.f, 0.f, 0.f};
    const int q4 = fr >> 2, p4 = fr & 3;
#pragma unroll
    for (int c = 0; c < 8; ++c) {
        if (do_pv) {
            if (c <= 5) asm volatile("s_waitcnt vmcnt(12)" ::: "memory"); else if (c == 6) asm volatile("s_waitcnt vmcnt(8)" ::: "memory"); else asm volatile("s_waitcnt vmcnt(0)" ::: "memory");
            if (c < nch) {
                const LAS unsigned char* va = vb0 + ((2 * c) % 5) * 4096; const LAS unsigned char* vbh = vb0 + ((2 * c + 1) % 5) * 4096;
                u32x4 bw; bw.x = pb[c][0]; bw.y = pb[c][1]; bw.z = pb[c][2]; bw.w = pb[c][3]; const bf16x8 bfrag = __builtin_bit_cast(bf16x8, bw);
                const int r0 = 4 * g + q4;
#pragma unroll
                for (int dt = 0; dt < 8; ++dt) {
                    const int ch = 2 * dt + (p4 >> 1); const int off = r0 * 256 + ((ch ^ (2 * (r0 & 7))) * 16) + 8 * (p4 & 1);
                    const s16x4 lo = __builtin_amdgcn_ds_read_tr16_b64_v4i16((LAS s16x4*)(va + off));
                    const s16x4 hi = __builtin_amdgcn_ds_read_tr16_b64_v4i16((LAS s16x4*)(vbh + off));
                    const u32x2 l2 = __builtin_bit_cast(u32x2, lo), h2 = __builtin_bit_cast(u32x2, hi); u32x4 aw; aw.x = l2.x; aw.y = l2.y; aw.z = h2.x; aw.w = h2.y;
                    o[dt] = __builtin_amdgcn_mfma_f32_16x16x32_bf16(__builtin_bit_cast(bf16x8, aw), bfrag, o[dt], 0, 0, 0); }
                LDS_WAIT();
            }
            if (2 * c + 5 < 16) P4_VDMA(2 * c + 5);
            if (2 * c + 6 < 16) P4_VDMA(2 * c + 6);
        }
    }
    asm volatile("s_waitcnt vmcnt(0)" ::: "memory");
#undef P4_KDMA
#undef P4_KDMA1
#undef P4_VDMA
#undef P4_VDMA1
    if (fr < 8 && !(P4_PROBE != 0 && rep)) {
#pragma unroll
        for (int dt = 0; dt < 8; ++dt) { u32x2 w; w.x = pk2(o[dt][0] * inv, o[dt][1] * inv); w.y = pk2(o[dt][2] * inv, o[dt][3] * inv);
            *(u32x2*)(P.ws + (unsigned)WS_YATT + ((unsigned)tok * 1024u + fr * 128u + 16u * dt + 4u * g) * 2u) = w; }
    }
    __builtin_amdgcn_wave_barrier();
}
__device__ __forceinline__ void p4_tokens(const Frame& F, const Params& P, const bool rep) {
    const unsigned char* ws = P.ws; int tok = F.gw; if (tok >= NTOK) return;
    int n = ((const int*)(ws + WS_NSEL))[tok]; u32x2 row = *(const u32x2*)(ws + (unsigned)WS_SEL + (unsigned)tok * 512u + 8u * F.lane);
    for (;;) {
        const int nxt = tok + F.NGW; const int tl = nxt < NTOK ? nxt : tok;
        const int n2 = ((const int*)(ws + WS_NSEL))[tl]; const u32x2 row2 = *(const u32x2*)(ws + (unsigned)WS_SEL + (unsigned)tl * 512u + 8u * F.lane);
        p4_token(F, P, tok, n, row, rep);
        if (nxt >= NTOK) break;
        tok = nxt; n = n2; row = row2;
    }
}

__device__ __forceinline__ void h1_pass(const Frame& F, const Params& P, int ubase, bool rep) {
    unsigned char* ws = P.ws; LAS unsigned char* lds = F.lds;
    const int us = F.tid >> 7, d = F.tid & 127; const int uidx = ubase + us;
    const int b = uidx >> 9, c = (uidx >> 3) & 63, h = uidx & 7; const unsigned tok0 = (unsigned)(b * SEQ + 64 * c); const unsigned col0 = 128u * h;
    LAS bf16_t* KtL = (LAS bf16_t*)(lds + us * 36864); LAS bf16_t* VtL = KtL + 128 * 72;
    const unsigned e0 = (tok0 * 1024u + col0 + d);
    __syncthreads();
    float cum[64];
#pragma unroll
    for (int t = 0; t < 64; ++t) cum[t] = *(const float*)(ws + (unsigned)WS_LOGF + (e0 + 1024u * t) * 4u);
#pragma unroll
    for (int t = 1; t < 64; ++t) cum[t] += cum[t - 1];
    const float cmid = cum[31], clast = cum[63];
#pragma unroll
    for (int tg = 0; tg < 64; tg += 8) {
        unsigned short qraw[8], vraw[8];
#pragma unroll
        for (int i = 0; i < 8; ++i) { const unsigned a = (e0 + 1024u * (tg + i)) * 2u; qraw[i] = *(const bf16_t*)(ws + (unsigned)WS_QT + a); vraw[i] = *(const bf16_t*)(ws + (unsigned)WS_VH + a); }
#pragma unroll
        for (int i = 0; i < 8; ++i) { const int t = tg + i; const float g = (t == 0) ? cum[0] : (cum[t] - cum[t - 1]);
            const float e = __expf(cum[t] - cmid), ei = __expf(cmid - cum[t]), el = __expf(clast - cum[t]); const float k1 = 1.0f - __expf(g);
            const unsigned a = (e0 + 1024u * t) * 2u;
            const bf16_t qb = (bf16_t)f2bf(bf2f(qraw[i]) * e);
            if (!rep) *(bf16_t*)(ws + (unsigned)WS_QT + a) = qb; else *(bf16_t*)(ws + (unsigned)WS_KT + a) = qb;
            *(bf16_t*)(ws + (unsigned)WS_KT + a) = (bf16_t)f2bf(k1 * ei);
            KtL[d * 72 + t] = (bf16_t)f2bf(k1 * el); VtL[d * 72 + t] = vraw[i]; }
        asm volatile("" ::: "memory"); __builtin_amdgcn_sched_barrier(0);
    }
    ((float*)(ws + WS_AVEC))[(size_t)uidx * 128 + d] = __expf(cmid); ((float*)(ws + WS_DECAY))[(size_t)uidx * 128 + d] = __expf(clast);
    __syncthreads();
    const int lane2 = opaque_i(F.lane); const int fr = lane2 & 15, g = lane2 >> 4, wu = F.wave & 1;
    bf16x8 kf[8][2];
#pragma unroll
    for (int dt = 0; dt < 8; ++dt) { kf[dt][0] = *(const LAS bf16x8*)(KtL + (16 * dt + fr) * 72 + 8 * g); kf[dt][1] = *(const LAS bf16x8*)(KtL + (16 * dt + fr) * 72 + 32 + 8 * g); }
    bf16_t* KVb = (bf16_t*)(ws + WS_KV) + (size_t)uidx * 16384;
#pragma unroll
    for (int vi = 0; vi < 4; ++vi) { const int vt = 4 * wu + vi;
        const bf16x8 a0 = *(const LAS bf16x8*)(VtL + (16 * vt + fr) * 72 + 8 * g), a1 = *(const LAS bf16x8*)(VtL + (16 * vt + fr) * 72 + 32 + 8 * g);
#pragma unroll
        for (int dt = 0; dt < 8; ++dt) { f32x4 acc = (f32x4){0.f, 0.f, 0.f, 0.f};
            acc = __builtin_amdgcn_mfma_f32_16x16x32_bf16(a0, kf[dt][0], acc, 0, 0, 0); acc = __builtin_amdgcn_mfma_f32_16x16x32_bf16(a1, kf[dt][1], acc, 0, 0, 0);
#pragma unroll
            for (int e = 0; e < 4; ++e) KVb[(16 * vt + 4 * g + e) * 128 + 16 * dt + fr] = (bf16_t)f2bf(acc[e]); }
        __builtin_amdgcn_sched_barrier(0); }
}
__device__ __forceinline__ void h2_scan(const Frame& F, const Params& P) {
    unsigned char* ws = P.ws; bf16_t* KV = (bf16_t*)(ws + WS_KV); const float* decay = (const float*)(ws + WS_DECAY);
    for (int idx = blockIdx.x * 512 + F.tid; idx < 32 * 4096; idx += F.G * 512) {
    const int bh = idx >> 12, rem = idx & 4095, v = rem >> 5, d4 = rem & 31; const int b = bh >> 3, h = bh & 7;
    f32x4 S = (f32x4){0.f, 0.f, 0.f, 0.f};
    for (int c0 = 0; c0 < 64; c0 += 16) {
        u32x2 kv[16]; f32x4 dc[16];
#pragma unroll
        for (int j = 0; j < 16; ++j) { const size_t u = (size_t)((b * 64 + c0 + j) * 8 + h); kv[j] = *(const u32x2*)(KV + u * 16384 + v * 128 + 4 * d4); dc[j] = *(const f32x4*)(decay + u * 128 + 4 * d4); }
#pragma unroll
        for (int j = 0; j < 16; ++j) { const size_t u = (size_t)((b * 64 + c0 + j) * 8 + h);
            u32x2 o; o.x = pk2(S[0], S[1]); o.y = pk2(S[2], S[3]);
            *(u32x2*)(KV + u * 16384 + v * 128 + 4 * d4) = o;
            S[0] = dc[j][0] * S[0] + bf2f(kv[j].x & 0xffffu); S[1] = dc[j][1] * S[1] + bf2f(kv[j].x >> 16); S[2] = dc[j][2] * S[2] + bf2f(kv[j].y & 0xffffu); S[3] = dc[j][3] * S[3] + bf2f(kv[j].y >> 16); }
    }
    }
}
__device__ __forceinline__ void h3_unit(const Frame& F, const Params& P, int bc) {
    const unsigned char* ws = P.ws; LAS unsigned char* lds = F.lds;
    const int lane = F.lane, fr = lane & 15, g = lane >> 4, h = F.wave; const int b = bc >> 6, c = bc & 63; const int uidx = bc * 8 + h;
    const unsigned tok0 = (unsigned)(b * SEQ + 64 * c); const unsigned col0 = 128u * h;
    const unsigned rowoff = ((tok0 + fr) * 1024u + col0 + 8u * g) * 2u;
    LAS unsigned char* Vt = lds + h * 16384; LAS float* ex = (LAS float*)(lds + 131072);
    __syncthreads();
    { const unsigned vo = (unsigned)WS_VH + ((tok0 + (lane >> 4)) * 1024u + col0 + 8u * (lane & 15)) * 2u;
#pragma unroll 4
      for (int it = 0; it < 16; ++it) { const int t = 4 * it + (lane >> 4), chunk = lane & 15;
        const u32x4 wv = *(const u32x4*)(ws + vo + (unsigned)it * 4u * 2048u);
#pragma unroll
        for (int e = 0; e < 8; ++e) { const int v = 8 * chunk + e; const unsigned wd = ((const unsigned*)&wv)[e >> 1]; const unsigned short val = (e & 1) ? (unsigned short)(wd >> 16) : (unsigned short)(wd & 0xffffu);
            *(LAS unsigned short*)(Vt + v * 128 + (((t >> 2) ^ (v & 15)) * 8) + (t & 3) * 2) = val; } } }
    LDS_WAIT(); __builtin_amdgcn_wave_barrier();
    const unsigned soff = (unsigned)WS_KV + ((unsigned)uidx * 16384u + (unsigned)fr * 128u + 8u * g) * 2u;
    const unsigned aoff = (unsigned)WS_AVEC + ((unsigned)uidx * 128u + 8u * g) * 4u;
#pragma unroll 1
    for (int jh = 0; jh < 2; ++jh) {
        bf16x8 qf[2][4];
#pragma unroll
        for (int jj = 0; jj < 2; ++jj)
#pragma unroll
            for (int ks = 0; ks < 4; ++ks) qf[jj][ks] = *(const bf16x8*)(ws + (unsigned)WS_QT + rowoff + (unsigned)(16 * (2 * jh + jj)) * 2048u + 64u * ks);
        unsigned bfr[2][2][4];
#pragma unroll
        for (int jj = 0; jj < 2; ++jj)
#pragma unroll
            for (int p = 0; p < 2; ++p)
#pragma unroll
                for (int e = 0; e < 4; ++e) bfr[jj][p][e] = 0u;
#pragma unroll
        for (int i = 0; i < 4; ++i) {
            if (i <= 2 * jh + 1) {
                bf16x8 kf[4];
#pragma unroll
                for (int ks = 0; ks < 4; ++ks) kf[ks] = *(const bf16x8*)(ws + (unsigned)WS_KT + rowoff + (unsigned)(16 * i) * 2048u + 64u * ks);
#pragma unroll
                for (int jj = 0; jj < 2; ++jj) { const int j = 2 * jh + jj;
                    if (i <= j) { f32x4 st = (f32x4){0.f, 0.f, 0.f, 0.f};
#pragma unroll
                        for (int ks = 0; ks < 4; ++ks) st = __builtin_amdgcn_mfma_f32_16x16x32_bf16(kf[ks], qf[jj][ks], st, 0, 0, 0);
                        if (i == j) {
#pragma unroll
                            for (int e = 0; e < 4; ++e) st[e] = (4 * g + e <= fr) ? st[e] : 0.f; }
                        bfr[jj][i >> 1][(i & 1) * 2] = pk2(st[0], st[1]); bfr[jj][i >> 1][(i & 1) * 2 + 1] = pk2(st[2], st[3]); } }
            }
        }
#pragma unroll
        for (int ks = 0; ks < 4; ++ks) { const f32x4 a0 = *(const f32x4*)(ws + aoff + 128u * ks), a1 = *(const f32x4*)(ws + aoff + 128u * ks + 16u);
#pragma unroll
            for (int jj = 0; jj < 2; ++jj) { const u32x4 qw = __builtin_bit_cast(u32x4, qf[jj][ks]); u32x4 o;
                o.x = pk2(bf2f(qw.x & 0xffffu) * a0[0], bf2f(qw.x >> 16) * a0[1]); o.y = pk2(bf2f(qw.y & 0xffffu) * a0[2], bf2f(qw.y >> 16) * a0[3]);
                o.z = pk2(bf2f(qw.z & 0xffffu) * a1[0], bf2f(qw.z >> 16) * a1[1]); o.w = pk2(bf2f(qw.w & 0xffffu) * a1[2], bf2f(qw.w >> 16) * a1[3]);
                qf[jj][ks] = __builtin_bit_cast(bf16x8, o); } }
        f32x4 acc[8][2];
#pragma unroll
        for (int vt = 0; vt < 8; ++vt) { acc[vt][0] = (f32x4){0.f, 0.f, 0.f, 0.f}; acc[vt][1] = (f32x4){0.f, 0.f, 0.f, 0.f}; }
#pragma unroll
        for (int vt = 0; vt < 8; ++vt) {
            const int v = 16 * vt + fr;
#pragma unroll
            for (int p = 0; p < 2; ++p) {
                if (p <= jh) {
                    const u32x2 lo = *(const LAS u32x2*)(Vt + v * 128 + (((8 * p + g) ^ (v & 15)) * 8)), hi = *(const LAS u32x2*)(Vt + v * 128 + (((8 * p + 4 + g) ^ (v & 15)) * 8));
                    u32x4 aw; aw.x = lo.x; aw.y = lo.y; aw.z = hi.x; aw.w = hi.y; const bf16x8 af = __builtin_bit_cast(bf16x8, aw);
#pragma unroll
                    for (int jj = 0; jj < 2; ++jj) { u32x4 bw; bw.x = bfr[jj][p][0]; bw.y = bfr[jj][p][1]; bw.z = bfr[jj][p][2]; bw.w = bfr[jj][p][3];
                        acc[vt][jj] = __builtin_amdgcn_mfma_f32_16x16x32_bf16(af, __builtin_bit_cast(bf16x8, bw), acc[vt][jj], 0, 0, 0); }
                }
            }
#pragma unroll
            for (int ks = 0; ks < 4; ++ks) {
                const bf16x8 af = *(const bf16x8*)(ws + soff + (unsigned)(16 * vt) * 256u + 64u * ks);
#pragma unroll
                for (int jj = 0; jj < 2; ++jj) acc[vt][jj] = __builtin_amdgcn_mfma_f32_16x16x32_bf16(af, qf[jj][ks], acc[vt][jj], 0, 0, 0);
            }
            if ((vt & 3) == 3) asm volatile("" ::: "memory");
        }
#pragma unroll
        for (int jj = 0; jj < 2; ++jj) { float s = 0.f;
#pragma unroll
            for (int vt = 0; vt < 8; ++vt) s += (acc[vt][jj][0] * acc[vt][jj][0] + acc[vt][jj][1] * acc[vt][jj][1]) + (acc[vt][jj][2] * acc[vt][jj][2] + acc[vt][jj][3] * acc[vt][jj][3]);
            s += shx(s, 16, lane); s += shx(s, 32, lane);
            if (g == 0) ex[(16 * (2 * jh + jj) + fr) * 8 + h] = s; }
        __syncthreads();
        const unsigned ooff = ((tok0 + fr) * 1024u + col0 + 4u * g) * 2u;
        f32x4 gh8[8];
#pragma unroll
        for (int vt = 0; vt < 8; ++vt) gh8[vt] = *(const f32x4*)(P.g_hnorm + col0 + 16 * vt + 4 * g);
#pragma unroll
        for (int jj = 0; jj < 2; ++jj) { const int t = 16 * (2 * jh + jj) + fr;
            const f32x4 e0 = *(const LAS f32x4*)(ex + t * 8), e1 = *(const LAS f32x4*)(ex + t * 8 + 4);
            const float rs = __builtin_amdgcn_rsqf((((e0[0] + e0[1]) + (e0[2] + e0[3])) + ((e1[0] + e1[1]) + (e1[2] + e1[3]))) * (1.0f / 1024.0f) + EPS);
            u32x2 sg8[8];
#pragma unroll
            for (int vt = 0; vt < 8; ++vt) sg8[vt] = *(const u32x2*)(ws + (unsigned)WS_SG + ooff + (unsigned)(16 * (2 * jh + jj)) * 2048u + 32u * vt);
#pragma unroll
            for (int vt = 0; vt < 8; ++vt) { const unsigned o = ooff + (unsigned)(16 * (2 * jh + jj)) * 2048u + 32u * vt;
                const u32x2 sgw = sg8[vt]; const f32x4 gh = gh8[vt];
                const float y0 = acc[vt][jj][0] * rs * gh[0] * bf2f(sgw.x & 0xffffu), y1 = acc[vt][jj][1] * rs * gh[1] * bf2f(sgw.x >> 16);
                const float y2 = acc[vt][jj][2] * rs * gh[2] * bf2f(sgw.y & 0xffffu), y3 = acc[vt][jj][3] * rs * gh[3] * bf2f(sgw.y >> 16);
                u32x2 w; w.x = pk2(y0, y1); w.y = pk2(y2, y3); *(u32x2*)(P.ws + (unsigned)WS_YREC + o) = w; } }
        __syncthreads();
    }
}

__device__ __forceinline__ void p7_pass(const Frame& F, const Params& P, int task0, bool rep) {
    unsigned char* ws = P.ws; LAS unsigned char* lds = F.lds;
    const int lane = F.lane, fr = lane & 15, g = lane >> 4, w = F.wave; const int tt = w & 3, kh = w >> 2; const unsigned tok0 = (unsigned)task0 * 16u;
    constexpr int STG = 57344;
    LAS float* lgx = (LAS float*)(lds + 2 * STG);
    LAS int* hist = (LAS int*)(lds + 2 * STG + 2 * 64 * 48 * 4);
    if (F.tid < 32) hist[F.tid] = 0;
    const int l5 = lane & 31, lh = lane >> 5;
#define P7_DMA(KC) do { LAS unsigned char* st_ = lds + ((KC) & 1) * STG; \
        _Pragma("unroll") for (int i_ = 0; i_ < 4; ++i_) { const int row_ = 8 * w + 2 * i_ + lh; \
            __builtin_amdgcn_global_load_lds((const unsigned*)(ws + (unsigned)WS_X1B + (tok0 + row_) * 4096u + (unsigned)(KC) * 512u + 16u * (unsigned)(l5 ^ (row_ & 15))), (LAS unsigned*)(st_ + (8 * w + 2 * i_) * 512), 16, 0, 0); } \
        _Pragma("unroll") for (int i_ = 0; i_ < 3; ++i_) { const int row_ = 6 * w + 2 * i_ + lh; \
            __builtin_amdgcn_global_load_lds((const unsigned*)(ws + (unsigned)WS_WRT + (unsigned)row_ * 4096u + (unsigned)(KC) * 512u + 16u * (unsigned)(l5 ^ (row_ & 15))), (LAS unsigned*)(st_ + 32768 + (6 * w + 2 * i_) * 512), 16, 0, 0); } } while (0)
    if (!rep) { int* tokrow = (int*)(ws + WS_TOKROW); for (int i = (task0 >> 2) * 159 + F.tid; i < (task0 >> 2) * 159 + 159; i += 512) tokrow[i] = 0; }
    f32x4 acc[3];
#pragma unroll
    for (int nt = 0; nt < 3; ++nt) acc[nt] = (f32x4){0.f, 0.f, 0.f, 0.f};
    __syncthreads();
    P7_DMA(0);
#pragma unroll 1
    for (int kc = 0; kc < 8; ++kc) {
        if (kc + 1 < 8) { P7_DMA(kc + 1); asm volatile("s_waitcnt vmcnt(7)" ::: "memory"); } else asm volatile("s_waitcnt vmcnt(0)" ::: "memory");
        __syncthreads();
        const LAS unsigned char* st = lds + (kc & 1) * STG;
#pragma unroll
        for (int q = 0; q < 4; ++q) { const int c = 4 * (4 * kh + q) + g;
            const bf16x8 a = *(const LAS bf16x8*)(st + (16 * tt + fr) * 512 + ((c ^ fr) * 16));
#pragma unroll
            for (int nt = 0; nt < 3; ++nt) acc[nt] = __builtin_amdgcn_mfma_f32_16x16x32_bf16(a, *(const LAS bf16x8*)(st + 32768 + (16 * nt + fr) * 512 + ((c ^ fr) * 16)), acc[nt], 0, 0, 0); }
        LDS_WAIT();
        __syncthreads();
    }
#undef P7_DMA
#pragma unroll
    for (int nt = 0; nt < 3; ++nt)
#pragma unroll
        for (int e = 0; e < 4; ++e) lgx[(kh * 64 + 16 * tt + 4 * g + e) * 48 + 16 * nt + fr] = acc[nt][e];
    __syncthreads();
    if (kh == 0 && lane < 16) {
        const unsigned tok = tok0 + 16u * tt + lane; const float* part = (const float*)(ws + WS_SSQ2) + (size_t)tok * 32; float ssq = 0.f;
#pragma unroll
        for (int q = 0; q < 8; ++q) { const f32x4 v = *(const f32x4*)(part + 4 * q); ssq += (v[0] + v[1]) + (v[2] + v[3]); }
        const float rs = 1.0f / sqrtf(ssq * (1.0f / DM) + EPS);
        const LAS float* l = lgx + (16 * tt + lane) * 48; const LAS float* l2 = l + 64 * 48;
        float gl0 = (l[0] + l2[0]) * rs + P.b_grp[0]; int grp = 0; float gmax = gl0; float glv[4]; glv[0] = gl0;
#pragma unroll
        for (int j = 1; j < 4; ++j) { const float v = (l[j] + l2[j]) * rs + P.b_grp[j]; glv[j] = v; if (v > gmax) { gmax = v; grp = j; } }
        float gsum = 0.f;
#pragma unroll
        for (int j = 0; j < 4; ++j) gsum += expf(glv[j] - gmax);
        const float pg = 1.0f / gsum;
        float m1 = -3.0e38f, m2 = -3.0e38f; int i1 = 0, i2 = 0;
#pragma unroll
        for (int i = 0; i < 8; ++i) { const float v = (l[4 + 8 * grp + i] + l2[4 + 8 * grp + i]) * rs + P.b_exp[8 * grp + i];
            if (v > m1) { m2 = m1; i2 = i1; m1 = v; i1 = i; } else if (v > m2) { m2 = v; i2 = i; } }
        const float r2 = expf(m2 - m1); const float g0 = pg / (1.0f + r2), g1 = pg * r2 / (1.0f + r2);
        const int e0 = grp * 8 + i1, e1 = grp * 8 + i2;
        const int r0 = __hip_atomic_fetch_add(hist + e0, 1, __ATOMIC_RELAXED, __HIP_MEMORY_SCOPE_WORKGROUP), r1 = __hip_atomic_fetch_add(hist + e1, 1, __ATOMIC_RELAXED, __HIP_MEMORY_SCOPE_WORKGROUP);
        ((int*)(ws + WS_ROUTE_E))[tok * 2] = e0 | (r0 << 8); ((int*)(ws + WS_ROUTE_E))[tok * 2 + 1] = e1 | (r1 << 8);
        ((float*)(ws + WS_ROUTE_G))[tok * 2] = g0; ((float*)(ws + WS_ROUTE_G))[tok * 2 + 1] = g1;
        ((float*)(ws + WS_RSTD1))[tok] = rs;
    }
    __syncthreads();
    if (F.tid < 32) ((int*)(ws + WS_CNTB))[(task0 >> 2) * 32 + F.tid] = hist[F.tid];
}

__device__ __forceinline__ void p7b_gather(const Frame& F, const Params& P, bool rep) {
    unsigned char* ws = P.ws; int* ctl = (int*)(ws + WS_CTL); const int lane = F.lane;
    int* tokrow = (int*)(ws + WS_TOKROW); const int* cb = (const int*)(ws + WS_CNTB);
    for (int tok0 = (F.wave * F.G + (int)blockIdx.x) * 64; tok0 < NTOK; tok0 += F.NGW * 64) {
        const int gi = tok0 >> 6;
        const int e = lane & 31; int tot = 0, lt = 0;
        const int tok = tok0 + lane;
        const int pk0 = ((const int*)(ws + WS_ROUTE_E))[tok * 2], pk1 = ((const int*)(ws + WS_ROUTE_E))[tok * 2 + 1];
        const float rs = ((const float*)(ws + WS_RSTD1))[tok]; const float gt0 = ((const float*)(ws + WS_ROUTE_G))[tok * 2], gt1 = ((const float*)(ws + WS_ROUTE_G))[tok * 2 + 1];
#pragma unroll 32
        for (int p = lane >> 5; p < NTOK / 64; p += 2) { const int v = cb[p * 32 + e]; tot += v; lt += (p < gi) ? v : 0; }
        tot += shl_i(tot, lane ^ 32, lane); lt += shl_i(lt, lane ^ 32, lane);
        const int c = (lane < 32) ? tot : 0; const int pad = (c + 255) & ~255;
        int incl = pad;
#pragma unroll
        for (int o = 1; o < 64; o <<= 1) { const int t = shl_i(incl, lane - o, lane); if (lane >= o) incl += t; }
        const int basev = incl - pad;
        if (gi == 0 && !rep) {
            const int total = shl_i(incl, 31, lane); if (lane == 0) ctl[128] = total >> 8;
            if (lane < 32) { for (int r = basev >> 8; r < (incl >> 8); ++r) ctl[256 + r] = lane; }
        }
        const int rowbase = basev + lt;
        const int d0 = shl_i(rowbase, pk0 & 255, lane) + (pk0 >> 8), d1 = shl_i(rowbase, pk1 & 255, lane) + (pk1 >> 8);
        tokrow[d0] = tok; tokrow[d1] = tok;
        ((float*)(ws + WS_RSS))[d0] = rs; ((float*)(ws + WS_RSS))[d1] = rs;
        ((float*)(ws + WS_GS))[d0] = gt0; ((float*)(ws + WS_GS))[d1] = gt1;
        ((int*)(ws + WS_DEST))[tok * 2] = d0; ((int*)(ws + WS_DEST))[tok * 2 + 1] = d1;
    }
}

__device__ __forceinline__ void p9_final(const Frame& F, const Params& P) {
    unsigned char* ws = P.ws; const bf16_t* ys = (const bf16_t*)(ws + WS_YS); const bf16_t* x1b = (const bf16_t*)(ws + WS_X1B); const int lane = F.lane;
    f32x4 gf8[8];
#pragma unroll
    for (int j = 0; j < 8; ++j) gf8[j] = *((const f32x4*)P.g_final + 64 * j + lane);
    int tok = F.gw; if (tok >= NTOK) return;
    u32x2 xa[8], ya[8], yb[8];
    int d0n = ((const int*)(ws + WS_DEST))[tok * 2], d1n = ((const int*)(ws + WS_DEST))[tok * 2 + 1];
#define P9_LOAD(TOK, D0, D1) { const u32x2* x0_ = (const u32x2*)(x1b + (size_t)(TOK) * DM) + lane; const u32x2* y0_ = (const u32x2*)(ys + (size_t)(D0) * DM) + lane; const u32x2* y1_ = (const u32x2*)(ys + (size_t)(D1) * DM) + lane; \
        _Pragma("unroll") for (int j = 0; j < 8; ++j) { xa[j] = x0_[64 * j]; ya[j] = y0_[64 * j]; yb[j] = y1_[64 * j]; } }
    P9_LOAD(tok, d0n, d1n)
    { const int t1 = tok + F.NGW < NTOK ? tok + F.NGW : tok; d0n = ((const int*)(ws + WS_DEST))[t1 * 2]; d1n = ((const int*)(ws + WS_DEST))[t1 * 2 + 1]; }
    for (;;) {
        const int nxt = tok + F.NGW; const bool has = nxt < NTOK;
        f32x4 v[8]; float s = 0.f;
#pragma unroll
        for (int j = 0; j < 8; ++j) { const u32x2 x = xa[j], a = ya[j], b = yb[j];
            v[j][0] = bf2f(x.x & 0xffffu) + (bf2f(a.x & 0xffffu) + bf2f(b.x & 0xffffu)); v[j][1] = bf2f(x.x >> 16) + (bf2f(a.x >> 16) + bf2f(b.x >> 16));
            v[j][2] = bf2f(x.y & 0xffffu) + (bf2f(a.y & 0xffffu) + bf2f(b.y & 0xffffu)); v[j][3] = bf2f(x.y >> 16) + (bf2f(a.y >> 16) + bf2f(b.y >> 16));
            s += (v[j][0] * v[j][0] + v[j][1] * v[j][1]) + (v[j][2] * v[j][2] + v[j][3] * v[j][3]); }
        if (has) { P9_LOAD(nxt, d0n, d1n)
            const int t2 = nxt + F.NGW < NTOK ? nxt + F.NGW : nxt; d0n = ((const int*)(ws + WS_DEST))[t2 * 2]; d1n = ((const int*)(ws + WS_DEST))[t2 * 2 + 1]; }
        s = wave_sum(s, lane); const float rs = 1.0f / sqrtf(s * (1.0f / DM) + EPS);
        f32x4* xr = (f32x4*)(P.out + (size_t)tok * DM) + lane;
#pragma unroll
        for (int j = 0; j < 8; ++j) xr[64 * j] = v[j] * rs * gf8[j];
        if (!has) break;
        tok = nxt;
    }
#undef P9_LOAD
}

#ifndef PHMASK
#define PHMASK 0xFFFFFF
#endif
#ifndef SELREP
#define SELREP 0
#endif
#ifndef REPMASK
#define REPMASK 0
#endif
#define TS_READ(v) asm volatile("s_memrealtime %0\n\ts_waitcnt lgkmcnt(0)" : "=s"(v) :: "memory")
#ifdef TS_A0
#define TS_MARK(k) { if (blockIdx.x == TS_BLOCK && threadIdx.x == 0) { unsigned long long t_; TS_READ(t_); __hip_atomic_store((unsigned long long*)(ws + WS_BAR + 15360) + (k), t_, __ATOMIC_RELAXED, __HIP_MEMORY_SCOPE_AGENT); } }
#else
#define TS_MARK(k)
#endif
#define PH(k) for (int _rep = 0; _rep < 1 + ((REPMASK >> (k)) & 1); ++_rep) if constexpr ((PHMASK >> (k)) & 1)
__global__ void __launch_bounds__(512, 2) mega_fwd(Params P) {
    extern __shared__ __attribute__((aligned(16))) unsigned char lds_raw[];
    cg::grid_group grid = cg::this_grid();
    LAS unsigned char* lds = (LAS unsigned char*)lds_raw; const int G = gridDim.x;
    const int wave_id = __builtin_amdgcn_readfirstlane((int)(threadIdx.x >> 6));
    unsigned char* ws = P.ws;
    const float* ctab = (const float*)(ws + WS_COS); const float* stab = (const float*)(ws + WS_SIN);
    volatile unsigned* bst = (volatile unsigned*)(ws + WS_BST) + 2 * blockIdx.x;
    if (wave_id == 0 && lane_id() < 2) bst[lane_id()] = 0u;
    __syncthreads();
    const XcdBarrier xbar = xcd_barrier_post((unsigned*)(ws + WS_BAR), bst, wave_id);
#ifdef TS_A0
    TS_MARK(12)
#endif
    if (ws == nullptr) grid.sync();
    PH(0) { const Frame F = make_frame(lds, wave_id); p0_prep(F, P); }
    xcd_barrier(xbar);
    TS_MARK(0)
    const int skew = (blockIdx.x >> 3) & 3;
    const bool skew_first = skew != 0;
    if (skew_first) { const Frame F = make_frame(lds, wave_id); conv_small(F, P, 0, skew == 3 ? 2432 : 2048); conv_down(F, P, 0, (4 * skew) / 3); __syncthreads(); }
#ifdef P1_DELAY_US
    { const unsigned long long t0 = __builtin_amdgcn_s_memrealtime(); const unsigned long long dt = (unsigned long long)(skew * P1_DELAY_US) * 100ull;
      while (__builtin_amdgcn_s_memrealtime() - t0 < dt) __builtin_amdgcn_s_sleep(8); }
#endif
    PH(1) { SchedDense S; S.A = (const char*)(ws + WS_XB); S.Bt = (const char*)(ws + WS_WTIN); S.nM = NTOK / 256; S.nN = NP1 / 256; S.G = G; S.c = blockIdx.x; S.tstep = (size_t)256 * DM * 2;
      EpiIn E; E.ws = ws; E.rstd1 = (const float*)(ws + WS_RSTD1); E.lb = (const float*)(ws + WS_LB); E.ctab = ctab; E.stab = stab;
      if (_rep == 0) pg8::gemm_phase(lds, DM, S, E, wave_id); else {
#if defined(EPI_PROBE_MODE)
        EpiProbeStore<EPI_PROBE_MODE> E0; E0.ws = ws; pg8::gemm_phase(lds, DM, S, E0, wave_id);
#else
        EpiNull E0; pg8::gemm_phase(lds, DM, S, E0, wave_id);
#endif
      } }
    { const Frame F = make_frame(lds, wave_id); if (skew != 3) { conv_small(F, P, skew == 0 ? 0 : 2048, 2432); conv_down(F, P, (4 * skew) / 3, 4); } }
    xcd_barrier(xbar);
    TS_MARK(1)
    PH(2) { SchedDense S; S.A = (const char*)(ws + WS_CQ); S.Bt = (const char*)(ws + WS_WTQQ); S.nM = NTOK / 256; S.nN = 3072 / 256; S.G = G; S.c = blockIdx.x; S.tstep = (size_t)256 * QR * 2;
      EpiQ E; E.ws = ws;
      pg8::gemm_phase(lds, QR, S, E, wave_id); }
    PH(3) { const Frame F = make_frame(lds, wave_id); for (int u = 4 * blockIdx.x; u < 2048; u += 4 * G) h1_pass(F, P, u, _rep != 0); }
    xcd_barrier(xbar);
    TS_MARK(2)
    PH(4) { const Frame F = make_frame(lds, wave_id); for (int task = blockIdx.x; task < 512; task += G) { const int bb = task >> 7, j = task & 127; p3_task(F, P, bb, ((bb >> 1) & 1) ? 127 - j : j, (_rep == 0) || SELREP); } }
    TS_MARK(15)
    __syncthreads();
    PH(5) { const Frame F = make_frame(lds, wave_id); h2_scan(F, P); }
    TS_MARK(16)
    xcd_barrier(xbar);
    TS_MARK(3)
#if defined(DUMP) && DUMP == 3
    { const Frame F = make_frame(lds, wave_id); const float* src = (const float*)(ws + WS_KV);
      for (size_t i = (size_t)blockIdx.x * 512 + F.tid; i < (size_t)NTOK * DM; i += (size_t)G * 512) P.out[i] = src[i];
      return; }
#endif
#if defined(DUMP) && DUMP == 2
    { const Frame F = make_frame(lds, wave_id); const bf16_t* s0 = (const bf16_t*)(ws + WS_QT); const bf16_t* s1 = (const bf16_t*)(ws + WS_KT);
      for (size_t i = (size_t)blockIdx.x * 512 + F.tid; i < (size_t)NTOK * DM; i += (size_t)G * 512) { const size_t r = i / DM, c = i % DM; P.out[i] = bf2f((c < 1024 ? s0 : s1)[r * 1024 + (c & 1023)]); }
      return; }
#endif
    PH(6) { const Frame F = make_frame(lds, wave_id); p4_tokens(F, P, _rep != 0); }
    PH(7) { const Frame F = make_frame(lds, wave_id); for (int bc = blockIdx.x; bc < 256; bc += G) h3_unit(F, P, bc); }
    xcd_barrier(xbar);
    TS_MARK(4)
#ifdef DUMP
    { const Frame F = make_frame(lds, wave_id); const bf16_t* src = (const bf16_t*)(ws + (DUMP == 0 ? WS_YATT : WS_YREC));
      for (size_t i = (size_t)blockIdx.x * 512 + F.tid; i < (size_t)NTOK * DM; i += (size_t)G * 512) { const size_t r = i / DM, c = i % DM; P.out[i] = bf2f(src[r * 1024 + (c & 1023)]); }
      return; }
#endif
    PH(8) { SchedMerged S; S.A0 = (const char*)(ws + WS_YATT); S.A1 = (const char*)(ws + WS_YREC); S.B0 = (const char*)(ws + WS_WTPA); S.B1 = (const char*)(ws + WS_WTPB);
      S.nM = NTOK / 256; S.nN = DM / 256; S.G = G; S.c = blockIdx.x; S.tstep = (size_t)256 * 1024 * 2;
      EpiMerged E; E.ws = ws;
      if (skew_first) { const Frame F = make_frame(lds, wave_id); conv_gateup(F, P, 0, skew); __syncthreads(); }
      pg8::gemm_phase(lds, 1024, S, E, wave_id);
      if (skew != 3) { const Frame F = make_frame(lds, wave_id); conv_gateup(F, P, skew, 3); } }
    xcd_barrier(xbar);
    TS_MARK(5)
    if (skew_first) { PH(9) { const Frame F = make_frame(lds, wave_id); conv_gateup(F, P, 3, 3 + (5 * skew) / 3); } __syncthreads(); }
    PH(10) { SchedDense S; S.A = (const char*)(ws + WS_MERGED); S.Bt = (const char*)(ws + WS_WTO); S.nM = NTOK / 256; S.nN = DM / 256; S.G = G; S.c = blockIdx.x; S.tstep = (size_t)256 * DM * 2;
      EpiX1 E; E.ws = ws; E.x = P.x; E.x1 = P.out;
      pg8::gemm_phase(lds, DM, S, E, wave_id); }
    TS_MARK(13)
    if (skew != 3) { PH(9) { const Frame F = make_frame(lds, wave_id); conv_gateup(F, P, 3 + (5 * skew) / 3, 8); } }
    TS_MARK(14)
    xcd_barrier(xbar);
    TS_MARK(6)
    PH(12) { const Frame F = make_frame(lds, wave_id); for (int t = 4 * blockIdx.x; t < NTOK / 16; t += 4 * G) p7_pass(F, P, t, _rep != 0); }
    xcd_barrier(xbar);
    TS_MARK(7)
    PH(13) { const Frame F = make_frame(lds, wave_id); p7b_gather(F, P, _rep != 0); }
    xcd_barrier(xbar);
    TS_MARK(8)
    const int* ctl = (const int*)(ws + WS_CTL);
    const int moe_nt = __builtin_amdgcn_readfirstlane(ctl[128]);
    LAS int* tile_lds = (LAS int*)(lds + 131072 + 1024);
    { const int t_ = wave_id * 64 + lane_id(); if (t_ < 160) tile_lds[t_] = ctl[256 + t_]; }
    __syncthreads();
    PH(14) { SchedMoeG S; S.gA = (const char*)(ws + WS_X1B); S.tokrow = (const int*)(ws + WS_TOKROW); S.Bt = (const char*)(ws + WS_WGUT); S.tile_e = tile_lds; S.ntiles = moe_nt; S.NCT = 4; S.G = G; S.c = blockIdx.x; S.tstep = (size_t)256 * DM * 2;
      EpiGateUp E; E.ws = ws; E.bar = (unsigned*)(ws + WS_BAR); E.G = G; E.c = blockIdx.x; E.full = (4 * moe_nt) / G; E.xcd = xbar.x; E.nloc = __hip_atomic_load((const unsigned*)bst, __ATOMIC_RELAXED, __HIP_MEMORY_SCOPE_AGENT);
      pg8::gemm_phase<EpiGateUp, SchedMoeG, true>(lds, DM, S, E, wave_id); }
    TS_MARK(9)
    PH(15) { SchedMoeB S; S.A = (const char*)(ws + WS_ACT); S.Bt = (const char*)(ws + WS_WDT); S.tile_e = tile_lds; S.ntiles = moe_nt; S.G = G; S.c = blockIdx.x; S.tstep = (size_t)256 * DEXP * 2;
      const int n_extra = 4 * moe_nt - ((4 * moe_nt) / G) * G;
      { const int full = (4 * moe_nt) / G; int H = n_extra; int msplit = (full * G) >> 2;
        if (2 * H > G || (G & 3)) { H = 0; msplit = moe_nt; }
        S.H = H; S.msplit = msplit; }
      { unsigned* bar = (unsigned*)(ws + WS_BAR);
        if (wave_id == 0 && lane_id() == 0) {
            const bool heavy = (int)blockIdx.x < S.H;
            if ((heavy || S.H == 0) && n_extra > 0) { const unsigned want = (unsigned)n_extra; XB_SPIN(xb_ld(&bar[XB2_LATE]) < want, bar); }
            if (!heavy && (4 * moe_nt) / G > 0) { const unsigned want = __hip_atomic_load((const unsigned*)bst + 1, __ATOMIC_RELAXED, __HIP_MEMORY_SCOPE_AGENT); XB_SPIN(xb_ld(&bar[XB2_TOP]) < want, bar); }
            __builtin_amdgcn_fence(__ATOMIC_ACQUIRE, "agent"); asm volatile("s_waitcnt vmcnt(0)" ::: "memory"); }
        __syncthreads(); }
      TS_MARK(17)
      EpiDown E; E.ws = ws;
      pg8::gemm_phase(lds, DEXP, S, E, wave_id); }
    TS_MARK(18)
    xcd_barrier(xbar);
    TS_MARK(10)
    PH(16) { const Frame F = make_frame(lds, wave_id); p9_final(F, P); }
#ifdef TS_A0
    TS_MARK(11)
    if (blockIdx.x == TS_BLOCK && threadIdx.x == 0) { unsigned long long t0; TS_READ(t0);
      unsigned long long* tsb = (unsigned long long*)(ws + WS_BAR + 15360);
#define TS_LD(k) __hip_atomic_load(tsb + (k), __ATOMIC_RELAXED, __HIP_MEMORY_SCOPE_AGENT)
      const unsigned long long dt = 10ull * (TS_LD(TS_A1) - TS_LD(TS_A0)) + 1024000ull * ((TS_LD(TS_B1) - TS_LD(TS_B0)) / 800ull);
      for (;;) { unsigned long long t1; TS_READ(t1); if (t1 - t0 >= dt) break; __builtin_amdgcn_s_sleep(8); } }
#endif
}

extern "C" void kernel_launch(void* const* d_in, const int* in_sizes, int n_in, void* d_out, int out_size, void* d_ws, size_t ws_size, hipStream_t stream) {
    static int grid = 0;
    if (grid == 0) {
        if (n_in != 20 || out_size != NTOK * DM || ws_size < WS_END) { fprintf(stderr, "kernel_launch: unexpected shapes (n_in %d out %d ws %zu, need %zu)\n", n_in, out_size, ws_size, (size_t)WS_END); grid = -1; return; }
        int dev = 0, cus = 0, per_cu = 0;
        if (hipGetDevice(&dev) != hipSuccess || hipDeviceGetAttribute(&cus, hipDeviceAttributeMultiprocessorCount, dev) != hipSuccess) { grid = -1; return; }
        if (hipFuncSetAttribute((const void*)mega_fwd, hipFuncAttributeMaxDynamicSharedMemorySize, LDS_BYTES) != hipSuccess) { fprintf(stderr, "kernel_launch: hipFuncSetAttribute failed\n"); grid = -1; return; }
        if (hipOccupancyMaxActiveBlocksPerMultiprocessor(&per_cu, (const void*)mega_fwd, 512, LDS_BYTES) != hipSuccess || per_cu < 1) { fprintf(stderr, "kernel_launch: occupancy query says %d\n", per_cu); (void)hipGetLastError(); grid = -1; return; }
        grid = cus;
        if (grid > 256) grid = 256;
    }
    if (grid < 0) return;
    if (hipMemsetAsync((unsigned char*)d_ws + WS_BAR, 0, 16384, stream) != hipSuccess) { fprintf(stderr, "kernel_launch: memset of the barrier words failed\n"); return; }
    Params p{};
    const float** pp = (const float**)&p;
    for (int i = 0; i < 20; ++i) pp[i] = (const float*)d_in[i];
    p.out = (float*)d_out; p.ws = (unsigned char*)d_ws;
    void* args[] = {&p};
    hipError_t e = hipLaunchCooperativeKernel((const void*)mega_fwd, dim3(grid), dim3(512), args, LDS_BYTES, stream);
    if (e != hipSuccess) fprintf(stderr, "cooperative launch failed: %s (grid %d)\n", hipGetErrorString(e), grid);
}
```
